# Optimizing an MI355X kernel written in HIP

```python
import math
import jax, jax.numpy as jnp
from jax import lax
import numpy as np

D_MODEL = 1024
BATCH = 16
SEQ = 256
DEPTH = 1
DEC_BATCH = 4
DEC_SEQ = 4096
PAST_LEN = 256

GRID_W = 64
ROPE_BASE = 10000.0
RET_HEADS = 4
RET_DK = 128
RET_DV = 256
RET_CHUNK = 128
DIFF_HEADS = 8
DIFF_DH = 64
Q_BLOCK = 128
FFN_HIDDEN = -(-8 * D_MODEL // (3 * 256)) * 256
RET_QK_W = RET_HEADS * RET_DK
RET_V_W = RET_HEADS * RET_DV
DIFF_QK_W = DIFF_HEADS * 2 * DIFF_DH
DIFF_V_W = DIFF_HEADS * 2 * DIFF_DH
W_IN_COLS = 2 * RET_QK_W + 2 * RET_V_W + 2 * DIFF_QK_W + DIFF_V_W + 2 * D_MODEL
RMS_EPS = 1e-6
GN_EPS = 1e-5

kernel_name = "hybrid_retention_diffattn_dit_step"


def rmsnorm(x, g):
    xf = x.astype(jnp.float32)
    y = xf * lax.rsqrt(jnp.mean(xf * xf, axis=-1, keepdims=True) + RMS_EPS)
    return (y * g).astype(x.dtype)


def head_group_norm(y, g):
    yf = y.astype(jnp.float32)
    mu = jnp.mean(yf, axis=-1, keepdims=True)
    var = jnp.mean(jnp.square(yf - mu), axis=-1, keepdims=True)
    return ((yf - mu) * lax.rsqrt(var + GN_EPS) * g).astype(y.dtype)


def modulation(cvec, w_ada, b_ada):
    return jax.nn.silu(cvec) @ w_ada + b_ada


def axial_rope_tables(L, d):
    rows = L // GRID_W
    pos_r = jnp.repeat(jnp.arange(rows), GRID_W).astype(jnp.float32)
    pos_c = jnp.tile(jnp.arange(GRID_W), rows).astype(jnp.float32)
    n = d // 4
    inv = ROPE_BASE ** (-jnp.arange(n, dtype=jnp.float32) / n)
    ang = jnp.concatenate([pos_r[:, None] * inv, pos_c[:, None] * inv], axis=-1)
    return jnp.cos(ang), jnp.sin(ang)


def apply_rope(x, cos, sin):
    shape = (x.shape[1],) + (1,) * (x.ndim - 3) + (cos.shape[-1],)
    c = cos.reshape(shape)
    s = sin.reshape(shape)
    x1, x2 = jnp.split(x, 2, axis=-1)
    return jnp.concatenate([x1 * c - x2 * s, x1 * s + x2 * c], axis=-1).astype(x.dtype)


def retention_scan(q, k, v, log_gamma, s0, inclusive):
    B, L, H, dk = q.shape
    dv = v.shape[-1]
    C = RET_CHUNK
    N = L // C
    qc = q.reshape(B, N, C, H, dk)
    kc = k.reshape(B, N, C, H, dk)
    vc = v.reshape(B, N, C, H, dv)
    idx = jnp.arange(C, dtype=jnp.float32)
    dist = idx[:, None] - idx[None, :]
    mask = (dist >= 0) if inclusive else (dist > 0)
    decay = jnp.where(mask[None], jnp.exp(log_gamma[:, None, None] * jnp.where(mask, dist, 0.0)[None]), 0.0)
    scores = jnp.einsum('bnihd,bnjhd->bnhij', qc, kc) * decay[None, None]
    intra = jnp.einsum('bnhij,bnjhe->bnihe', scores, vc)
    w_k = jnp.exp(log_gamma[:, None] * (C - 1.0 - idx)[None])
    kv = jnp.einsum('bnjhd,hj,bnjhe->bnhde', kc, w_k, vc).astype(jnp.float32)
    gamma_c = jnp.exp(log_gamma * C)[None, :, None, None]

    def step(s, kv_n):
        return gamma_c * s + kv_n, s

    s_final, s_prev = lax.scan(step, s0.astype(jnp.float32), jnp.moveaxis(kv, 1, 0))
    s_prev = jnp.moveaxis(s_prev, 0, 1)
    w_q = jnp.exp(log_gamma[:, None] * (idx + 1.0)[None])
    cross = jnp.einsum('bnihd,hi,bnhde->bnihe', qc, w_q, s_prev)
    out = (intra + cross).reshape(B, L, H, dv).astype(v.dtype)
    return out, s_final.astype(v.dtype)


def diff_attention(q, k, v, lam):
    B, Lq, H, _, dh = q.shape
    nb = Lq // Q_BLOCK
    qb = jnp.moveaxis(q.reshape(B, nb, Q_BLOCK, H, 2, dh), 1, 0)
    scale = dh ** -0.5

    def block(qblk):
        s = jnp.einsum('bqhmd,bkhmd->bhmqk', qblk, k, preferred_element_type=jnp.float32) * scale
        p = jax.nn.softmax(s, axis=-1)
        a = p[:, :, 0] - lam * p[:, :, 1]
        return jnp.einsum('bhqk,bkhe->bqhe', a.astype(v.dtype), v)

    out = lax.map(block, qb)
    return jnp.moveaxis(out, 0, 1).reshape(B, Lq, H, v.shape[-1])


def split_projection(proj):
    widths = (RET_QK_W, RET_QK_W, RET_V_W, RET_V_W, DIFF_QK_W, DIFF_QK_W, DIFF_V_W)
    points, acc = [], 0
    for w in widths:
        acc += w
        points.append(acc)
    return jnp.split(proj, points, axis=-1)


def trunk_layer(x, mod, norm1_g, norm2_g, w_in, b_gate, ret_decay_fwd, ret_decay_bwd, ret_gn_g,
                w_ret_out, lam, lam_init, diff_subln_g, w_diff_out, w_o, w_ffn_gate, w_ffn_up,
                w_ffn_down, ctx_cache):
    B, L, _ = x.shape
    latent = ctx_cache is not None
    shift1, scale1, gate1, shift2, scale2, gate2 = jnp.split(mod, 6, axis=-1)
    h = rmsnorm(x, norm1_g) * (1.0 + scale1) + shift1
    proj = h @ w_in
    q_r, k_r, v_r, g_r, q_d, k_d, v_d, gates = split_projection(proj)
    gates = jax.nn.sigmoid(gates + b_gate)
    gate_r, gate_d = jnp.split(gates, 2, axis=-1)

    q_r = q_r.reshape(B, L, RET_HEADS, RET_DK)
    k_r = k_r.reshape(B, L, RET_HEADS, RET_DK)
    v_r = v_r.reshape(B, L, RET_HEADS, RET_DV)
    q_d = q_d.reshape(B, L, DIFF_HEADS, 2, DIFF_DH)
    k_d = k_d.reshape(B, L, DIFF_HEADS, 2, DIFF_DH)
    v_d = v_d.reshape(B, L, DIFF_HEADS, 2 * DIFF_DH)

    if latent:
        cos_r, sin_r = axial_rope_tables(L, RET_DK)
        q_r = apply_rope(q_r, cos_r, sin_r)
        k_r = apply_rope(k_r, cos_r, sin_r)
        cos_d, sin_d = axial_rope_tables(L, DIFF_DH)
        q_d = apply_rope(q_d, cos_d, sin_d)
        k_d = apply_rope(k_d, cos_d, sin_d)
        s0_f, s0_b, k_ctx, v_ctx = ctx_cache
    else:
        s0_f = jnp.zeros((B, RET_HEADS, RET_DK, RET_DV), jnp.float32)
        s0_b = s0_f
    k_r = k_r * (RET_DK ** -0.5)

    lg_f = jax.nn.log_sigmoid(ret_decay_fwd.astype(jnp.float32))
    lg_b = jax.nn.log_sigmoid(ret_decay_bwd.astype(jnp.float32))
    out_f, s_f = retention_scan(q_r, k_r, v_r, lg_f, s0_f, True)
    out_b_rev, s_b = retention_scan(jnp.flip(q_r, 1), jnp.flip(k_r, 1), jnp.flip(v_r, 1), lg_b, s0_b, False)
    y_r = head_group_norm(out_f + jnp.flip(out_b_rev, 1), ret_gn_g.reshape(RET_HEADS, RET_DV))
    branch_r = (jax.nn.silu(g_r) * y_r.reshape(B, L, RET_V_W)) @ w_ret_out

    if latent:
        k_all = jnp.concatenate([k_d, k_ctx.astype(k_d.dtype)], axis=1)
        v_all = jnp.concatenate([v_d, v_ctx.astype(v_d.dtype)], axis=1)
    else:
        k_all, v_all = k_d, v_d
    o_d = diff_attention(q_d, k_all, v_all, lam)
    o_d = rmsnorm(o_d, diff_subln_g) * (1.0 - lam_init)
    branch_d = o_d.reshape(B, L, DIFF_V_W) @ w_diff_out

    mix = (gate_r * branch_r + gate_d * branch_d) @ w_o
    x = x + gate1 * mix
    h2 = rmsnorm(x, norm2_g) * (1.0 + scale2) + shift2
    ffn = (jax.nn.silu(h2 @ w_ffn_gate) * (h2 @ w_ffn_up)) @ w_ffn_down
    x = x + gate2 * ffn
    ctx_tensors = None if latent else (s_f, s_b, k_d, v_d)
    return x, ctx_tensors


def setup_inputs(seed: int = 0) -> dict:
    key = jax.random.key(seed)
    ks = jax.random.split(key, 32)
    f32 = jnp.float32
    D, F = D_MODEL, FFN_HIDDEN

    def nrm(k, shape, scale):
        return jax.random.normal(k, shape, f32) * scale

    base = 1.0 - 2.0 ** (-5.0 - jnp.arange(RET_HEADS, dtype=f32))
    decay_logit = jnp.log(base) - jnp.log1p(-base)
    return {
        "x_prompt": nrm(ks[0], (BATCH, SEQ, D), 1.0),
        "x_sample": nrm(ks[1], (DEC_BATCH, DEC_SEQ, D), 1.0),
        "state_ret_fwd": nrm(ks[2], (DEC_BATCH, DEPTH, RET_HEADS, RET_DK, RET_DV), 1.0),
        "state_ret_bwd": nrm(ks[3], (DEC_BATCH, DEPTH, RET_HEADS, RET_DK, RET_DV), 1.0),
        "cache_diff_k": nrm(ks[4], (DEC_BATCH, DEPTH, PAST_LEN, DIFF_HEADS, 2, DIFF_DH), 1.0),
        "cache_diff_v": nrm(ks[5], (DEC_BATCH, DEPTH, PAST_LEN, DIFF_HEADS, 2 * DIFF_DH), 1.0),
        "c": nrm(ks[6], (DEC_BATCH, D), 1.0),
        "c_ctx": nrm(ks[7], (D,), 1.0),
        "norm1_g": 1.0 + nrm(ks[8], (DEPTH, D), 0.02),
        "norm2_g": 1.0 + nrm(ks[9], (DEPTH, D), 0.02),
        "w_ada": nrm(ks[10], (DEPTH, D, 6 * D), 0.5 * D ** -0.5),
        "b_ada": nrm(ks[11], (DEPTH, 6 * D), 0.02),
        "w_in": nrm(ks[12], (DEPTH, D, W_IN_COLS), D ** -0.5),
        "b_gate": nrm(ks[13], (DEPTH, 2 * D), 0.1),
        "ret_decay_fwd": decay_logit[None] + nrm(ks[14], (DEPTH, RET_HEADS), 0.1),
        "ret_decay_bwd": decay_logit[None] + nrm(ks[15], (DEPTH, RET_HEADS), 0.1),
        "ret_gn_g": 1.0 + nrm(ks[16], (DEPTH, RET_V_W), 0.02),
        "w_ret_out": nrm(ks[17], (DEPTH, RET_V_W, D), RET_V_W ** -0.5),
        "diff_lambda_q1": nrm(ks[18], (DEPTH, DIFF_DH), 0.1),
        "diff_lambda_k1": nrm(ks[19], (DEPTH, DIFF_DH), 0.1),
        "diff_lambda_q2": nrm(ks[20], (DEPTH, DIFF_DH), 0.1),
        "diff_lambda_k2": nrm(ks[21], (DEPTH, DIFF_DH), 0.1),
        "diff_subln_g": 1.0 + nrm(ks[22], (DEPTH, 2 * DIFF_DH), 0.02),
        "w_diff_out": nrm(ks[23], (DEPTH, DIFF_V_W, D), DIFF_V_W ** -0.5),
        "w_o": nrm(ks[24], (DEPTH, D, D), D ** -0.5),
        "w_ffn_gate": nrm(ks[25], (DEPTH, D, F), D ** -0.5),
        "w_ffn_up": nrm(ks[26], (DEPTH, D, F), D ** -0.5),
        "w_ffn_down": nrm(ks[27], (DEPTH, F, D), F ** -0.5),
        "final_norm_g": 1.0 + nrm(ks[28], (D,), 0.02),
    }


def reference(x_prompt, x_sample, state_ret_fwd, state_ret_bwd, cache_diff_k, cache_diff_v, c,
              c_ctx, norm1_g, norm2_g, w_ada, b_ada, w_in, b_gate, ret_decay_fwd, ret_decay_bwd,
              ret_gn_g, w_ret_out, diff_lambda_q1, diff_lambda_k1, diff_lambda_q2, diff_lambda_k2,
              diff_subln_g, w_diff_out, w_o, w_ffn_gate, w_ffn_up, w_ffn_down, final_norm_g):
    xp, xs = x_prompt, x_sample
    new_f, new_b, new_k, new_v = [], [], [], []
    for l in range(DEPTH):
        lam_init = 0.8 - 0.6 * math.exp(-0.3 * l)
        lam = (jnp.exp(jnp.sum(diff_lambda_q1[l].astype(jnp.float32) * diff_lambda_k1[l].astype(jnp.float32)))
               - jnp.exp(jnp.sum(diff_lambda_q2[l].astype(jnp.float32) * diff_lambda_k2[l].astype(jnp.float32)))
               + lam_init)
        mod_ctx = modulation(c_ctx, w_ada[l], b_ada[l])[None, None, :]
        mod_lat = modulation(c, w_ada[l], b_ada[l])[:, None, :]
        weights = (norm1_g[l], norm2_g[l], w_in[l], b_gate[l], ret_decay_fwd[l], ret_decay_bwd[l],
                   ret_gn_g[l], w_ret_out[l], lam, lam_init, diff_subln_g[l], w_diff_out[l], w_o[l],
                   w_ffn_gate[l], w_ffn_up[l], w_ffn_down[l])
        xp, ctx_t = trunk_layer(xp, mod_ctx, *weights, None)
        xs, _ = trunk_layer(xs, mod_lat, *weights,
                            (state_ret_fwd[:, l], state_ret_bwd[:, l], cache_diff_k[:, l], cache_diff_v[:, l]))
        new_f.append(ctx_t[0])
        new_b.append(ctx_t[1])
        new_k.append(ctx_t[2])
        new_v.append(ctx_t[3])
    y_prompt = rmsnorm(xp, final_norm_g)
    y_sample = rmsnorm(xs, final_norm_g)
    new_ret_fwd = jnp.stack(new_f, axis=1)
    new_ret_bwd = jnp.stack(new_b, axis=1)
    new_diff_k = jnp.stack(new_k, axis=1)
    new_diff_v = jnp.stack(new_v, axis=1)
    return (y_prompt, y_sample, new_ret_fwd, new_ret_bwd, new_diff_k, new_diff_v)
```

```cpp
#include <hip/hip_runtime.h>
#include <hip/hip_cooperative_groups.h>
#include <cstdio>
namespace cg = cooperative_groups;

#ifndef PROBE_M1
#define PROBE_M1 0
#endif
#ifndef PROBE_M2
#define PROBE_M2 0
#endif
#ifndef PROBE_M3
#define PROBE_M3 0
#endif
#ifndef COOP
#define COOP 1
#endif

#define DI __device__ __forceinline__
typedef unsigned short u16;
typedef __attribute__((ext_vector_type(8))) short bf16x8;
typedef __attribute__((ext_vector_type(4))) short s16x4;
typedef __attribute__((ext_vector_type(16))) float f32x16;
typedef __attribute__((ext_vector_type(4))) unsigned u32x4;
typedef __attribute__((ext_vector_type(2))) unsigned u32x2;
#define SCHED_FENCE() asm volatile("" ::: "memory")
#define MFMA(a, b, c) __builtin_amdgcn_mfma_f32_32x32x16_bf16((a), (b), (c), 0, 0, 0)

constexpr int D = 1024;
constexpr int TG = 4096;
constexpr int NG = 5;
constexpr int TT = TG * NG;
constexpr int FF = 2816;
constexpr int WCOLS = 8192;

constexpr size_t OFF_WIN = 0;
constexpr size_t OFF_WR = OFF_WIN + (size_t)8192 * 1024 * 2;
constexpr size_t OFF_WD = OFF_WR + 2097152;
constexpr size_t OFF_WO = OFF_WD + 2097152;
constexpr size_t OFF_WGU = OFF_WO + 2097152;
constexpr size_t OFF_WDN = OFF_WGU + (size_t)5632 * 1024 * 2;
constexpr size_t OFF_MOD = OFF_WDN + (size_t)1024 * 2816 * 2;
constexpr size_t OFF_COSR = OFF_MOD + 122880;
constexpr size_t OFF_SINR = OFF_COSR + 1048576;
constexpr size_t OFF_COSD = OFF_SINR + 1048576;
constexpr size_t OFF_SIND = OFF_COSD + 524288;
constexpr size_t OFF_DEC = OFF_SIND + 524288;
constexpr size_t OFF_KC = OFF_DEC + 16384;
constexpr size_t OFF_VCT = OFF_KC + 2097152;
constexpr size_t OFF_HB = OFF_VCT + 2097152;
constexpr size_t OFF_G = OFF_HB + (size_t)TT * 1024 * 2;
constexpr size_t G_QR = OFF_G;
constexpr size_t G_QA = G_QR + 4194304;
constexpr size_t G_QB = G_QA + 4194304;
constexpr size_t G_KR = G_QB + 4194304;
constexpr size_t G_KRTF = G_KR + 4194304;
constexpr size_t G_KRTB = G_KRTF + 4194304;
constexpr size_t G_VRT = G_KRTB + 4194304;
constexpr size_t G_GR = G_VRT + 8388608;
constexpr size_t G_QD = G_GR + 8388608;
constexpr size_t G_KD = G_QD + 8388608;
constexpr size_t G_VDT = G_KD + 8388608;
constexpr size_t G_GATES = G_VDT + 8388608;
constexpr size_t G_KV = G_GATES + 16777216;
constexpr size_t G_SP = G_KV + 33554432;
constexpr size_t G_SC = G_SP + 16777216;
constexpr size_t G_MIX = G_SC + 4194304;
constexpr size_t G_END = G_MIX + 8388608;
constexpr size_t OFF_BAR = G_END;
constexpr size_t OFF_ACT = OFF_G;
static_assert((size_t)TT * FF * 2 <= G_END - OFF_G, "ACT alias");
static_assert(G_END + 16384 <= (size_t)256 * 1024 * 1024, "ws");

constexpr int DEC_WQF = 0, DEC_WQB = 512, DEC_WKF = 1024, DEC_WKB = 1536, DEC_LGF = 2048, DEC_LGB = 2052, DEC_GCF = 2056, DEC_GCB = 2060, DEC_LAM = 2064;

constexpr size_t OUT_Y = 0;
constexpr size_t OUT_RF = (size_t)TT * 1024;
constexpr size_t OUT_RB = OUT_RF + 2097152;
constexpr size_t OUT_DK = OUT_RB + 2097152;
constexpr size_t OUT_DV = OUT_DK + 4194304;

struct Params {
  const float *x_prompt, *x_sample, *state_f, *state_b, *cache_k, *cache_v, *c, *c_ctx, *norm1_g, *norm2_g, *w_ada, *b_ada, *w_in, *b_gate,
      *decay_f, *decay_b, *gn_g, *w_ret_out, *lq1, *lk1, *lq2, *lk2, *subln_g, *w_diff_out, *w_o, *w_gate, *w_up, *w_down, *final_g;
  float* out;
  char* ws;
};

DI int ltid() { int t = threadIdx.x; asm volatile("" : "+v"(t)); return t; }
DI char* glaunder(char* p) { __attribute__((address_space(1))) char* g = (__attribute__((address_space(1))) char*)p; asm volatile("" : "+s"(g)); return (char*)g; }
DI int lbid() { int b = blockIdx.x; asm volatile("" : "+s"(b)); return b; }
DI int lgdim() { int b = gridDim.x; asm volatile("" : "+s"(b)); return b; }
typedef __bf16 hbf16x2 __attribute__((ext_vector_type(2)));
typedef float f32x2 __attribute__((ext_vector_type(2)));
DI u16 f2bf(float x) { return __builtin_bit_cast(u16, (__bf16)x); }
DI float bf2f(u16 v) { return __uint_as_float(((unsigned)v) << 16); }
DI unsigned pack2(float a, float b) { f32x2 v = {a, b}; return __builtin_bit_cast(unsigned, __builtin_convertvector(v, hbf16x2)); }
DI float silu_f(float x) { return x * __builtin_amdgcn_rcpf(1.f + __expf(-x)); }
DI float sigmoid_f(float x) { return __builtin_amdgcn_rcpf(1.f + __expf(-x)); }
DI float wave_sum(float v) {
#pragma unroll
  for (int o = 32; o > 0; o >>= 1) v += __shfl_xor(v, o, 64);
  return v;
}
DI const float* xrow(const Params& p, int row) { return row < TG ? p.x_prompt + (size_t)row * D : p.x_sample + (size_t)(row - TG) * D; }

constexpr int LDT = 72;
constexpr int SMEM_BYTES = 2 * 2 * 128 * LDT * 2;
constexpr int SMEM_OLD_UNUSED = 0;

template <int NJ>
DI void gemm_accum_t(f32x16 (&acc)[2][NJ], const u16* A, int lda, const u16* Bt, int ldb, int K, u16* sA, u16* sB, int cbmode) {
  constexpr int STG = 2 * 128 * LDT;
  constexpr int NB = 2 * NJ;
  const int tid = ltid(), lane = tid & 63, wave = tid >> 6, wm = wave >> 1, wn = wave & 1, r = lane & 31, h = lane >> 5;
  const int lrow = tid >> 3, lcol = (tid & 7) * 8;
  const u16* ap = A + (size_t)lrow * lda + lcol;
  const u16* bp = Bt + (size_t)lrow * ldb + lcol;
  const int nk = K >> 6;
  u32x4 ra[3][4], rb[3][NB];
#define GEMM_LOAD(SET)                                                                            \
  {                                                                                               \
    _Pragma("unroll") for (int q = 0; q < 4; ++q) ra[SET][q] = *(const u32x4*)(ap + (size_t)(32 * q) * lda);  \
    _Pragma("unroll") for (int q = 0; q < NB; ++q) rb[SET][q] = *(const u32x4*)(bp + (size_t)(32 * q) * ldb); \
    ap += 64; bp += 64;                                                                           \
  }
  GEMM_LOAD(0)
  if (nk > 1) GEMM_LOAD(1)
  if (nk > 2) GEMM_LOAD(2)
  const int cb0 = NJ == 1 ? wn : (cbmode ? wn : 2 * wn), cb1 = cbmode ? wn + 2 : 2 * wn + 1;
  const u16* sa0 = sA + (wm * 64 + r) * LDT + h * 8;
  const u16* sb0 = sB + (cb0 * 32 + r) * LDT + h * 8;
  const u16* sb1 = sB + (cb1 * 32 + r) * LDT + h * 8;
  u16* wa = sA + lrow * LDT + lcol;
  u16* wb = sB + lrow * LDT + lcol;
  __syncthreads();
#pragma unroll
  for (int q = 0; q < 4; ++q) *(u32x4*)(wa + 32 * q * LDT) = ra[0][q];
#pragma unroll
  for (int q = 0; q < NB; ++q) *(u32x4*)(wb + 32 * q * LDT) = rb[0][q];
  __syncthreads();
#define GEMM_ITER(IDX, PAR, SET)                                                                  \
  {                                                                                               \
    const int kk = kt + IDX;                                                                      \
    if (kk + 3 < nk) GEMM_LOAD(SET)                                                               \
                       \
    bf16x8 fa[2][2], fb[2][2];                                                                    \
    fa[0][0] = *(const bf16x8*)(sa0 + PAR * STG);                                                 \
    fa[0][1] = *(const bf16x8*)(sa0 + PAR * STG + 32 * LDT);                                      \
    fb[0][0] = *(const bf16x8*)(sb0 + PAR * STG);                                                 \
    fb[0][1] = *(const bf16x8*)((NJ == 2 ? sb1 : sb0) + PAR * STG);                               \
    _Pragma("unroll") for (int ks = 0; ks < 4; ++ks) {                                            \
      if (ks < 3) {                                                                               \
        fa[(ks + 1) & 1][0] = *(const bf16x8*)(sa0 + PAR * STG + (ks + 1) * 16);                  \
        fa[(ks + 1) & 1][1] = *(const bf16x8*)(sa0 + PAR * STG + 32 * LDT + (ks + 1) * 16);       \
        fb[(ks + 1) & 1][0] = *(const bf16x8*)(sb0 + PAR * STG + (ks + 1) * 16);                  \
        if (NJ == 2) fb[(ks + 1) & 1][1] = *(const bf16x8*)(sb1 + PAR * STG + (ks + 1) * 16);     \
      }                                                                                           \
      __builtin_amdgcn_sched_barrier(0);                                                          \
      acc[0][0] = MFMA(fa[ks & 1][0], fb[ks & 1][0], acc[0][0]);                                  \
      acc[1][0] = MFMA(fa[ks & 1][1], fb[ks & 1][0], acc[1][0]);                                  \
      if (NJ == 2) {                                                                              \
        acc[0][NJ - 1] = MFMA(fa[ks & 1][0], fb[ks & 1][1], acc[0][NJ - 1]);                      \
        acc[1][NJ - 1] = MFMA(fa[ks & 1][1], fb[ks & 1][1], acc[1][NJ - 1]);                      \
      }                                                                                           \
      __builtin_amdgcn_sched_barrier(0);                                                          \
    }                                                                                             \
    if (kk + 1 < nk) {                                                                            \
      _Pragma("unroll") for (int q = 0; q < 4; ++q) *(u32x4*)(wa + (1 - PAR) * STG + 32 * q * LDT) = ra[(SET + 1) % 3][q];  \
      _Pragma("unroll") for (int q = 0; q < NB; ++q) *(u32x4*)(wb + (1 - PAR) * STG + 32 * q * LDT) = rb[(SET + 1) % 3][q]; \
    }                                                                                             \
    __syncthreads();                                                                              \
  }
  for (int kt = 0; kt < nk; kt += 6) {
    GEMM_ITER(0, 0, 0)
    if (kt + 1 < nk) GEMM_ITER(1, 1, 1)
    if (kt + 2 < nk) GEMM_ITER(2, 0, 2)
    if (kt + 3 < nk) GEMM_ITER(3, 1, 0)
    if (kt + 4 < nk) GEMM_ITER(4, 0, 1)
    if (kt + 5 < nk) GEMM_ITER(5, 1, 2)
  }
#undef GEMM_ITER
#undef GEMM_LOAD
}
DI void gemm_accum_256(f32x16 (&acc)[4][2], const u16* A, int a_rs, int a_ks, int a_sub, const u16* Bt, int b_rs, int b_ks, int K, u16* sA, int cbmode) {
  u16* sB = sA + 256 * LDT;
  const int tid = ltid(), lane = tid & 63, wave = tid >> 6, wm = wave >> 1, wn = wave & 1, r = lane & 31, h = lane >> 5;
  const int lrow = tid >> 3, lcol = (tid & 7) * 8;
  const u16* ap = A + (size_t)lrow * a_rs + lcol;
  const u16* bp = Bt + (size_t)lrow * b_rs + lcol;
  const int nk = K >> 6;
  u32x4 ra[8], rb[4];
#define A_OFF(q) ((size_t)((q) >> 2) * a_sub + (size_t)(32 * ((q) & 3)) * a_rs)
#pragma unroll
  for (int q = 0; q < 8; ++q) ra[q] = *(const u32x4*)(ap + A_OFF(q));
#pragma unroll
  for (int q = 0; q < 4; ++q) rb[q] = *(const u32x4*)(bp + (size_t)(32 * q) * b_rs);
  const int cb0 = cbmode ? wn : 2 * wn, cb1 = cbmode ? wn + 2 : 2 * wn + 1;
  const u16* sa0 = sA + (wm * 128 + r) * LDT + h * 8;
  const u16* sb0 = sB + (cb0 * 32 + r) * LDT + h * 8;
  const u16* sb1 = sB + (cb1 * 32 + r) * LDT + h * 8;
  u16* wa = sA + lrow * LDT + lcol;
  u16* wb = sB + lrow * LDT + lcol;
  for (int kt = 0; kt < nk; ++kt) {
    __syncthreads();
#pragma unroll
    for (int q = 0; q < 8; ++q) *(u32x4*)(wa + 32 * q * LDT) = ra[q];
#pragma unroll
    for (int q = 0; q < 4; ++q) *(u32x4*)(wb + 32 * q * LDT) = rb[q];
    __syncthreads();
    if (kt + 1 < nk) {
      ap += a_ks; bp += b_ks;
#pragma unroll
      for (int q = 0; q < 8; ++q) ra[q] = *(const u32x4*)(ap + A_OFF(q));
#pragma unroll
      for (int q = 0; q < 4; ++q) rb[q] = *(const u32x4*)(bp + (size_t)(32 * q) * b_rs);
    }
    bf16x8 fa[4], fb[2][2];
    fb[0][0] = *(const bf16x8*)(sb0);
    fb[0][1] = *(const bf16x8*)(sb1);
#pragma unroll
    for (int i = 0; i < 4; ++i) fa[i] = *(const bf16x8*)(sa0 + i * 32 * LDT);
#pragma unroll
    for (int ks = 0; ks < 4; ++ks) {
      if (ks < 3) {
        fb[(ks + 1) & 1][0] = *(const bf16x8*)(sb0 + (ks + 1) * 16);
        fb[(ks + 1) & 1][1] = *(const bf16x8*)(sb1 + (ks + 1) * 16);
      }
#pragma unroll
      for (int i = 0; i < 4; ++i) {
        __builtin_amdgcn_sched_barrier(0);
        acc[i][0] = MFMA(fa[i], fb[ks & 1][0], acc[i][0]);
        acc[i][1] = MFMA(fa[i], fb[ks & 1][1], acc[i][1]);
        __builtin_amdgcn_sched_barrier(0);
        if (ks < 3) fa[i] = *(const bf16x8*)(sa0 + i * 32 * LDT + (ks + 1) * 16);
      }
    }
  }
}
#undef A_OFF
DI void zero_acc4(f32x16 (&acc)[4][2]) {
#pragma unroll
  for (int i = 0; i < 4; ++i)
#pragma unroll
    for (int j = 0; j < 2; ++j)
#pragma unroll
      for (int e = 0; e < 16; ++e) acc[i][j][e] = 0.f;
}
DI void gemm_accum(f32x16 (&acc)[2][2], const u16* A, int lda, const u16* Bt, int ldb, int K, u16* sA, u16* sB, int cbmode) {
  gemm_accum_t<2>(acc, A, lda, Bt, ldb, K, sA, sB, cbmode);
}
DI void zero_acc1(f32x16 (&acc)[2][1]) {
#pragma unroll
  for (int i = 0; i < 2; ++i)
#pragma unroll
    for (int e = 0; e < 16; ++e) acc[i][0][e] = 0.f;
}

DI void zero_acc(f32x16 (&acc)[2][2]) {
#pragma unroll
  for (int i = 0; i < 2; ++i)
#pragma unroll
    for (int j = 0; j < 2; ++j)
#pragma unroll
      for (int e = 0; e < 16; ++e) acc[i][j][e] = 0.f;
}

#define TILE_COORDS                                                                                  \
  const int tid = ltid(), lane = tid & 63, wave = tid >> 6, wm = wave >> 1, wn = wave & 1;      \
  const int r = lane & 31, h = lane >> 5;                                                            \
  (void)r; (void)h; (void)wm; (void)wn;
#define ROW_L(i, reg) (wm * 64 + (i) * 32 + ((reg) & 3) + 8 * ((reg) >> 2) + 4 * h)
#define COL_L(j, cbmode) (((cbmode) ? (wn + 2 * (j)) : (2 * wn + (j))) * 32 + r)

DI void step_p0(const Params& p, char* smem) {
  const int tid = ltid();
  char* ws = glaunder(p.ws);
  {
    float(*tile)[65] = (float(*)[65])smem;
    constexpr int NT_ALL = 2048 + 768 + 1408 + 704 + 256;
    for (int t = lbid(); t < NT_ALL; t += lgdim()) {
      const float* src; int N; u16* dst; int dld; int mode = 0; int ntl; int tt = t;
      if (tt < 2048) { src = p.w_in; N = 8192; dst = (u16*)(ws + OFF_WIN); dld = 1024; ntl = 128; }
      else if ((tt -= 2048) < 256) { src = p.w_ret_out; N = 1024; dst = (u16*)(ws + OFF_WR); dld = 1024; ntl = 16; }
      else if ((tt -= 256) < 256) { src = p.w_diff_out; N = 1024; dst = (u16*)(ws + OFF_WD); dld = 1024; ntl = 16; }
      else if ((tt -= 256) < 256) { src = p.w_o; N = 1024; dst = (u16*)(ws + OFF_WO); dld = 1024; ntl = 16; }
      else if ((tt -= 256) < 704) { src = p.w_gate; N = FF; dst = (u16*)(ws + OFF_WGU); dld = 1024; mode = 1; ntl = 44; }
      else if ((tt -= 704) < 704) { src = p.w_up; N = FF; dst = (u16*)(ws + OFF_WGU); dld = 1024; mode = 2; ntl = 44; }
      else if ((tt -= 704) < 704) { src = p.w_down; N = 1024; dst = (u16*)(ws + OFF_WDN); dld = FF; ntl = 16; }
      else { tt -= 704; int b = tt >> 6; tt &= 63; src = p.cache_v + (size_t)b * 256 * 1024; N = 1024; dst = (u16*)(ws + OFF_VCT) + (size_t)b * 1024 * 256; dld = 256; ntl = 16; }
      const int kt = tt / ntl, nt = tt % ntl;
      __syncthreads();
#pragma unroll
      for (int q = 0; q < 4; ++q) {
        const int k = (tid >> 4) + 16 * q, n4 = (tid & 15) * 4;
        const float4 v = *(const float4*)(src + (size_t)(kt * 64 + k) * N + nt * 64 + n4);
        tile[k][n4 + 0] = v.x; tile[k][n4 + 1] = v.y; tile[k][n4 + 2] = v.z; tile[k][n4 + 3] = v.w;
      }
      __syncthreads();
#pragma unroll
      for (int q = 0; q < 2; ++q) {
        const int n = (tid >> 3) + 32 * q, k8 = (tid & 7) * 8;
        uint4 o;
        o.x = pack2(tile[k8 + 0][n], tile[k8 + 1][n]);
        o.y = pack2(tile[k8 + 2][n], tile[k8 + 3][n]);
        o.z = pack2(tile[k8 + 4][n], tile[k8 + 5][n]);
        o.w = pack2(tile[k8 + 6][n], tile[k8 + 7][n]);
        const int ng = nt * 64 + n;
        const int drow = mode == 0 ? ng : (64 * (ng >> 5) + (mode == 2 ? 32 : 0) + (ng & 31));
        if (t < 2048) *(uint4*)(dst + ((size_t)((drow >> 7) * 16 + kt) * 128 + (drow & 127)) * 64 + k8) = o;
        else *(uint4*)(dst + (size_t)drow * dld + kt * 64 + k8) = o;
      }
    }
  }
  {
    float* sil = (float*)smem;
    float* red = sil + 5 * 1024;
    float* MOD = (float*)(ws + OFF_MOD);
    for (int t = lbid(); t < 192; t += lgdim()) {
      __syncthreads();
      for (int e = tid; e < 5 * 1024; e += 256) {
        const int v = e >> 10, k = e & 1023;
        const float cv = v == 0 ? p.c_ctx[k] : p.c[(v - 1) * 1024 + k];
        sil[e] = silu_f(cv);
      }
      __syncthreads();
      const int cidx = tid & 31, kg = tid >> 5, n0 = t * 32;
      float a0 = 0, a1 = 0, a2 = 0, a3 = 0, a4 = 0;
      const float* wp = p.w_ada + (size_t)kg * 6144 + n0 + cidx;
      for (int k0 = 0; k0 < 128; k0 += 16) {
        float w[16];
#pragma unroll
        for (int u = 0; u < 16; ++u) w[u] = wp[(size_t)(k0 + u) * (8 * 6144)];
#pragma unroll
        for (int u = 0; u < 16; ++u) {
          const int k = kg + 8 * (k0 + u);
          a0 += sil[k] * w[u]; a1 += sil[1024 + k] * w[u]; a2 += sil[2048 + k] * w[u]; a3 += sil[3072 + k] * w[u]; a4 += sil[4096 + k] * w[u];
        }
      }
      red[(kg * 5 + 0) * 32 + cidx] = a0; red[(kg * 5 + 1) * 32 + cidx] = a1; red[(kg * 5 + 2) * 32 + cidx] = a2;
      red[(kg * 5 + 3) * 32 + cidx] = a3; red[(kg * 5 + 4) * 32 + cidx] = a4;
      __syncthreads();
      if (tid < 160) {
        const int v = tid >> 5, cc = tid & 31;
        float s = p.b_ada[n0 + cc];
#pragma unroll
        for (int g8 = 0; g8 < 8; ++g8) s += red[(g8 * 5 + v) * 32 + cc];
        MOD[v * 6144 + n0 + cc] = s;
      }
    }
  }
  {
    const int gt = lbid() * 256 + tid, gn = lgdim() * 256;
    u16* KC = (u16*)(ws + OFF_KC);
    for (int e = gt; e < 4 * 256 * 1024 / 4; e += gn) {
      const float4 v = *(const float4*)(p.cache_k + (size_t)e * 4);
      uint2 o; o.x = pack2(v.x, v.y); o.y = pack2(v.z, v.w);
      *(uint2*)(KC + (size_t)e * 4) = o;
    }
    float* cosR = (float*)(ws + OFF_COSR); float* sinR = (float*)(ws + OFF_SINR);
    for (int e = gt; e < 4096 * 64; e += gn) {
      const int pos = e >> 6, d = e & 63;
      const int fi = d & 31;
      const float inv = powf(10000.0f, -(float)fi / 32.0f);
      const float pp = d < 32 ? (float)(pos >> 6) : (float)(pos & 63);
      const float ang = pp * inv;
      cosR[e] = cosf(ang); sinR[e] = sinf(ang);
    }
    float* cosD = (float*)(ws + OFF_COSD); float* sinD = (float*)(ws + OFF_SIND);
    for (int e = gt; e < 4096 * 32; e += gn) {
      const int pos = e >> 5, d = e & 31;
      const int fi = d & 15;
      const float inv = powf(10000.0f, -(float)fi / 16.0f);
      const float pp = d < 16 ? (float)(pos >> 6) : (float)(pos & 63);
      const float ang = pp * inv;
      cosD[e] = cosf(ang); sinD[e] = sinf(ang);
    }
  }
  if (lbid() == 0) {
    float* DEC = (float*)(ws + OFF_DEC);
    for (int e = tid; e < 512; e += 256) {
      const int hh = e >> 7, i = e & 127;
      const float df = p.decay_f[hh], db = p.decay_b[hh];
      const float lgf = fminf(df, 0.f) - log1pf(expf(-fabsf(df)));
      const float lgb = fminf(db, 0.f) - log1pf(expf(-fabsf(db)));
      DEC[DEC_WQF + e] = expf(lgf * (float)(i + 1));
      DEC[DEC_WQB + e] = expf(lgb * (float)(128 - i));
      DEC[DEC_WKF + e] = expf(lgf * (float)(127 - i));
      DEC[DEC_WKB + e] = expf(lgb * (float)i);
      if (i == 0) {
        DEC[DEC_LGF + hh] = lgf; DEC[DEC_LGB + hh] = lgb;
        DEC[DEC_GCF + hh] = expf(lgf * 128.f); DEC[DEC_GCB + hh] = expf(lgb * 128.f);
      }
    }
    if (tid < 64) {
      float s1 = p.lq1[tid] * p.lk1[tid], s2 = p.lq2[tid] * p.lk2[tid];
      s1 = wave_sum(s1); s2 = wave_sum(s2);
      if (tid == 0) DEC[DEC_LAM] = expf(s1) - expf(s2) + 0.2f;
    }
  }
}

DI void step_rownorm(const Params& p, int mode) {
  const int lane = ltid() & 63, wave = ltid() >> 6;
  const float* MOD = (const float*)(p.ws + OFF_MOD);
  u16* HB = (u16*)(p.ws + OFF_HB);
  for (int row = lbid() * 4 + wave; row < TT; row += lgdim() * 4) {
    const float* src = mode == 0 ? xrow(p, row) : p.out + OUT_Y + (size_t)row * D;
    float4 v[4];
    float ss = 0.f;
#pragma unroll
    for (int i = 0; i < 4; ++i) {
      v[i] = *(const float4*)(src + lane * 4 + 256 * i);
      ss += v[i].x * v[i].x + v[i].y * v[i].y + v[i].z * v[i].z + v[i].w * v[i].w;
    }
    ss = wave_sum(ss);
    const float rstd = rsqrtf(ss * (1.f / 1024.f) + 1e-6f);
    const int mv = row < TG ? 0 : 1 + ((row - TG) >> 12);
    const float* md = MOD + mv * 6144;
#pragma unroll
    for (int i = 0; i < 4; ++i) {
      const int col = lane * 4 + 256 * i;
      if (mode == 2) {
        const float4 g = *(const float4*)(p.final_g + col);
        float4 o; o.x = v[i].x * rstd * g.x; o.y = v[i].y * rstd * g.y; o.z = v[i].z * rstd * g.z; o.w = v[i].w * rstd * g.w;
        *(float4*)(p.out + OUT_Y + (size_t)row * D + col) = o;
      } else {
        const float4 g = *(const float4*)((mode == 0 ? p.norm1_g : p.norm2_g) + col);
        const float4 sh = *(const float4*)(md + (mode == 0 ? 0 : 3072) + col);
        const float4 sc = *(const float4*)(md + (mode == 0 ? 1024 : 4096) + col);
        uint2 o;
        o.x = pack2(v[i].x * rstd * g.x * (1.f + sc.x) + sh.x, v[i].y * rstd * g.y * (1.f + sc.y) + sh.y);
        o.y = pack2(v[i].z * rstd * g.z * (1.f + sc.z) + sh.z, v[i].w * rstd * g.w * (1.f + sc.w) + sh.w);
        if (mode == 0) *(uint2*)(HB + ((size_t)((row >> 7) * 16 + (col >> 6)) * 128 + (row & 127)) * 64 + (col & 63)) = o;
        else *(uint2*)(HB + (size_t)row * D + col) = o;
      }
    }
  }
}

template <typename T> DI T* launder(T* p) { __attribute__((address_space(1))) T* g = (__attribute__((address_space(1))) T*)p; asm volatile("" : "+v"(g)); return (T*)g; }
#define ROFF(i, reg) ((i) * 32 + ((reg) & 3) + 8 * ((reg) >> 2))

DI void step_proj(const Params& p, int g, char* smem) {
  TILE_COORDS
  char* ws = glaunder(p.ws);
  u16* sA = (u16*)smem; u16* sB = sA + 128 * LDT;
  const u16* HBg = (const u16*)(ws + OFF_HB) + (size_t)g * TG * D;
  const u16* WIN = (const u16*)(ws + OFF_WIN);
  const float* DEC = (const float*)(ws + OFF_DEC);
  const bool lat = g > 0;
  for (int t = lbid(); t < 16 * 64; t += lgdim()) {
    const int ntile = t >> 4, mt = t & 15;
    const int m0 = mt * 256, n0 = ntile * 128;
    const int cbmode = n0 < 1024 ? 1 : 0;
    f32x16 acc[4][2];
    zero_acc4(acc);
    gemm_accum_256(acc, HBg + (size_t)(m0 >> 7) * 16 * 8192, 64, 8192, 16 * 8192, WIN + (size_t)ntile * 16 * 8192, 64, 8192, D, sA, cbmode);
    const int rowb = m0 + wm * 128 + 4 * h;
    if (n0 < 1024) {
      const bool isk = n0 >= 512;
      const int hh = (n0 & 511) >> 7;
      const int d1 = 32 * wn + r;
      const float* cosb = launder((const float*)(ws + OFF_COSR) + (size_t)rowb * 64 + d1);
      const float* sinb = launder((const float*)(ws + OFF_SINR) + (size_t)rowb * 64 + d1);
      const int ib = rowb & 127;
      const float* wfb = launder(DEC + (isk ? DEC_WKF : DEC_WQF) + hh * 128 + ib);
      const float* wbb = launder(DEC + (isk ? DEC_WKB : DEC_WQB) + hh * 128 + ib);
      const size_t o512 = (size_t)rowb * 512 + hh * 128 + d1;
      if (!isk) {
        u16* qr = launder((u16*)(ws + G_QR) + o512); u16* qa = launder((u16*)(ws + G_QA) + o512); u16* qb = launder((u16*)(ws + G_QB) + o512);
#pragma unroll
        for (int i = 0; i < 4; ++i) {
#pragma unroll
          for (int reg = 0; reg < 16; ++reg) {
            const int ro = ROFF(i, reg);
            const float x1 = acc[i][0][reg], x2 = acc[i][1][reg];
            float a = x1, b = x2;
            if (lat) { const float cs = cosb[ro * 64], sn = sinb[ro * 64]; a = x1 * cs - x2 * sn; b = x1 * sn + x2 * cs; }
            const float wf = wfb[ro], wb = wbb[ro];
            qr[ro * 512] = f2bf(a); qr[ro * 512 + 64] = f2bf(b);
            qa[ro * 512] = f2bf(a * wf); qa[ro * 512 + 64] = f2bf(b * wf);
            qb[ro * 512] = f2bf(a * wb); qb[ro * 512 + 64] = f2bf(b * wb);
          }
          SCHED_FENCE();
        }
      } else {
        u16* kr = launder((u16*)(ws + G_KR) + o512);
        const size_t ot = (size_t)(hh * 128 + d1) * TG + rowb;
        u16* kf = launder((u16*)(ws + G_KRTF) + ot); u16* kb = launder((u16*)(ws + G_KRTB) + ot);
#pragma unroll
        for (int i = 0; i < 4; ++i) {
#pragma unroll
          for (int rg = 0; rg < 4; ++rg) {
            float o1[4], o2[4], wf[4], wb[4];
#pragma unroll
            for (int e = 0; e < 4; ++e) {
              const int ro = ROFF(i, rg * 4 + e);
              const float x1 = acc[i][0][rg * 4 + e], x2 = acc[i][1][rg * 4 + e];
              float a = x1, b = x2;
              if (lat) { const float cs = cosb[ro * 64], sn = sinb[ro * 64]; a = x1 * cs - x2 * sn; b = x1 * sn + x2 * cs; }
              a *= 0.08838834764831845f; b *= 0.08838834764831845f;
              wf[e] = wfb[ro]; wb[e] = wbb[ro];
              o1[e] = a; o2[e] = b;
              kr[ro * 512] = f2bf(a); kr[ro * 512 + 64] = f2bf(b);
            }
            const int to = i * 32 + 8 * rg;
            u32x2 v;
            v.x = pack2(o1[0] * wf[0], o1[1] * wf[1]); v.y = pack2(o1[2] * wf[2], o1[3] * wf[3]); *(u32x2*)(kf + to) = v;
            v.x = pack2(o2[0] * wf[0], o2[1] * wf[1]); v.y = pack2(o2[2] * wf[2], o2[3] * wf[3]); *(u32x2*)(kf + to + 64 * TG) = v;
            v.x = pack2(o1[0] * wb[0], o1[1] * wb[1]); v.y = pack2(o1[2] * wb[2], o1[3] * wb[3]); *(u32x2*)(kb + to) = v;
            v.x = pack2(o2[0] * wb[0], o2[1] * wb[1]); v.y = pack2(o2[2] * wb[2], o2[3] * wb[3]); *(u32x2*)(kb + to + 64 * TG) = v;
          }
          SCHED_FENCE();
        }
      }
    } else if (n0 < 2048 || (n0 >= 5120 && n0 < 6144)) {
      const bool isd = n0 >= 5120;
      const int cbase = isd ? n0 - 5120 : n0 - 1024;
#pragma unroll
      for (int j = 0; j < 2; ++j) {
        const int col = cbase + COL_L(j, 0);
        u16* vt = launder((isd ? (u16*)(ws + G_VDT) : (u16*)(ws + G_VRT)) + (size_t)col * TG + rowb);
        float* ov = launder(p.out + OUT_DV + (size_t)rowb * 1024 + col);
#pragma unroll
        for (int i = 0; i < 4; ++i) {
#pragma unroll
          for (int rg = 0; rg < 4; ++rg) {
            u32x2 v;
            v.x = pack2(acc[i][j][rg * 4 + 0], acc[i][j][rg * 4 + 1]);
            v.y = pack2(acc[i][j][rg * 4 + 2], acc[i][j][rg * 4 + 3]);
            *(u32x2*)(vt + i * 32 + 8 * rg) = v;
            if (isd && !lat) {
#pragma unroll
              for (int e = 0; e < 4; ++e) ov[(i * 32 + 8 * rg + e) * 1024] = acc[i][j][rg * 4 + e];
            }
          }
        }
        SCHED_FENCE();
      }
    } else if (n0 < 3072) {
#pragma unroll
      for (int j = 0; j < 2; ++j) {
        u16* gr = launder((u16*)(ws + G_GR) + (size_t)rowb * 1024 + n0 - 2048 + COL_L(j, 0));
#pragma unroll
        for (int i = 0; i < 4; ++i)
#pragma unroll
          for (int reg = 0; reg < 16; ++reg) gr[ROFF(i, reg) * 1024] = f2bf(silu_f(acc[i][j][reg]));
        SCHED_FENCE();
      }
    } else if (n0 < 5120) {
      const bool isk = n0 >= 4096;
      const int cbase = (isk ? n0 - 4096 : n0 - 3072) + 64 * wn + r;
      const float* cosb = launder((const float*)(ws + OFF_COSD) + (size_t)rowb * 32 + r);
      const float* sinb = launder((const float*)(ws + OFF_SIND) + (size_t)rowb * 32 + r);
      u16* dst = launder((isk ? (u16*)(ws + G_KD) : (u16*)(ws + G_QD)) + (size_t)rowb * 1024 + cbase);
      float* ok = launder(p.out + OUT_DK + (size_t)rowb * 1024 + cbase);
      const float qs = isk ? 1.f : 0.125f * 1.4426950408889634f;
#pragma unroll
      for (int i = 0; i < 4; ++i) {
#pragma unroll
        for (int reg = 0; reg < 16; ++reg) {
          const int ro = ROFF(i, reg);
          const float x1 = acc[i][0][reg], x2 = acc[i][1][reg];
          float a = x1, b = x2;
          if (lat) { const float cs = cosb[ro * 32], sn = sinb[ro * 32]; a = x1 * cs - x2 * sn; b = x1 * sn + x2 * cs; }
          else if (isk) { ok[ro * 1024] = x1; ok[ro * 1024 + 32] = x2; }
          dst[ro * 1024] = f2bf(a * qs);
          dst[ro * 1024 + 32] = f2bf(b * qs);
        }
        SCHED_FENCE();
      }
    } else {
#pragma unroll
      for (int j = 0; j < 2; ++j) {
        const int col = n0 - 6144 + COL_L(j, 0);
        const float bg = p.b_gate[col];
        u16* gt = launder((u16*)(ws + G_GATES) + (size_t)rowb * 2048 + col);
#pragma unroll
        for (int i = 0; i < 4; ++i)
#pragma unroll
          for (int reg = 0; reg < 16; ++reg) gt[ROFF(i, reg) * 2048] = f2bf(sigmoid_f(acc[i][j][reg] + bg));
        SCHED_FENCE();
      }
    }
  }
}

constexpr int LDK = 136, LDV = 72, LDC = 132;
DI void attn_item(const Params& p, int g, int item, char* smem, bool dummy = false) {
  const int tid = ltid(), lane = tid & 63, wave = tid >> 6, r = lane & 31, h = lane >> 5;
  const int m = wave >> 1, rw = wave & 1;
  char* ws = glaunder(p.ws);
  u16* sK = (u16*)smem; u16* sV = sK + 64 * LDK;
  float* cmb = (float*)smem;
  const int head = item & 7, rest = item >> 3;
  int q0, kbase, nt0, nt1;
  if (g == 0) { const int seq = rest >> 2; q0 = seq * 256 + (rest & 3) * 64; kbase = seq * 256; nt0 = 4; nt1 = 0; }
  else { q0 = rest * 64; kbase = 0; nt0 = 64; nt1 = 4; }
  u16* QD = (u16*)(ws + G_QD);
  const u16* KD = (const u16*)(ws + G_KD);
  const u16* VDT = (const u16*)(ws + G_VDT);
  const u16* KCb = (const u16*)(ws + OFF_KC) + (size_t)(g > 0 ? g - 1 : 0) * 256 * 1024;
  const u16* VCb = (const u16*)(ws + OFF_VCT) + (size_t)(g > 0 ? g - 1 : 0) * 1024 * 256;
  const float lam = ((const float*)(ws + OFF_DEC))[DEC_LAM];
  const int qrow = q0 + rw * 32 + r;
  bf16x8 qf[4];
#pragma unroll
  for (int ks = 0; ks < 4; ++ks) qf[ks] = *(const bf16x8*)(QD + (size_t)qrow * 1024 + head * 128 + m * 64 + ks * 16 + h * 8);
  f32x16 O[4];
#pragma unroll
  for (int d = 0; d < 4; ++d)
#pragma unroll
    for (int e = 0; e < 16; ++e) O[d][e] = 0.f;
  float mrun = -1e30f, lsum = 0.f;
  const int ntiles = nt0 + nt1;
  constexpr int ASTG = 64 * LDK + 128 * LDV;
  const u16* sKw = sK + r * LDK + m * 64 + h * 8;
  const u16* sVw = sV + r * LDV + 8 * h;
  const int krow_l = tid >> 4;
  const int krow_p = (krow_l & 3) | ((krow_l & 4) << 1) | ((krow_l & 8) >> 1);
  u16* wK = sK + krow_p * LDK + (tid & 15) * 8;
  u16* wV = sV + (tid >> 3) * LDV + (tid & 7) * 8;
  u32x4 rk[4], rv[4];
#define ATTN_LOAD(T)                                                                                                   \
  {                                                                                                                    \
    const u16* kp; const u16* vp; int ldv;                                                                             \
    if ((T) < nt0) { kp = KD + (size_t)(kbase + (T) * 64) * 1024 + head * 128; vp = VDT + (size_t)(head * 128) * TG + kbase + (T) * 64; ldv = TG; } \
    else { const int t2 = (T) - nt0; kp = KCb + (size_t)(t2 * 64) * 1024 + head * 128; vp = VCb + (size_t)(head * 128) * 256 + t2 * 64; ldv = 256; } \
    _Pragma("unroll") for (int q = 0; q < 4; ++q) {                                                                    \
      rk[q] = *(const u32x4*)(kp + (size_t)((tid >> 4) + 16 * q) * 1024 + (tid & 15) * 8);                             \
      rv[q] = *(const u32x4*)(vp + (size_t)((tid >> 3) + 32 * q) * ldv + (tid & 7) * 8);                               \
    }                                                                                                                  \
  }
#define ATTN_STORE(STAGE)                                                                                              \
  {                                                                                                                    \
    _Pragma("unroll") for (int q = 0; q < 4; ++q) {                                                                    \
      *(u32x4*)(wK + (STAGE) * ASTG + 16 * q * LDK) = rk[q];                                                           \
      *(u32x4*)(wV + (STAGE) * ASTG + 32 * q * LDV) = rv[q];                                                           \
    }                                                                                                                  \
  }
  ATTN_LOAD(0)
  __syncthreads();
  ATTN_STORE(0)
  __syncthreads();
  if (ntiles > 1) ATTN_LOAD(1)
  for (int t = 0; t < ntiles; ++t) {
    const int cur = t & 1;
    const u16* sKc = sKw + cur * ASTG;
    const u16* sVc = sVw + cur * ASTG;
    bf16x8 ka[2][4];
#pragma unroll
    for (int kb = 0; kb < 2; ++kb)
#pragma unroll
      for (int ks = 0; ks < 4; ++ks) ka[kb][ks] = *(const bf16x8*)(sKc + kb * 32 * LDK + ks * 16);
    __builtin_amdgcn_sched_barrier(0);
    f32x16 st[2];
#pragma unroll
    for (int e = 0; e < 16; ++e) { st[0][e] = 0.f; st[1][e] = 0.f; }
#pragma unroll
    for (int ks = 0; ks < 4; ++ks) {
      st[0] = MFMA(ka[0][ks], qf[ks], st[0]);
      st[1] = MFMA(ka[1][ks], qf[ks], st[1]);
    }
    bf16x8 va[2][4];
#define ATTN_LOADV(BUF, GI)                                                                       \
  {                                                                                               \
    _Pragma("unroll") for (int d = 0; d < 4; ++d) {                                               \
      va[BUF][d] = *(const bf16x8*)(sVc + d * 32 * LDV + (GI) * 16);                              \
    }                                                                                             \
  }
    ATTN_LOADV(0, 0)
    __builtin_amdgcn_sched_barrier(0);
    float mx = fmaxf(st[0][0], st[1][0]);
#pragma unroll
    for (int e = 1; e < 16; ++e) mx = fmaxf(mx, fmaxf(st[0][e], st[1][e]));
    mx = fmaxf(mx, __shfl_xor(mx, 32, 64));
    const float mold = mrun;
    const float mnew = fmaxf(mold, mx);
    mrun = mnew;
    float rs = 0.f;
#pragma unroll
    for (int kb = 0; kb < 2; ++kb)
#pragma unroll
      for (int e = 0; e < 16; ++e) { const float pv = __builtin_amdgcn_exp2f(st[kb][e] - mnew); st[kb][e] = pv; rs += pv; }
    rs += __shfl_xor(rs, 32, 64);
    if (__any(mnew > mold)) {
      const float alpha = __builtin_amdgcn_exp2f(mold - mnew);
      lsum *= alpha;
#pragma unroll
      for (int d = 0; d < 4; ++d)
#pragma unroll
        for (int e = 0; e < 16; ++e) O[d][e] *= alpha;
    }
    lsum += rs;
    union { bf16x8 v; unsigned u[4]; } pf[4];
#pragma unroll
    for (int gi = 0; gi < 4; ++gi) {
      const int kb = gi >> 1, s2 = gi & 1;
      pf[gi].u[0] = pack2(st[kb][8 * s2 + 0], st[kb][8 * s2 + 1]);
      pf[gi].u[1] = pack2(st[kb][8 * s2 + 2], st[kb][8 * s2 + 3]);
      pf[gi].u[2] = pack2(st[kb][8 * s2 + 4], st[kb][8 * s2 + 5]);
      pf[gi].u[3] = pack2(st[kb][8 * s2 + 6], st[kb][8 * s2 + 7]);
    }
    __builtin_amdgcn_sched_barrier(0);
#pragma unroll
    for (int gi = 0; gi < 4; ++gi) {
      if (gi < 3) ATTN_LOADV((gi + 1) & 1, gi + 1)
      __builtin_amdgcn_sched_barrier(0);
#pragma unroll
      for (int d = 0; d < 4; ++d) O[d] = MFMA(va[gi & 1][d], pf[gi].v, O[d]);
      __builtin_amdgcn_sched_barrier(0);
    }
#undef ATTN_LOADV
    if (t + 1 < ntiles) ATTN_STORE(cur ^ 1)
    __syncthreads();
    if (t + 2 < ntiles) ATTN_LOAD(t + 2)
  }
#undef ATTN_LOAD
#undef ATTN_STORE
  __syncthreads();
  float* crow_p = cmb + (rw * 32 + r) * LDC + 4 * h;
  if (m == 1) {
    const float sc = lam / lsum;
#pragma unroll
    for (int d = 0; d < 4; ++d)
#pragma unroll
      for (int rg = 0; rg < 4; ++rg) {
        float4 v; v.x = O[d][rg * 4 + 0] * sc; v.y = O[d][rg * 4 + 1] * sc; v.z = O[d][rg * 4 + 2] * sc; v.w = O[d][rg * 4 + 3] * sc;
        *(float4*)(crow_p + d * 32 + 8 * rg) = v;
      }
  }
  __syncthreads();
  if (m == 0) {
    const float i0 = 1.f / lsum;
    float ss = 0.f;
#pragma unroll
    for (int d = 0; d < 4; ++d)
#pragma unroll
      for (int rg = 0; rg < 4; ++rg) {
        const float4 c = *(const float4*)(crow_p + d * 32 + 8 * rg);
        const float o0 = O[d][rg * 4 + 0] * i0 - c.x, o1 = O[d][rg * 4 + 1] * i0 - c.y, o2 = O[d][rg * 4 + 2] * i0 - c.z, o3 = O[d][rg * 4 + 3] * i0 - c.w;
        O[d][rg * 4 + 0] = o0; O[d][rg * 4 + 1] = o1; O[d][rg * 4 + 2] = o2; O[d][rg * 4 + 3] = o3;
        ss += o0 * o0 + o1 * o1 + o2 * o2 + o3 * o3;
      }
    ss += __shfl_xor(ss, 32, 64);
    const float rstd = rsqrtf(ss * (1.f / 128.f) + 1e-6f) * 0.8f;
#pragma unroll
    for (int d = 0; d < 4; ++d)
#pragma unroll
      for (int rg = 0; rg < 4; ++rg) {
        const int e0 = d * 32 + 8 * rg + 4 * h;
        const float4 gg = *(const float4*)(p.subln_g + e0);
        u32x2 v;
        v.x = pack2(O[d][rg * 4 + 0] * rstd * gg.x, O[d][rg * 4 + 1] * rstd * gg.y);
        v.y = pack2(O[d][rg * 4 + 2] * rstd * gg.z, O[d][rg * 4 + 3] * rstd * gg.w);
        *(u32x2*)((dummy ? (u16*)(ws + G_SP) : QD) + (size_t)qrow * 1024 + head * 128 + e0) = v;
      }
  }
}

DI void step_mix3(const Params& p, int g, char* smem) {
  TILE_COORDS
  char* ws = glaunder(p.ws);
  u16* sA = (u16*)smem; u16* sB = sA + 128 * LDT;
  const float* DEC = (const float*)(ws + OFF_DEC);
  for (int t = lbid(); t < 512 + 512 + 128; t += lgdim()) {
    if (t < 512) {
#if PROBE_M3
      attn_item(p, g, t, smem, true);
#endif
      attn_item(p, g, t, smem); continue; }
    f32x16 acc[2][2];
    zero_acc(acc);
    const int rowb = wm * 64 + 4 * h;
    if (t < 1024) {
      const int tt = t - 512;
      const int chunk = tt >> 4, hh = (tt >> 2) & 3, dir = (tt >> 1) & 1, mt = tt & 1;
      const u16* A = (const u16*)(ws + G_VRT) + (size_t)(hh * 256 + mt * 128) * TG + chunk * 128;
      const u16* Bt = (const u16*)(ws + (dir ? G_KRTB : G_KRTF)) + (size_t)(hh * 128) * TG + chunk * 128;
      gemm_accum(acc, A, TG, Bt, TG, 128, sA, sB, 0);
#pragma unroll
      for (int j = 0; j < 2; ++j) {
        float* kv = launder((float*)(ws + G_KV) + (size_t)((chunk * 4 + hh) * 2 + dir) * 32768 + (size_t)(mt * 128 + rowb) * 128 + COL_L(j, 0));
#pragma unroll
        for (int i = 0; i < 2; ++i)
#pragma unroll
          for (int reg = 0; reg < 16; ++reg) kv[ROFF(i, reg) * 128] = acc[i][j][reg];
        SCHED_FENCE();
      }
    } else {
      const int tt = t - 1024;
      const int chunk = tt >> 2, hh = tt & 3;
      const u16* A = (const u16*)(ws + G_QR) + (size_t)(chunk * 128) * 512 + hh * 128;
      const u16* Bt = (const u16*)(ws + G_KR) + (size_t)(chunk * 128) * 512 + hh * 128;
      gemm_accum(acc, A, 512, Bt, 512, 128, sA, sB, 0);
      const float lgf = DEC[DEC_LGF + hh], lgb = DEC[DEC_LGB + hh];
      int rbl = rowb;
      asm volatile("" : "+v"(rbl));
#pragma unroll
      for (int j = 0; j < 2; ++j) {
        const int cj = COL_L(j, 0);
        u16* sc = launder((u16*)(ws + G_SC) + (size_t)(chunk * 4 + hh) * 16384 + rowb * 128 + cj);
#pragma unroll
        for (int i = 0; i < 2; ++i)
#pragma unroll
          for (int reg = 0; reg < 16; ++reg) {
            const int ri = rbl + ROFF(i, reg);
            const float dd = (float)(ri - cj);
            const float dec = cj <= ri ? __expf(lgf * dd) : __expf(-lgb * dd);
            sc[ROFF(i, reg) * 128] = f2bf(acc[i][j][reg] * dec);
          }
        SCHED_FENCE();
      }
    }
  }
}

template <int NCH> DI void scan_body(const Params& p, int g, char* ws) {
  const float* DEC = (const float*)(ws + OFF_DEC);
  const float* KV = (const float*)(ws + G_KV);
  u16* SP = (u16*)(ws + G_SP);
  const int nseq = (4096 / 128) / NCH;
  const int total = nseq * 262144;
  for (int e = lbid() * 256 + ltid(); e < total; e += lgdim() * 256) {
    const int idx = e & 32767, hd = (e >> 15) & 7, hh = hd >> 1, dir = hd & 1, seq = e >> 18;
    const int dv = idx >> 7, dk = idx & 127;
    float s = 0.f;
    if (g > 0) s = (dir ? p.state_b : p.state_f)[(size_t)((g - 1) * 4 + hh) * 32768 + dk * 256 + dv];
    const float gc = DEC[(dir ? DEC_GCB : DEC_GCF) + hh];
    const int c0 = seq * NCH;
    const size_t ob = (size_t)(((dir ? c0 + NCH - 1 : c0) * 4 + hh) * 2 + dir) * 32768 + idx;
    const ptrdiff_t stp = (ptrdiff_t)(dir ? -1 : 1) * (4 * 2 * 32768);
    float kvv[NCH];
#pragma unroll
    for (int n = 0; n < NCH; ++n) kvv[n] = KV[ob + n * stp];
#pragma unroll
    for (int n = 0; n < NCH; ++n) {
      SP[ob + n * stp] = f2bf(s);
      s = gc * s + kvv[n];
    }
    if (g == 0) (p.out + (dir ? OUT_RB : OUT_RF))[(size_t)(seq * 4 + hh) * 32768 + dk * 256 + dv] = s;
  }
}
DI void step_scan(const Params& p, int g) {
  char* ws = glaunder(p.ws);
  if (g == 0) scan_body<2>(p, g, ws); else scan_body<32>(p, g, ws);
}

DI void step_retout(const Params& p, char* smem) {
  TILE_COORDS
  char* ws = glaunder(p.ws);
  u16* sA = (u16*)smem; u16* sB = sA + 128 * LDT;
  for (int t = lbid(); t < 512; t += lgdim()) {
    const int chunk = t >> 4, hh = (t >> 2) & 3, nt = t & 3;
    f32x16 acc[2][1];
    zero_acc1(acc);
    gemm_accum_t<1>(acc, (const u16*)(ws + G_SC) + (size_t)(chunk * 4 + hh) * 16384, 128,
                    (const u16*)(ws + G_VRT) + (size_t)(hh * 256 + nt * 64) * TG + chunk * 128, TG, 128, sA, sB, 0);
    gemm_accum_t<1>(acc, (const u16*)(ws + G_QA) + (size_t)(chunk * 128) * 512 + hh * 128, 512,
                    (const u16*)(ws + G_SP) + (size_t)((chunk * 4 + hh) * 2 + 0) * 32768 + (size_t)nt * 64 * 128, 128, 128, sA, sB, 0);
    gemm_accum_t<1>(acc, (const u16*)(ws + G_QB) + (size_t)(chunk * 128) * 512 + hh * 128, 512,
                    (const u16*)(ws + G_SP) + (size_t)((chunk * 4 + hh) * 2 + 1) * 32768 + (size_t)nt * 64 * 128, 128, 128, sA, sB, 0);
    const int rowb = chunk * 128 + wm * 64 + 4 * h;
    float* op = launder((float*)(ws + G_KV) + (size_t)rowb * 1024 + hh * 256 + nt * 64 + wn * 32 + r);
#pragma unroll
    for (int i = 0; i < 2; ++i)
#pragma unroll
      for (int reg = 0; reg < 16; ++reg) op[ROFF(i, reg) * 1024] = acc[i][0][reg];
  }
}

DI void step_gn(const Params& p) {
  const int lane = ltid() & 63, wave = ltid() >> 6;
  const float* OPRE = (const float*)(p.ws + G_KV);
  u16* GR = (u16*)(p.ws + G_GR);
  for (int it = lbid() * 4 + wave; it < TG * 4; it += lgdim() * 4) {
    const int tok = it >> 2, hh = it & 3;
    const size_t o = (size_t)tok * 1024 + hh * 256 + lane * 4;
    const float4 v = *(const float4*)(OPRE + o);
    const float mu = wave_sum(v.x + v.y + v.z + v.w) * (1.f / 256.f);
    const float d0 = v.x - mu, d1 = v.y - mu, d2 = v.z - mu, d3 = v.w - mu;
    const float var = wave_sum(d0 * d0 + d1 * d1 + d2 * d2 + d3 * d3) * (1.f / 256.f);
    const float rstd = rsqrtf(var + 1e-5f);
    const float4 gg = *(const float4*)(p.gn_g + hh * 256 + lane * 4);
    const u32x2 gr = *(const u32x2*)(GR + o);
    u32x2 w;
    w.x = pack2(d0 * rstd * gg.x * bf2f((u16)(gr.x & 0xffff)), d1 * rstd * gg.y * bf2f((u16)(gr.x >> 16)));
    w.y = pack2(d2 * rstd * gg.z * bf2f((u16)(gr.y & 0xffff)), d3 * rstd * gg.w * bf2f((u16)(gr.y >> 16)));
    *(u32x2*)(GR + o) = w;
  }
}

DI void step_branch(const Params& p, char* smem) {
  TILE_COORDS
  char* ws = glaunder(p.ws);
  u16* sA = (u16*)smem; u16* sB = sA + 128 * LDT;
  for (int t = lbid(); t < 512; t += lgdim()) {
    const int ntile = t >> 5, mt = t & 31;
    const int m0 = mt * 128, n0 = ntile * 64;
    const int rowb = m0 + wm * 64 + 4 * h;
    const int col = n0 + wn * 32 + r;
    f32x16 acc[2][1];
    zero_acc1(acc);
    gemm_accum_t<1>(acc, (const u16*)(ws + G_GR) + (size_t)m0 * 1024, 1024, (const u16*)(ws + OFF_WR) + (size_t)n0 * 1024, 1024, 1024, sA, sB, 0);
    {
      const u16* gt = launder((const u16*)(ws + G_GATES) + (size_t)rowb * 2048 + col);
      float* tmp = launder((float*)(ws + G_KV) + (size_t)rowb * 1024 + col);
#pragma unroll
      for (int i = 0; i < 2; ++i)
#pragma unroll
        for (int reg = 0; reg < 16; ++reg) tmp[ROFF(i, reg) * 1024] = acc[i][0][reg] * bf2f(gt[ROFF(i, reg) * 2048]);
      SCHED_FENCE();
    }
    zero_acc1(acc);
    gemm_accum_t<1>(acc, (const u16*)(ws + G_QD) + (size_t)m0 * 1024, 1024, (const u16*)(ws + OFF_WD) + (size_t)n0 * 1024, 1024, 1024, sA, sB, 0);
    {
      const u16* gt = launder((const u16*)(ws + G_GATES) + (size_t)rowb * 2048 + 1024 + col);
      const float* tmp = launder((const float*)(ws + G_KV) + (size_t)rowb * 1024 + col);
      u16* mix = launder((u16*)(ws + G_MIX) + (size_t)rowb * 1024 + col);
#pragma unroll
      for (int i = 0; i < 2; ++i)
#pragma unroll
        for (int reg = 0; reg < 16; ++reg)
          mix[ROFF(i, reg) * 1024] = f2bf(tmp[ROFF(i, reg) * 1024] + acc[i][0][reg] * bf2f(gt[ROFF(i, reg) * 2048]));
      SCHED_FENCE();
    }
  }
}

DI void step_wo(const Params& p, int g, char* smem) {
  TILE_COORDS
  char* ws = glaunder(p.ws);
  u16* sA = (u16*)smem; u16* sB = sA + 128 * LDT;
  const float* gate1 = (const float*)(ws + OFF_MOD) + g * 6144 + 2048;
  for (int t = lbid(); t < 512; t += lgdim()) {
    const int ntile = t >> 5, mt = t & 31;
    const int m0 = mt * 128, n0 = ntile * 64;
    f32x16 acc[2][1];
    zero_acc1(acc);
    gemm_accum_t<1>(acc, (const u16*)(ws + G_MIX) + (size_t)m0 * 1024, 1024, (const u16*)(ws + OFF_WO) + (size_t)n0 * 1024, 1024, 1024, sA, sB, 0);
    const int rowb = g * TG + m0 + wm * 64 + 4 * h;
    const int col = n0 + wn * 32 + r;
    const float g1 = gate1[col];
    const float* xs = launder(xrow(p, rowb) + col);
    float* o = launder(p.out + OUT_Y + (size_t)rowb * D + col);
#pragma unroll
    for (int i = 0; i < 2; ++i)
#pragma unroll
      for (int reg = 0; reg < 16; ++reg) o[ROFF(i, reg) * D] = xs[ROFF(i, reg) * D] + g1 * acc[i][0][reg];
  }
}

DI void step_ffn_up(const Params& p, char* smem) {
  TILE_COORDS
  char* ws = glaunder(p.ws);
  u16* sA = (u16*)smem; u16* sB = sA + 128 * LDT;
  for (int t = lbid(); t < 80 * 44; t += lgdim()) {
    const int ntile = t / 80, mt = t % 80;
    const int m0 = mt * 256, n0 = ntile * 128;
    f32x16 acc[4][2];
    zero_acc4(acc);
    gemm_accum_256(acc, (const u16*)(ws + OFF_HB) + (size_t)m0 * 1024, 1024, 64, 128 * 1024, (const u16*)(ws + OFF_WGU) + (size_t)n0 * 1024, 1024, 64, 1024, sA, 0);
    const int rowb = m0 + wm * 128 + 4 * h;
    u16* act = launder((u16*)(ws + OFF_ACT) + (size_t)rowb * FF + ntile * 64 + 32 * wn + r);
#pragma unroll
    for (int i = 0; i < 4; ++i) {
#pragma unroll
      for (int reg = 0; reg < 16; ++reg) act[ROFF(i, reg) * FF] = f2bf(silu_f(acc[i][0][reg]) * acc[i][1][reg]);
      SCHED_FENCE();
    }
  }
}

DI void step_ffn_down(const Params& p, char* smem) {
  TILE_COORDS
  char* ws = glaunder(p.ws);
  u16* sA = (u16*)smem; u16* sB = sA + 128 * LDT;
  const float* MOD = (const float*)(ws + OFF_MOD);
  for (int t = lbid(); t < 160 * 8; t += lgdim()) {
    const int ntile = t / 160, mt = t % 160;
    const int m0 = mt * 128, n0 = ntile * 128;
    f32x16 acc[2][2];
    zero_acc(acc);
    gemm_accum(acc, (const u16*)(ws + OFF_ACT) + (size_t)m0 * FF, FF, (const u16*)(ws + OFF_WDN) + (size_t)n0 * FF, FF, FF, sA, sB, 0);
    const int mv = m0 < TG ? 0 : 1 + ((m0 - TG) >> 12);
    const float* gate2 = MOD + mv * 6144 + 5120;
    const int rowb = m0 + wm * 64 + 4 * h;
#pragma unroll
    for (int j = 0; j < 2; ++j) {
      const int col = n0 + COL_L(j, 0);
      const float g2 = gate2[col];
      float* o = launder(p.out + OUT_Y + (size_t)rowb * D + col);
#pragma unroll
      for (int i = 0; i < 2; ++i)
#pragma unroll
        for (int reg = 0; reg < 16; ++reg) o[ROFF(i, reg) * D] = o[ROFF(i, reg) * D] + g2 * acc[i][j][reg];
      SCHED_FENCE();
    }
  }
}


#define XB_TMO      128
#define XB_XCNT(j)  (256  + 64 * (j))
#define XB_XSUB(j)  (1280 + 64 * (j))
#define XB_XGEN(j)  (2304 + 64 * (j))
#define XB_TOP      3328
#define XB_TOPGEN   3392
#define XCD_BAR_WORDS 3456
#define XB_SPIN_CAP (1u << 22)
#define LAS __attribute__((address_space(3)))
DI unsigned xb_ld(unsigned* p)              { return __hip_atomic_load(p, __ATOMIC_RELAXED, __HIP_MEMORY_SCOPE_AGENT); }
DI unsigned xb_add(unsigned* p, unsigned v) { return __hip_atomic_fetch_add(p, v, __ATOMIC_RELAXED, __HIP_MEMORY_SCOPE_AGENT); }
DI unsigned xb_xcc_id() { return (unsigned)__builtin_amdgcn_s_getreg((3 << 11) | 20) & 0xFu; }
#define XB_SPIN(cond, bar) do { unsigned _sp = 0; while (cond) { __builtin_amdgcn_s_sleep(1); \
    if ((++_sp & 255u) == 0u) { if (xb_ld(&(bar)[XB_TMO])) break; if (_sp > XB_SPIN_CAP) { atomicAdd(&(bar)[XB_TMO], 1u); break; } } } } while (0)
struct XcdBarrier { unsigned* bar; unsigned x; volatile LAS unsigned* st; };
DI XcdBarrier xcd_barrier_post(unsigned* bar, volatile LAS unsigned* st) {
  XcdBarrier b; b.bar = bar; b.x = xb_xcc_id(); b.st = st;
  if (threadIdx.x == 0) (void)xb_add(&bar[XB_XCNT(b.x)], 1u);
  return b;
}
DI void xcd_barrier_complete(unsigned* bar, unsigned x, unsigned& nloc, unsigned& nx) {
  const unsigned G = gridDim.x * gridDim.y * gridDim.z;
  unsigned sum, cnt, mine, sp = 0u;
  for (;;) {
    sum = 0u; cnt = 0u; mine = 0u;
#pragma unroll
    for (unsigned j = 0; j < 16; ++j) { const unsigned c = xb_ld(&bar[XB_XCNT(j)]); sum += c; cnt += (c > 0u) ? 1u : 0u; mine = (j == x) ? c : mine; }
    if (sum == G) break;
    __builtin_amdgcn_s_sleep(1);
    if ((++sp & 255u) == 0u) { if (xb_ld(&bar[XB_TMO])) break; if (sp > XB_SPIN_CAP) { atomicAdd(&bar[XB_TMO], 1u); break; } }
  }
  nloc = mine > 0u ? mine : 1u; nx = cnt > 0u ? cnt : 1u;
}
DI void xcd_barrier(const XcdBarrier& b) {
  asm volatile("s_waitcnt vmcnt(0)" ::: "memory");
  __syncthreads();
  if (threadIdx.x == 0) {
    unsigned* bar = b.bar;
    __builtin_amdgcn_s_waitcnt(0);
    unsigned nloc = b.st[0], nx = b.st[1];
    if (nloc == 0u) { xcd_barrier_complete(bar, b.x, nloc, nx); b.st[0] = nloc; b.st[1] = nx; }
    const unsigned old = xb_add(&bar[XB_XSUB(b.x)], 1u);
    const unsigned gen = old / nloc;
    if (old + 1u == (gen + 1u) * nloc) {
      __builtin_amdgcn_fence(__ATOMIC_RELEASE, "agent");
      asm volatile("s_waitcnt vmcnt(0)" ::: "memory");
      const unsigned og = xb_add(&bar[XB_TOP], 1u);
      const unsigned tg = og / nx;
      if (og + 1u == (tg + 1u) * nx) xb_add(&bar[XB_TOPGEN], 1u);
      else XB_SPIN(xb_ld(&bar[XB_TOPGEN]) == tg, bar);
      __builtin_amdgcn_fence(__ATOMIC_ACQUIRE, "agent");
      xb_add(&bar[XB_XGEN(b.x)], 1u);
      asm volatile("s_waitcnt vmcnt(0)" ::: "memory");
    } else {
      XB_SPIN(xb_ld(&bar[XB_XGEN(b.x)]) == gen, bar);
      __builtin_amdgcn_fence(__ATOMIC_ACQUIRE, "agent");
      asm volatile("s_waitcnt vmcnt(0)" ::: "memory");
    }
  }
  __syncthreads();
}

constexpr int NSTEPS = 37;

__global__ void __launch_bounds__(256, 2) mega(Params p, int lo, int hi) {
  __shared__ __attribute__((aligned(16))) char smem[SMEM_BYTES];
  __shared__ uint4 xb_words;
  cg::grid_group grid = cg::this_grid();
  if (lo > hi) grid.sync();
  if (threadIdx.x == 0) xb_words = make_uint4(0u, 0u, 0u, 0u);
  __syncthreads();
  XcdBarrier xb = xcd_barrier_post((unsigned*)(p.ws + OFF_BAR), (volatile LAS unsigned*)&xb_words);
  for (int step = lo; step < hi; ++step) {
    if (step == 0) { step_p0(p, smem); if (PROBE_M1) step_p0(p, smem); }
    else if (step == 1) { step_rownorm(p, 0); if (PROBE_M1) step_rownorm(p, 0); }
    else if (step == 2) step_proj(p, 0, smem);
    else if (step < 33) {
      const int g = (step - 3) / 6, s = (step - 3) % 6;
      if (s == 0) step_mix3(p, g, smem);
      else if (s == 1) { step_scan(p, g); if (PROBE_M1) step_scan(p, g); }
      else if (s == 2) { step_retout(p, smem); if (PROBE_M2) step_retout(p, smem); }
      else if (s == 3) step_gn(p);
      else if (s == 4) { step_branch(p, smem); if (PROBE_M2) step_branch(p, smem); }
      else { step_wo(p, g, smem); if (g < 4) step_proj(p, g + 1, smem); }
    } else if (step == 33) { step_rownorm(p, 1); if (PROBE_M1) step_rownorm(p, 1); }
    else if (step == 34) step_ffn_up(p, smem);
    else if (step == 35) step_ffn_down(p, smem);
    else step_rownorm(p, 2);
    if (step + 1 < hi) xcd_barrier(xb);
  }
}

extern "C" void kernel_launch(void* const* d_in, const int* in_sizes, int n_in, void* d_out, int out_size, void* d_ws, size_t ws_size, hipStream_t stream) {
  static int grid_blocks = 0;
  if (!grid_blocks) {
    int dev = 0, cus = 0, per_cu = 0;
    hipGetDevice(&dev);
    hipDeviceGetAttribute(&cus, hipDeviceAttributeMultiprocessorCount, dev);
    hipOccupancyMaxActiveBlocksPerMultiprocessor(&per_cu, mega, 256, 0);
    if (per_cu < 1) per_cu = 1;
    if (per_cu > 2) per_cu = 2;
    grid_blocks = cus * per_cu;
  }
  Params p{};
  const float** f = (const float**)&p;
  for (int i = 0; i < 29; ++i) f[i] = (const float*)d_in[i];
  p.out = (float*)d_out;
  p.ws = (char*)d_ws;
  hipMemsetAsync((char*)d_ws + OFF_BAR, 0, XCD_BAR_WORDS * 4, stream);
#if COOP
  int lo = 0, hi = NSTEPS;
  void* args[] = {&p, &lo, &hi};
  hipError_t e = hipLaunchCooperativeKernel((void*)mega, dim3(grid_blocks), dim3(256), args, 0, stream);
  if (e != hipSuccess) fprintf(stderr, "cooperative launch failed: %s (grid %d)\n", hipGetErrorString(e), grid_blocks);
#else
  for (int s = 0; s < NSTEPS; ++s) hipLaunchKernelGGL(mega, dim3(grid_blocks), dim3(256), 0, stream, p, s, s + 1);
#endif
}
```

```cpp
#include <hip/hip_runtime.h>
#include <hip/hip_cooperative_groups.h>
#include <cstdio>
namespace cg = cooperative_groups;

#ifndef PROBE_M1
#define PROBE_M1 0
#endif
#ifndef PROBE_M2
#define PROBE_M2 0
#endif
#ifndef PROBE_M3
#define PROBE_M3 0
#endif
#ifndef COOP
#define COOP 1
#endif

#define DI __device__ __forceinline__
typedef unsigned short u16;
typedef __attribute__((ext_vector_type(8))) short bf16x8;
typedef __attribute__((ext_vector_type(4))) short s16x4;
typedef __attribute__((ext_vector_type(16))) float f32x16;
typedef __attribute__((ext_vector_type(4))) unsigned u32x4;
typedef __attribute__((ext_vector_type(2))) unsigned u32x2;
#define SCHED_FENCE() asm volatile("" ::: "memory")
#define MFMA(a, b, c) __builtin_amdgcn_mfma_f32_32x32x16_bf16((a), (b), (c), 0, 0, 0)

constexpr int D = 1024;
constexpr int TG = 4096;
constexpr int NG = 5;
constexpr int TT = TG * NG;
constexpr int FF = 2816;
constexpr int WCOLS = 8192;

constexpr size_t OFF_WIN = 0;
constexpr size_t OFF_WR = OFF_WIN + (size_t)8192 * 1024 * 2;
constexpr size_t OFF_WD = OFF_WR + 2097152;
constexpr size_t OFF_WO = OFF_WD + 2097152;
constexpr size_t OFF_WGU = OFF_WO + 2097152;
constexpr size_t OFF_WDN = OFF_WGU + (size_t)5632 * 1024 * 2;
constexpr size_t OFF_MOD = OFF_WDN + (size_t)1024 * 2816 * 2;
constexpr size_t OFF_COSR = OFF_MOD + 122880;
constexpr size_t OFF_SINR = OFF_COSR + 1048576;
constexpr size_t OFF_COSD = OFF_SINR + 1048576;
constexpr size_t OFF_SIND = OFF_COSD + 524288;
constexpr size_t OFF_DEC = OFF_SIND + 524288;
constexpr size_t OFF_KC = OFF_DEC + 16384;
constexpr size_t OFF_VCT = OFF_KC + 2097152;
constexpr size_t OFF_HB = OFF_VCT + 2097152;
constexpr size_t OFF_G = OFF_HB + (size_t)TT * 1024 * 2;
constexpr size_t G_QR = OFF_G;
constexpr size_t G_QA = G_QR + 4194304;
constexpr size_t G_QB = G_QA + 4194304;
constexpr size_t G_KR = G_QB + 4194304;
constexpr size_t G_KRTF = G_KR + 4194304;
constexpr size_t G_KRTB = G_KRTF + 4194304;
constexpr size_t G_VRT = G_KRTB + 4194304;
constexpr size_t G_GR = G_VRT + 8388608;
constexpr size_t G_QD = G_GR + 8388608;
constexpr size_t G_KD = G_QD + 8388608;
constexpr size_t G_VDT = G_KD + 8388608;
constexpr size_t G_GATES = G_VDT + 8388608;
constexpr size_t G_KV = G_GATES + 16777216;
constexpr size_t G_SP = G_KV + 33554432;
constexpr size_t G_SC = G_SP + 16777216;
constexpr size_t G_MIX = G_SC + 4194304;
constexpr size_t G_END = G_MIX + 8388608;
constexpr size_t OFF_BAR = G_END;
constexpr size_t OFF_ACT = OFF_G;
static_assert((size_t)TT * FF * 2 <= G_END - OFF_G, "ACT alias");
static_assert(G_END + 16384 <= (size_t)256 * 1024 * 1024, "ws");

constexpr int DEC_WQF = 0, DEC_WQB = 512, DEC_WKF = 1024, DEC_WKB = 1536, DEC_LGF = 2048, DEC_LGB = 2052, DEC_GCF = 2056, DEC_GCB = 2060, DEC_LAM = 2064;

constexpr size_t OUT_Y = 0;
constexpr size_t OUT_RF = (size_t)TT * 1024;
constexpr size_t OUT_RB = OUT_RF + 2097152;
constexpr size_t OUT_DK = OUT_RB + 2097152;
constexpr size_t OUT_DV = OUT_DK + 4194304;

struct Params {
  const float *x_prompt, *x_sample, *state_f, *state_b, *cache_k, *cache_v, *c, *c_ctx, *norm1_g, *norm2_g, *w_ada, *b_ada, *w_in, *b_gate,
      *decay_f, *decay_b, *gn_g, *w_ret_out, *lq1, *lk1, *lq2, *lk2, *subln_g, *w_diff_out, *w_o, *w_gate, *w_up, *w_down, *final_g;
  float* out;
  char* ws;
};

DI int ltid() { int t = threadIdx.x; asm volatile("" : "+v"(t)); return t; }
DI char* glaunder(char* p) { __attribute__((address_space(1))) char* g = (__attribute__((address_space(1))) char*)p; asm volatile("" : "+s"(g)); return (char*)g; }
DI int lbid() { int b = blockIdx.x; asm volatile("" : "+s"(b)); return b; }
DI int lgdim() { int b = gridDim.x; asm volatile("" : "+s"(b)); return b; }
typedef __bf16 hbf16x2 __attribute__((ext_vector_type(2)));
typedef float f32x2 __attribute__((ext_vector_type(2)));
DI u16 f2bf(float x) { return __builtin_bit_cast(u16, (__bf16)x); }
DI float bf2f(u16 v) { return __uint_as_float(((unsigned)v) << 16); }
DI unsigned pack2(float a, float b) { f32x2 v = {a, b}; return __builtin_bit_cast(unsigned, __builtin_convertvector(v, hbf16x2)); }
DI float silu_f(float x) { return x * __builtin_amdgcn_rcpf(1.f + __expf(-x)); }
DI float sigmoid_f(float x) { return __builtin_amdgcn_rcpf(1.f + __expf(-x)); }
DI float wave_sum(float v) {
#pragma unroll
  for (int o = 32; o > 0; o >>= 1) v += __shfl_xor(v, o, 64);
  return v;
}
DI const float* xrow(const Params& p, int row) { return row < TG ? p.x_prompt + (size_t)row * D : p.x_sample + (size_t)(row - TG) * D; }

constexpr int LDT = 72;
constexpr int SMEM_BYTES = 2 * 2 * 128 * LDT * 2;
constexpr int SMEM_OLD_UNUSED = 0;

template <int NJ>
DI void gemm_accum_t(f32x16 (&acc)[2][NJ], const u16* A, int lda, const u16* Bt, int ldb, int K, u16* sA, u16* sB, int cbmode) {
  constexpr int STG = 2 * 128 * LDT;
  constexpr int NB = 2 * NJ;
  const int tid = ltid(), lane = tid & 63, wave = tid >> 6, wm = wave >> 1, wn = wave & 1, r = lane & 31, h = lane >> 5;
  const int lrow = tid >> 3, lcol = (tid & 7) * 8;
  const u16* ap = A + (size_t)lrow * lda + lcol;
  const u16* bp = Bt + (size_t)lrow * ldb + lcol;
  const int nk = K >> 6;
  u32x4 ra[3][4], rb[3][NB];
#define GEMM_LOAD(SET)                                                                            \
  {                                                                                               \
    _Pragma("unroll") for (int q = 0; q < 4; ++q) ra[SET][q] = *(const u32x4*)(ap + (size_t)(32 * q) * lda);  \
    _Pragma("unroll") for (int q = 0; q < NB; ++q) rb[SET][q] = *(const u32x4*)(bp + (size_t)(32 * q) * ldb); \
    ap += 64; bp += 64;                                                                           \
  }
  GEMM_LOAD(0)
  if (nk > 1) GEMM_LOAD(1)
  if (nk > 2) GEMM_LOAD(2)
  const int cb0 = NJ == 1 ? wn : (cbmode ? wn : 2 * wn), cb1 = cbmode ? wn + 2 : 2 * wn + 1;
  const u16* sa0 = sA + (wm * 64 + r) * LDT + h * 8;
  const u16* sb0 = sB + (cb0 * 32 + r) * LDT + h * 8;
  const u16* sb1 = sB + (cb1 * 32 + r) * LDT + h * 8;
  u16* wa = sA + lrow * LDT + lcol;
  u16* wb = sB + lrow * LDT + lcol;
  __syncthreads();
#pragma unroll
  for (int q = 0; q < 4; ++q) *(u32x4*)(wa + 32 * q * LDT) = ra[0][q];
#pragma unroll
  for (int q = 0; q < NB; ++q) *(u32x4*)(wb + 32 * q * LDT) = rb[0][q];
  __syncthreads();
#define GEMM_ITER(IDX, PAR, SET)                                                                  \
  {                                                                                               \
    const int kk = kt + IDX;                                                                      \
    if (kk + 3 < nk) GEMM_LOAD(SET)                                                               \
                       \
    bf16x8 fa[2][2], fb[2][2];                                                                    \
    fa[0][0] = *(const bf16x8*)(sa0 + PAR * STG);                                                 \
    fa[0][1] = *(const bf16x8*)(sa0 + PAR * STG + 32 * LDT);                                      \
    fb[0][0] = *(const bf16x8*)(sb0 + PAR * STG);                                                 \
    fb[0][1] = *(const bf16x8*)((NJ == 2 ? sb1 : sb0) + PAR * STG);                               \
    _Pragma("unroll") for (int ks = 0; ks < 4; ++ks) {                                            \
      if (ks < 3) {                                                                               \
        fa[(ks + 1) & 1][0] = *(const bf16x8*)(sa0 + PAR * STG + (ks + 1) * 16);                  \
        fa[(ks + 1) & 1][1] = *(const bf16x8*)(sa0 + PAR * STG + 32 * LDT + (ks + 1) * 16);       \
        fb[(ks + 1) & 1][0] = *(const bf16x8*)(sb0 + PAR * STG + (ks + 1) * 16);                  \
        if (NJ == 2) fb[(ks + 1) & 1][1] = *(const bf16x8*)(sb1 + PAR * STG + (ks + 1) * 16);     \
      }                                                                                           \
      __builtin_amdgcn_sched_barrier(0);                                                          \
      acc[0][0] = MFMA(fa[ks & 1][0], fb[ks & 1][0], acc[0][0]);                                  \
      acc[1][0] = MFMA(fa[ks & 1][1], fb[ks & 1][0], acc[1][0]);                                  \
      if (NJ == 2) {                                                                              \
        acc[0][NJ - 1] = MFMA(fa[ks & 1][0], fb[ks & 1][1], acc[0][NJ - 1]);                      \
        acc[1][NJ - 1] = MFMA(fa[ks & 1][1], fb[ks & 1][1], acc[1][NJ - 1]);                      \
      }                                                                                           \
      __builtin_amdgcn_sched_barrier(0);                                                          \
    }                                                                                             \
    if (kk + 1 < nk) {                                                                            \
      _Pragma("unroll") for (int q = 0; q < 4; ++q) *(u32x4*)(wa + (1 - PAR) * STG + 32 * q * LDT) = ra[(SET + 1) % 3][q];  \
      _Pragma("unroll") for (int q = 0; q < NB; ++q) *(u32x4*)(wb + (1 - PAR) * STG + 32 * q * LDT) = rb[(SET + 1) % 3][q]; \
    }                                                                                             \
    __syncthreads();                                                                              \
  }
  for (int kt = 0; kt < nk; kt += 6) {
    GEMM_ITER(0, 0, 0)
    if (kt + 1 < nk) GEMM_ITER(1, 1, 1)
    if (kt + 2 < nk) GEMM_ITER(2, 0, 2)
    if (kt + 3 < nk) GEMM_ITER(3, 1, 0)
    if (kt + 4 < nk) GEMM_ITER(4, 0, 1)
    if (kt + 5 < nk) GEMM_ITER(5, 1, 2)
  }
#undef GEMM_ITER
#undef GEMM_LOAD
}
DI void gemm_accum_256(f32x16 (&acc)[4][2], const u16* A, int a_rs, int a_ks, int a_sub, const u16* Bt, int b_rs, int b_ks, int K, u16* sA, int cbmode) {
  u16* sB = sA + 256 * LDT;
  const int tid = ltid(), lane = tid & 63, wave = tid >> 6, wm = wave >> 1, wn = wave & 1, r = lane & 31, h = lane >> 5;
  const int lrow = tid >> 3, lcol = (tid & 7) * 8;
  const u16* ap = A + (size_t)lrow * a_rs + lcol;
  const u16* bp = Bt + (size_t)lrow * b_rs + lcol;
  const int nk = K >> 6;
  u32x4 ra[8], rb[4];
#define A_OFF(q) ((size_t)((q) >> 2) * a_sub + (size_t)(32 * ((q) & 3)) * a_rs)
#pragma unroll
  for (int q = 0; q < 8; ++q) ra[q] = *(const u32x4*)(ap + A_OFF(q));
#pragma unroll
  for (int q = 0; q < 4; ++q) rb[q] = *(const u32x4*)(bp + (size_t)(32 * q) * b_rs);
  const int cb0 = cbmode ? wn : 2 * wn, cb1 = cbmode ? wn + 2 : 2 * wn + 1;
  const u16* sa0 = sA + (wm * 128 + r) * LDT + h * 8;
  const u16* sb0 = sB + (cb0 * 32 + r) * LDT + h * 8;
  const u16* sb1 = sB + (cb1 * 32 + r) * LDT + h * 8;
  u16* wa = sA + lrow * LDT + lcol;
  u16* wb = sB + lrow * LDT + lcol;
  for (int kt = 0; kt < nk; ++kt) {
    __syncthreads();
#pragma unroll
    for (int q = 0; q < 8; ++q) *(u32x4*)(wa + 32 * q * LDT) = ra[q];
#pragma unroll
    for (int q = 0; q < 4; ++q) *(u32x4*)(wb + 32 * q * LDT) = rb[q];
    __syncthreads();
    if (kt + 1 < nk) {
      ap += a_ks; bp += b_ks;
#pragma unroll
      for (int q = 0; q < 8; ++q) ra[q] = *(const u32x4*)(ap + A_OFF(q));
#pragma unroll
      for (int q = 0; q < 4; ++q) rb[q] = *(const u32x4*)(bp + (size_t)(32 * q) * b_rs);
    }
    bf16x8 fa[4], fb[2][2];
    fb[0][0] = *(const bf16x8*)(sb0);
    fb[0][1] = *(const bf16x8*)(sb1);
#pragma unroll
    for (int i = 0; i < 4; ++i) fa[i] = *(const bf16x8*)(sa0 + i * 32 * LDT);
#pragma unroll
    for (int ks = 0; ks < 4; ++ks) {
      if (ks < 3) {
        fb[(ks + 1) & 1][0] = *(const bf16x8*)(sb0 + (ks + 1) * 16);
        fb[(ks + 1) & 1][1] = *(const bf16x8*)(sb1 + (ks + 1) * 16);
      }
#pragma unroll
      for (int i = 0; i < 4; ++i) {
        __builtin_amdgcn_sched_barrier(0);
        acc[i][0] = MFMA(fa[i], fb[ks & 1][0], acc[i][0]);
        acc[i][1] = MFMA(fa[i], fb[ks & 1][1], acc[i][1]);
        __builtin_amdgcn_sched_barrier(0);
        if (ks < 3) fa[i] = *(const bf16x8*)(sa0 + i * 32 * LDT + (ks + 1) * 16);
      }
    }
  }
}
#undef A_OFF
DI void zero_acc4(f32x16 (&acc)[4][2]) {
#pragma unroll
  for (int i = 0; i < 4; ++i)
#pragma unroll
    for (int j = 0; j < 2; ++j)
#pragma unroll
      for (int e = 0; e < 16; ++e) acc[i][j][e] = 0.f;
}
DI void gemm_accum(f32x16 (&acc)[2][2], const u16* A, int lda, const u16* Bt, int ldb, int K, u16* sA, u16* sB, int cbmode) {
  gemm_accum_t<2>(acc, A, lda, Bt, ldb, K, sA, sB, cbmode);
}
DI void zero_acc1(f32x16 (&acc)[2][1]) {
#pragma unroll
  for (int i = 0; i < 2; ++i)
#pragma unroll
    for (int e = 0; e < 16; ++e) acc[i][0][e] = 0.f;
}

DI void zero_acc(f32x16 (&acc)[2][2]) {
#pragma unroll
  for (int i = 0; i < 2; ++i)
#pragma unroll
    for (int j = 0; j < 2; ++j)
#pragma unroll
      for (int e = 0; e < 16; ++e) acc[i][j][e] = 0.f;
}

#define TILE_COORDS                                                                                  \
  const int tid = ltid(), lane = tid & 63, wave = tid >> 6, wm = wave >> 1, wn = wave & 1;      \
  const int r = lane & 31, h = lane >> 5;                                                            \
  (void)r; (void)h; (void)wm; (void)wn;
#define ROW_L(i, reg) (wm * 64 + (i) * 32 + ((reg) & 3) + 8 * ((reg) >> 2) + 4 * h)
#define COL_L(j, cbmode) (((cbmode) ? (wn + 2 * (j)) : (2 * wn + (j))) * 32 + r)

DI void step_p0(const Params& p, char* smem) {
  const int tid = ltid();
  char* ws = glaunder(p.ws);
  {
    float(*tile)[65] = (float(*)[65])smem;
    constexpr int NT_ALL = 2048 + 768 + 1408 + 704 + 256;
    for (int t = lbid(); t < NT_ALL; t += lgdim()) {
      const float* src; int N; u16* dst; int dld; int mode = 0; int ntl; int tt = t;
      if (tt < 2048) { src = p.w_in; N = 8192; dst = (u16*)(ws + OFF_WIN); dld = 1024; ntl = 128; }
      else if ((tt -= 2048) < 256) { src = p.w_ret_out; N = 1024; dst = (u16*)(ws + OFF_WR); dld = 1024; ntl = 16; }
      else if ((tt -= 256) < 256) { src = p.w_diff_out; N = 1024; dst = (u16*)(ws + OFF_WD); dld = 1024; ntl = 16; }
      else if ((tt -= 256) < 256) { src = p.w_o; N = 1024; dst = (u16*)(ws + OFF_WO); dld = 1024; ntl = 16; }
      else if ((tt -= 256) < 704) { src = p.w_gate; N = FF; dst = (u16*)(ws + OFF_WGU); dld = 1024; mode = 1; ntl = 44; }
      else if ((tt -= 704) < 704) { src = p.w_up; N = FF; dst = (u16*)(ws + OFF_WGU); dld = 1024; mode = 2; ntl = 44; }
      else if ((tt -= 704) < 704) { src = p.w_down; N = 1024; dst = (u16*)(ws + OFF_WDN); dld = FF; ntl = 16; }
      else { tt -= 704; int b = tt >> 6; tt &= 63; src = p.cache_v + (size_t)b * 256 * 1024; N = 1024; dst = (u16*)(ws + OFF_VCT) + (size_t)b * 1024 * 256; dld = 256; ntl = 16; }
      const int kt = tt / ntl, nt = tt % ntl;
      __syncthreads();
#pragma unroll
      for (int q = 0; q < 4; ++q) {
        const int k = (tid >> 4) + 16 * q, n4 = (tid & 15) * 4;
        const float4 v = *(const float4*)(src + (size_t)(kt * 64 + k) * N + nt * 64 + n4);
        tile[k][n4 + 0] = v.x; tile[k][n4 + 1] = v.y; tile[k][n4 + 2] = v.z; tile[k][n4 + 3] = v.w;
      }
      __syncthreads();
#pragma unroll
      for (int q = 0; q < 2; ++q) {
        const int n = (tid >> 3) + 32 * q, k8 = (tid & 7) * 8;
        uint4 o;
        o.x = pack2(tile[k8 + 0][n], tile[k8 + 1][n]);
        o.y = pack2(tile[k8 + 2][n], tile[k8 + 3][n]);
        o.z = pack2(tile[k8 + 4][n], tile[k8 + 5][n]);
        o.w = pack2(tile[k8 + 6][n], tile[k8 + 7][n]);
        const int ng = nt * 64 + n;
        const int drow = mode == 0 ? ng : (64 * (ng >> 5) + (mode == 2 ? 32 : 0) + (ng & 31));
        if (t < 2048) *(uint4*)(dst + ((size_t)((drow >> 7) * 16 + kt) * 128 + (drow & 127)) * 64 + k8) = o;
        else *(uint4*)(dst + (size_t)drow * dld + kt * 64 + k8) = o;
      }
    }
  }
  {
    float* sil = (float*)smem;
    float* red = sil + 5 * 1024;
    float* MOD = (float*)(ws + OFF_MOD);
    for (int t = lbid(); t < 192; t += lgdim()) {
      __syncthreads();
      for (int e = tid; e < 5 * 1024; e += 256) {
        const int v = e >> 10, k = e & 1023;
        const float cv = v == 0 ? p.c_ctx[k] : p.c[(v - 1) * 1024 + k];
        sil[e] = silu_f(cv);
      }
      __syncthreads();
      const int cidx = tid & 31, kg = tid >> 5, n0 = t * 32;
      float a0 = 0, a1 = 0, a2 = 0, a3 = 0, a4 = 0;
      const float* wp = p.w_ada + (size_t)kg * 6144 + n0 + cidx;
      for (int k0 = 0; k0 < 128; k0 += 16) {
        float w[16];
#pragma unroll
        for (int u = 0; u < 16; ++u) w[u] = wp[(size_t)(k0 + u) * (8 * 6144)];
#pragma unroll
        for (int u = 0; u < 16; ++u) {
          const int k = kg + 8 * (k0 + u);
          a0 += sil[k] * w[u]; a1 += sil[1024 + k] * w[u]; a2 += sil[2048 + k] * w[u]; a3 += sil[3072 + k] * w[u]; a4 += sil[4096 + k] * w[u];
        }
      }
      red[(kg * 5 + 0) * 32 + cidx] = a0; red[(kg * 5 + 1) * 32 + cidx] = a1; red[(kg * 5 + 2) * 32 + cidx] = a2;
      red[(kg * 5 + 3) * 32 + cidx] = a3; red[(kg * 5 + 4) * 32 + cidx] = a4;
      __syncthreads();
      if (tid < 160) {
        const int v = tid >> 5, cc = tid & 31;
        float s = p.b_ada[n0 + cc];
#pragma unroll
        for (int g8 = 0; g8 < 8; ++g8) s += red[(g8 * 5 + v) * 32 + cc];
        MOD[v * 6144 + n0 + cc] = s;
      }
    }
  }
  {
    const int gt = lbid() * 256 + tid, gn = lgdim() * 256;
    u16* KC = (u16*)(ws + OFF_KC);
    for (int e = gt; e < 4 * 256 * 1024 / 4; e += gn) {
      const float4 v = *(const float4*)(p.cache_k + (size_t)e * 4);
      uint2 o; o.x = pack2(v.x, v.y); o.y = pack2(v.z, v.w);
      *(uint2*)(KC + (size_t)e * 4) = o;
    }
    float* cosR = (float*)(ws + OFF_COSR); float* sinR = (float*)(ws + OFF_SINR);
    for (int e = gt; e < 4096 * 64; e += gn) {
      const int pos = e >> 6, d = e & 63;
      const int fi = d & 31;
      const float inv = powf(10000.0f, -(float)fi / 32.0f);
      const float pp = d < 32 ? (float)(pos >> 6) : (float)(pos & 63);
      const float ang = pp * inv;
      cosR[e] = cosf(ang); sinR[e] = sinf(ang);
    }
    float* cosD = (float*)(ws + OFF_COSD); float* sinD = (float*)(ws + OFF_SIND);
    for (int e = gt; e < 4096 * 32; e += gn) {
      const int pos = e >> 5, d = e & 31;
      const int fi = d & 15;
      const float inv = powf(10000.0f, -(float)fi / 16.0f);
      const float pp = d < 16 ? (float)(pos >> 6) : (float)(pos & 63);
      const float ang = pp * inv;
      cosD[e] = cosf(ang); sinD[e] = sinf(ang);
    }
  }
  if (lbid() == 0) {
    float* DEC = (float*)(ws + OFF_DEC);
    for (int e = tid; e < 512; e += 256) {
      const int hh = e >> 7, i = e & 127;
      const float df = p.decay_f[hh], db = p.decay_b[hh];
      const float lgf = fminf(df, 0.f) - log1pf(expf(-fabsf(df)));
      const float lgb = fminf(db, 0.f) - log1pf(expf(-fabsf(db)));
      DEC[DEC_WQF + e] = expf(lgf * (float)(i + 1));
      DEC[DEC_WQB + e] = expf(lgb * (float)(128 - i));
      DEC[DEC_WKF + e] = expf(lgf * (float)(127 - i));
      DEC[DEC_WKB + e] = expf(lgb * (float)i);
      if (i == 0) {
        DEC[DEC_LGF + hh] = lgf; DEC[DEC_LGB + hh] = lgb;
        DEC[DEC_GCF + hh] = expf(lgf * 128.f); DEC[DEC_GCB + hh] = expf(lgb * 128.f);
      }
    }
    if (tid < 64) {
      float s1 = p.lq1[tid] * p.lk1[tid], s2 = p.lq2[tid] * p.lk2[tid];
      s1 = wave_sum(s1); s2 = wave_sum(s2);
      if (tid == 0) DEC[DEC_LAM] = expf(s1) - expf(s2) + 0.2f;
    }
  }
}

DI void step_rownorm(const Params& p, int mode) {
  const int lane = ltid() & 63, wave = ltid() >> 6;
  const float* MOD = (const float*)(p.ws + OFF_MOD);
  u16* HB = (u16*)(p.ws + OFF_HB);
  for (int row = lbid() * 4 + wave; row < TT; row += lgdim() * 4) {
    const float* src = mode == 0 ? xrow(p, row) : p.out + OUT_Y + (size_t)row * D;
    float4 v[4];
    float ss = 0.f;
#pragma unroll
    for (int i = 0; i < 4; ++i) {
      v[i] = *(const float4*)(src + lane * 4 + 256 * i);
      ss += v[i].x * v[i].x + v[i].y * v[i].y + v[i].z * v[i].z + v[i].w * v[i].w;
    }
    ss = wave_sum(ss);
    const float rstd = rsqrtf(ss * (1.f / 1024.f) + 1e-6f);
    const int mv = row < TG ? 0 : 1 + ((row - TG) >> 12);
    const float* md = MOD + mv * 6144;
#pragma unroll
    for (int i = 0; i < 4; ++i) {
      const int col = lane * 4 + 256 * i;
      if (mode == 2) {
        const float4 g = *(const float4*)(p.final_g + col);
        float4 o; o.x = v[i].x * rstd * g.x; o.y = v[i].y * rstd * g.y; o.z = v[i].z * rstd * g.z; o.w = v[i].w * rstd * g.w;
        *(float4*)(p.out + OUT_Y + (size_t)row * D + col) = o;
      } else {
        const float4 g = *(const float4*)((mode == 0 ? p.norm1_g : p.norm2_g) + col);
        const float4 sh = *(const float4*)(md + (mode == 0 ? 0 : 3072) + col);
        const float4 sc = *(const float4*)(md + (mode == 0 ? 1024 : 4096) + col);
        uint2 o;
        o.x = pack2(v[i].x * rstd * g.x * (1.f + sc.x) + sh.x, v[i].y * rstd * g.y * (1.f + sc.y) + sh.y);
        o.y = pack2(v[i].z * rstd * g.z * (1.f + sc.z) + sh.z, v[i].w * rstd * g.w * (1.f + sc.w) + sh.w);
        if (mode == 0) *(uint2*)(HB + ((size_t)((row >> 7) * 16 + (col >> 6)) * 128 + (row & 127)) * 64 + (col & 63)) = o;
        else *(uint2*)(HB + (size_t)row * D + col) = o;
      }
    }
  }
}

template <typename T> DI T* launder(T* p) { __attribute__((address_space(1))) T* g = (__attribute__((address_space(1))) T*)p; asm volatile("" : "+v"(g)); return (T*)g; }
#define ROFF(i, reg) ((i) * 32 + ((reg) & 3) + 8 * ((reg) >> 2))

DI void step_proj(const Params& p, int g, char* smem) {
  TILE_COORDS
  char* ws = glaunder(p.ws);
  u16* sA = (u16*)smem; u16* sB = sA + 128 * LDT;
  const u16* HBg = (const u16*)(ws + OFF_HB) + (size_t)g * TG * D;
  const u16* WIN = (const u16*)(ws + OFF_WIN);
  const float* DEC = (const float*)(ws + OFF_DEC);
  const bool lat = g > 0;
  for (int t = lbid(); t < 16 * 64; t += lgdim()) {
    const int ntile = t >> 4, mt = t & 15;
    const int m0 = mt * 256, n0 = ntile * 128;
    const int cbmode = n0 < 1024 ? 1 : 0;
    f32x16 acc[4][2];
    zero_acc4(acc);
    gemm_accum_256(acc, HBg + (size_t)(m0 >> 7) * 16 * 8192, 64, 8192, 16 * 8192, WIN + (size_t)ntile * 16 * 8192, 64, 8192, D, sA, cbmode);
    const int rowb = m0 + wm * 128 + 4 * h;
    if (n0 < 1024) {
      const bool isk = n0 >= 512;
      const int hh = (n0 & 511) >> 7;
      const int d1 = 32 * wn + r;
      const float* cosb = launder((const float*)(ws + OFF_COSR) + (size_t)rowb * 64 + d1);
      const float* sinb = launder((const float*)(ws + OFF_SINR) + (size_t)rowb * 64 + d1);
      const int ib = rowb & 127;
      const float* wfb = launder(DEC + (isk ? DEC_WKF : DEC_WQF) + hh * 128 + ib);
      const float* wbb = launder(DEC + (isk ? DEC_WKB : DEC_WQB) + hh * 128 + ib);
      const size_t o512 = (size_t)rowb * 512 + hh * 128 + d1;
      if (!isk) {
        u16* qr = launder((u16*)(ws + G_QR) + o512); u16* qa = launder((u16*)(ws + G_QA) + o512); u16* qb = launder((u16*)(ws + G_QB) + o512);
#pragma unroll
        for (int i = 0; i < 4; ++i) {
#pragma unroll
          for (int reg = 0; reg < 16; ++reg) {
            const int ro = ROFF(i, reg);
            const float x1 = acc[i][0][reg], x2 = acc[i][1][reg];
            float a = x1, b = x2;
            if (lat) { const float cs = cosb[ro * 64], sn = sinb[ro * 64]; a = x1 * cs - x2 * sn; b = x1 * sn + x2 * cs; }
            const float wf = wfb[ro], wb = wbb[ro];
            qr[ro * 512] = f2bf(a); qr[ro * 512 + 64] = f2bf(b);
            qa[ro * 512] = f2bf(a * wf); qa[ro * 512 + 64] = f2bf(b * wf);
            qb[ro * 512] = f2bf(a * wb); qb[ro * 512 + 64] = f2bf(b * wb);
          }
          SCHED_FENCE();
        }
      } else {
        u16* kr = launder((u16*)(ws + G_KR) + o512);
        const size_t ot = (size_t)(hh * 128 + d1) * TG + rowb;
        u16* kf = launder((u16*)(ws + G_KRTF) + ot); u16* kb = launder((u16*)(ws + G_KRTB) + ot);
#pragma unroll
        for (int i = 0; i < 4; ++i) {
#pragma unroll
          for (int rg = 0; rg < 4; ++rg) {
            float o1[4], o2[4], wf[4], wb[4];
#pragma unroll
            for (int e = 0; e < 4; ++e) {
              const int ro = ROFF(i, rg * 4 + e);
              const float x1 = acc[i][0][rg * 4 + e], x2 = acc[i][1][rg * 4 + e];
              float a = x1, b = x2;
              if (lat) { const float cs = cosb[ro * 64], sn = sinb[ro * 64]; a = x1 * cs - x2 * sn; b = x1 * sn + x2 * cs; }
              a *= 0.08838834764831845f; b *= 0.08838834764831845f;
              wf[e] = wfb[ro]; wb[e] = wbb[ro];
              o1[e] = a; o2[e] = b;
              kr[ro * 512] = f2bf(a); kr[ro * 512 + 64] = f2bf(b);
            }
            const int to = i * 32 + 8 * rg;
            u32x2 v;
            v.x = pack2(o1[0] * wf[0], o1[1] * wf[1]); v.y = pack2(o1[2] * wf[2], o1[3] * wf[3]); *(u32x2*)(kf + to) = v;
            v.x = pack2(o2[0] * wf[0], o2[1] * wf[1]); v.y = pack2(o2[2] * wf[2], o2[3] * wf[3]); *(u32x2*)(kf + to + 64 * TG) = v;
            v.x = pack2(o1[0] * wb[0], o1[1] * wb[1]); v.y = pack2(o1[2] * wb[2], o1[3] * wb[3]); *(u32x2*)(kb + to) = v;
            v.x = pack2(o2[0] * wb[0], o2[1] * wb[1]); v.y = pack2(o2[2] * wb[2], o2[3] * wb[3]); *(u32x2*)(kb + to + 64 * TG) = v;
          }
          SCHED_FENCE();
        }
      }
    } else if (n0 < 2048 || (n0 >= 5120 && n0 < 6144)) {
      const bool isd = n0 >= 5120;
      const int cbase = isd ? n0 - 5120 : n0 - 1024;
#pragma unroll
      for (int j = 0; j < 2; ++j) {
        const int col = cbase + COL_L(j, 0);
        u16* vt = launder((isd ? (u16*)(ws + G_VDT) : (u16*)(ws + G_VRT)) + (size_t)col * TG + rowb);
        float* ov = launder(p.out + OUT_DV + (size_t)rowb * 1024 + col);
#pragma unroll
        for (int i = 0; i < 4; ++i) {
#pragma unroll
          for (int rg = 0; rg < 4; ++rg) {
            u32x2 v;
            v.x = pack2(acc[i][j][rg * 4 + 0], acc[i][j][rg * 4 + 1]);
            v.y = pack2(acc[i][j][rg * 4 + 2], acc[i][j][rg * 4 + 3]);
            *(u32x2*)(vt + i * 32 + 8 * rg) = v;
            if (isd && !lat) {
#pragma unroll
              for (int e = 0; e < 4; ++e) ov[(i * 32 + 8 * rg + e) * 1024] = acc[i][j][rg * 4 + e];
            }
          }
        }
        SCHED_FENCE();
      }
    } else if (n0 < 3072) {
#pragma unroll
      for (int j = 0; j < 2; ++j) {
        u16* gr = launder((u16*)(ws + G_GR) + (size_t)rowb * 1024 + n0 - 2048 + COL_L(j, 0));
#pragma unroll
        for (int i = 0; i < 4; ++i)
#pragma unroll
          for (int reg = 0; reg < 16; ++reg) gr[ROFF(i, reg) * 1024] = f2bf(silu_f(acc[i][j][reg]));
        SCHED_FENCE();
      }
    } else if (n0 < 5120) {
      const bool isk = n0 >= 4096;
      const int cbase = (isk ? n0 - 4096 : n0 - 3072) + 64 * wn + r;
      const float* cosb = launder((const float*)(ws + OFF_COSD) + (size_t)rowb * 32 + r);
      const float* sinb = launder((const float*)(ws + OFF_SIND) + (size_t)rowb * 32 + r);
      u16* dst = launder((isk ? (u16*)(ws + G_KD) : (u16*)(ws + G_QD)) + (size_t)rowb * 1024 + cbase);
      float* ok = launder(p.out + OUT_DK + (size_t)rowb * 1024 + cbase);
      const float qs = isk ? 1.f : 0.125f * 1.4426950408889634f;
#pragma unroll
      for (int i = 0; i < 4; ++i) {
#pragma unroll
        for (int reg = 0; reg < 16; ++reg) {
          const int ro = ROFF(i, reg);
          const float x1 = acc[i][0][reg], x2 = acc[i][1][reg];
          float a = x1, b = x2;
          if (lat) { const float cs = cosb[ro * 32], sn = sinb[ro * 32]; a = x1 * cs - x2 * sn; b = x1 * sn + x2 * cs; }
          else if (isk) { ok[ro * 1024] = x1; ok[ro * 1024 + 32] = x2; }
          dst[ro * 1024] = f2bf(a * qs);
          dst[ro * 1024 + 32] = f2bf(b * qs);
        }
        SCHED_FENCE();
      }
    } else {
#pragma unroll
      for (int j = 0; j < 2; ++j) {
        const int col = n0 - 6144 + COL_L(j, 0);
        const float bg = p.b_gate[col];
        u16* gt = launder((u16*)(ws + G_GATES) + (size_t)rowb * 2048 + col);
#pragma unroll
        for (int i = 0; i < 4; ++i)
#pragma unroll
          for (int reg = 0; reg < 16; ++reg) gt[ROFF(i, reg) * 2048] = f2bf(sigmoid_f(acc[i][j][reg] + bg));
        SCHED_FENCE();
      }
    }
  }
}

constexpr int LDK = 136, LDV = 72, LDC = 132;
DI void attn_item(const Params& p, int g, int item, char* smem, bool dummy = false) {
  const int tid = ltid(), lane = tid & 63, wave = tid >> 6, r = lane & 31, h = lane >> 5;
  const int m = wave >> 1, rw = wave & 1;
  char* ws = glaunder(p.ws);
  u16* sK = (u16*)smem; u16* sV = sK + 64 * LDK;
  float* cmb = (float*)smem;
  const int head = item & 7, rest = item >> 3;
  int q0, kbase, nt0, nt1;
  if (g == 0) { const int seq = rest >> 2; q0 = seq * 256 + (rest & 3) * 64; kbase = seq * 256; nt0 = 4; nt1 = 0; }
  else { q0 = rest * 64; kbase = 0; nt0 = 64; nt1 = 4; }
  u16* QD = (u16*)(ws + G_QD);
  const u16* KD = (const u16*)(ws + G_KD);
  const u16* VDT = (const u16*)(ws + G_VDT);
  const u16* KCb = (const u16*)(ws + OFF_KC) + (size_t)(g > 0 ? g - 1 : 0) * 256 * 1024;
  const u16* VCb = (const u16*)(ws + OFF_VCT) + (size_t)(g > 0 ? g - 1 : 0) * 1024 * 256;
  const float lam = ((const float*)(ws + OFF_DEC))[DEC_LAM];
  const int qrow = q0 + rw * 32 + r;
  bf16x8 qf[4];
#pragma unroll
  for (int ks = 0; ks < 4; ++ks) qf[ks] = *(const bf16x8*)(QD + (size_t)qrow * 1024 + head * 128 + m * 64 + ks * 16 + h * 8);
  f32x16 O[4];
#pragma unroll
  for (int d = 0; d < 4; ++d)
#pragma unroll
    for (int e = 0; e < 16; ++e) O[d][e] = 0.f;
  float mrun = -1e30f, lsum = 0.f;
  const int ntiles = nt0 + nt1;
  constexpr int ASTG = 64 * LDK + 128 * LDV;
  const u16* sKw = sK + r * LDK + m * 64 + h * 8;
  const u16* sVw = sV + r * LDV + 8 * h;
  const int krow_l = tid >> 4;
  const int krow_p = (krow_l & 3) | ((krow_l & 4) << 1) | ((krow_l & 8) >> 1);
  u16* wK = sK + krow_p * LDK + (tid & 15) * 8;
  u16* wV = sV + (tid >> 3) * LDV + (tid & 7) * 8;
  u32x4 rk[4], rv[4];
#define ATTN_LOAD(T)                                                                                                   \
  {                                                                                                                    \
    const u16* kp; const u16* vp; int ldv;                                                                             \
    if ((T) < nt0) { kp = KD + (size_t)(kbase + (T) * 64) * 1024 + head * 128; vp = VDT + (size_t)(head * 128) * TG + kbase + (T) * 64; ldv = TG; } \
    else { const int t2 = (T) - nt0; kp = KCb + (size_t)(t2 * 64) * 1024 + head * 128; vp = VCb + (size_t)(head * 128) * 256 + t2 * 64; ldv = 256; } \
    _Pragma("unroll") for (int q = 0; q < 4; ++q) {                                                                    \
      rk[q] = *(const u32x4*)(kp + (size_t)((tid >> 4) + 16 * q) * 1024 + (tid & 15) * 8);                             \
      rv[q] = *(const u32x4*)(vp + (size_t)((tid >> 3) + 32 * q) * ldv + (tid & 7) * 8);                               \
    }                                                                                                                  \
  }
#define ATTN_STORE(STAGE)                                                                                              \
  {                                                                                                                    \
    _Pragma("unroll") for (int q = 0; q < 4; ++q) {                                                                    \
      *(u32x4*)(wK + (STAGE) * ASTG + 16 * q * LDK) = rk[q];                                                           \
      *(u32x4*)(wV + (STAGE) * ASTG + 32 * q * LDV) = rv[q];                                                           \
    }                                                                                                                  \
  }
  ATTN_LOAD(0)
  __syncthreads();
  ATTN_STORE(0)
  __syncthreads();
  if (ntiles > 1) ATTN_LOAD(1)
  for (int t = 0; t < ntiles; ++t) {
    const int cur = t & 1;
    const u16* sKc = sKw + cur * ASTG;
    const u16* sVc = sVw + cur * ASTG;
    bf16x8 ka[2][4];
#pragma unroll
    for (int kb = 0; kb < 2; ++kb)
#pragma unroll
      for (int ks = 0; ks < 4; ++ks) ka[kb][ks] = *(const bf16x8*)(sKc + kb * 32 * LDK + ks * 16);
    __builtin_amdgcn_sched_barrier(0);
    f32x16 st[2];
#pragma unroll
    for (int e = 0; e < 16; ++e) { st[0][e] = 0.f; st[1][e] = 0.f; }
#pragma unroll
    for (int ks = 0; ks < 4; ++ks) {
      st[0] = MFMA(ka[0][ks], qf[ks], st[0]);
      st[1] = MFMA(ka[1][ks], qf[ks], st[1]);
    }
    bf16x8 va[2][4];
#define ATTN_LOADV(BUF, GI)                                                                       \
  {                                                                                               \
    _Pragma("unroll") for (int d = 0; d < 4; ++d) {                                               \
      va[BUF][d] = *(const bf16x8*)(sVc + d * 32 * LDV + (GI) * 16);                              \
    }                                                                                             \
  }
    ATTN_LOADV(0, 0)
    __builtin_amdgcn_sched_barrier(0);
    float mx = fmaxf(st[0][0], st[1][0]);
#pragma unroll
    for (int e = 1; e < 16; ++e) mx = fmaxf(mx, fmaxf(st[0][e], st[1][e]));
    mx = fmaxf(mx, __shfl_xor(mx, 32, 64));
    if (__any(mx > mrun + 8.0f)) {
      const float mnew = fmaxf(mrun, mx);
      const float alpha = __builtin_amdgcn_exp2f(mrun - mnew);
      mrun = mnew;
      lsum *= alpha;
#pragma unroll
      for (int d = 0; d < 4; ++d)
#pragma unroll
        for (int e = 0; e < 16; ++e) O[d][e] *= alpha;
    }
    float rs = 0.f;
#pragma unroll
    for (int kb = 0; kb < 2; ++kb)
#pragma unroll
      for (int e = 0; e < 16; ++e) { const float pv = __builtin_amdgcn_exp2f(st[kb][e] - mrun); st[kb][e] = pv; rs += pv; }
    rs += __shfl_xor(rs, 32, 64);
    lsum += rs;
    union { bf16x8 v; unsigned u[4]; } pf[4];
#pragma unroll
    for (int gi = 0; gi < 4; ++gi) {
      const int kb = gi >> 1, s2 = gi & 1;
      pf[gi].u[0] = pack2(st[kb][8 * s2 + 0], st[kb][8 * s2 + 1]);
      pf[gi].u[1] = pack2(st[kb][8 * s2 + 2], st[kb][8 * s2 + 3]);
      pf[gi].u[2] = pack2(st[kb][8 * s2 + 4], st[kb][8 * s2 + 5]);
      pf[gi].u[3] = pack2(st[kb][8 * s2 + 6], st[kb][8 * s2 + 7]);
    }
    __builtin_amdgcn_sched_barrier(0);
#pragma unroll
    for (int gi = 0; gi < 4; ++gi) {
      if (gi < 3) ATTN_LOADV((gi + 1) & 1, gi + 1)
      __builtin_amdgcn_sched_barrier(0);
#pragma unroll
      for (int d = 0; d < 4; ++d) O[d] = MFMA(va[gi & 1][d], pf[gi].v, O[d]);
      __builtin_amdgcn_sched_barrier(0);
    }
#undef ATTN_LOADV
    if (t + 1 < ntiles) ATTN_STORE(cur ^ 1)
    __syncthreads();
    if (t + 2 < ntiles) ATTN_LOAD(t + 2)
  }
#undef ATTN_LOAD
#undef ATTN_STORE
  __syncthreads();
  float* crow_p = cmb + (rw * 32 + r) * LDC + 4 * h;
  if (m == 1) {
    const float sc = lam / lsum;
#pragma unroll
    for (int d = 0; d < 4; ++d)
#pragma unroll
      for (int rg = 0; rg < 4; ++rg) {
        float4 v; v.x = O[d][rg * 4 + 0] * sc; v.y = O[d][rg * 4 + 1] * sc; v.z = O[d][rg * 4 + 2] * sc; v.w = O[d][rg * 4 + 3] * sc;
        *(float4*)(crow_p + d * 32 + 8 * rg) = v;
      }
  }
  __syncthreads();
  if (m == 0) {
    const float i0 = 1.f / lsum;
    float ss = 0.f;
#pragma unroll
    for (int d = 0; d < 4; ++d)
#pragma unroll
      for (int rg = 0; rg < 4; ++rg) {
        const float4 c = *(const float4*)(crow_p + d * 32 + 8 * rg);
        const float o0 = O[d][rg * 4 + 0] * i0 - c.x, o1 = O[d][rg * 4 + 1] * i0 - c.y, o2 = O[d][rg * 4 + 2] * i0 - c.z, o3 = O[d][rg * 4 + 3] * i0 - c.w;
        O[d][rg * 4 + 0] = o0; O[d][rg * 4 + 1] = o1; O[d][rg * 4 + 2] = o2; O[d][rg * 4 + 3] = o3;
        ss += o0 * o0 + o1 * o1 + o2 * o2 + o3 * o3;
      }
    ss += __shfl_xor(ss, 32, 64);
    const float rstd = rsqrtf(ss * (1.f / 128.f) + 1e-6f) * 0.8f;
#pragma unroll
    for (int d = 0; d < 4; ++d)
#pragma unroll
      for (int rg = 0; rg < 4; ++rg) {
        const int e0 = d * 32 + 8 * rg + 4 * h;
        const float4 gg = *(const float4*)(p.subln_g + e0);
        u32x2 v;
        v.x = pack2(O[d][rg * 4 + 0] * rstd * gg.x, O[d][rg * 4 + 1] * rstd * gg.y);
        v.y = pack2(O[d][rg * 4 + 2] * rstd * gg.z, O[d][rg * 4 + 3] * rstd * gg.w);
        *(u32x2*)((dummy ? (u16*)(ws + G_SP) : QD) + (size_t)qrow * 1024 + head * 128 + e0) = v;
      }
  }
}

DI void step_mix3(const Params& p, int g, char* smem) {
  TILE_COORDS
  char* ws = glaunder(p.ws);
  u16* sA = (u16*)smem; u16* sB = sA + 128 * LDT;
  const float* DEC = (const float*)(ws + OFF_DEC);
  for (int t = lbid(); t < 512 + 512 + 128; t += lgdim()) {
    if (t < 512) {
#if PROBE_M3
      attn_item(p, g, t, smem, true);
#endif
      attn_item(p, g, t, smem); continue; }
    f32x16 acc[2][2];
    zero_acc(acc);
    const int rowb = wm * 64 + 4 * h;
    if (t < 1024) {
      const int tt = t - 512;
      const int chunk = tt >> 4, hh = (tt >> 2) & 3, dir = (tt >> 1) & 1, mt = tt & 1;
      const u16* A = (const u16*)(ws + G_VRT) + (size_t)(hh * 256 + mt * 128) * TG + chunk * 128;
      const u16* Bt = (const u16*)(ws + (dir ? G_KRTB : G_KRTF)) + (size_t)(hh * 128) * TG + chunk * 128;
      gemm_accum(acc, A, TG, Bt, TG, 128, sA, sB, 0);
#pragma unroll
      for (int j = 0; j < 2; ++j) {
        float* kv = launder((float*)(ws + G_KV) + (size_t)((chunk * 4 + hh) * 2 + dir) * 32768 + (size_t)(mt * 128 + rowb) * 128 + COL_L(j, 0));
#pragma unroll
        for (int i = 0; i < 2; ++i)
#pragma unroll
          for (int reg = 0; reg < 16; ++reg) kv[ROFF(i, reg) * 128] = acc[i][j][reg];
        SCHED_FENCE();
      }
    } else {
      const int tt = t - 1024;
      const int chunk = tt >> 2, hh = tt & 3;
      const u16* A = (const u16*)(ws + G_QR) + (size_t)(chunk * 128) * 512 + hh * 128;
      const u16* Bt = (const u16*)(ws + G_KR) + (size_t)(chunk * 128) * 512 + hh * 128;
      gemm_accum(acc, A, 512, Bt, 512, 128, sA, sB, 0);
      const float lgf = DEC[DEC_LGF + hh], lgb = DEC[DEC_LGB + hh];
      int rbl = rowb;
      asm volatile("" : "+v"(rbl));
#pragma unroll
      for (int j = 0; j < 2; ++j) {
        const int cj = COL_L(j, 0);
        u16* sc = launder((u16*)(ws + G_SC) + (size_t)(chunk * 4 + hh) * 16384 + rowb * 128 + cj);
#pragma unroll
        for (int i = 0; i < 2; ++i)
#pragma unroll
          for (int reg = 0; reg < 16; ++reg) {
            const int ri = rbl + ROFF(i, reg);
            const float dd = (float)(ri - cj);
            const float dec = cj <= ri ? __expf(lgf * dd) : __expf(-lgb * dd);
            sc[ROFF(i, reg) * 128] = f2bf(acc[i][j][reg] * dec);
          }
        SCHED_FENCE();
      }
    }
  }
}

template <int NCH> DI void scan_body(const Params& p, int g, char* ws) {
  const float* DEC = (const float*)(ws + OFF_DEC);
  const float* KV = (const float*)(ws + G_KV);
  u16* SP = (u16*)(ws + G_SP);
  const int nseq = (4096 / 128) / NCH;
  const int total = nseq * 262144;
  for (int e = lbid() * 256 + ltid(); e < total; e += lgdim() * 256) {
    const int idx = e & 32767, hd = (e >> 15) & 7, hh = hd >> 1, dir = hd & 1, seq = e >> 18;
    const int dv = idx >> 7, dk = idx & 127;
    float s = 0.f;
    if (g > 0) s = (dir ? p.state_b : p.state_f)[(size_t)((g - 1) * 4 + hh) * 32768 + dk * 256 + dv];
    const float gc = DEC[(dir ? DEC_GCB : DEC_GCF) + hh];
    const int c0 = seq * NCH;
    const size_t ob = (size_t)(((dir ? c0 + NCH - 1 : c0) * 4 + hh) * 2 + dir) * 32768 + idx;
    const ptrdiff_t stp = (ptrdiff_t)(dir ? -1 : 1) * (4 * 2 * 32768);
    float kvv[NCH];
#pragma unroll
    for (int n = 0; n < NCH; ++n) kvv[n] = KV[ob + n * stp];
#pragma unroll
    for (int n = 0; n < NCH; ++n) {
      SP[ob + n * stp] = f2bf(s);
      s = gc * s + kvv[n];
    }
    if (g == 0) (p.out + (dir ? OUT_RB : OUT_RF))[(size_t)(seq * 4 + hh) * 32768 + dk * 256 + dv] = s;
  }
}
DI void step_scan(const Params& p, int g) {
  char* ws = glaunder(p.ws);
  if (g == 0) scan_body<2>(p, g, ws); else scan_body<32>(p, g, ws);
}

DI void step_retout(const Params& p, char* smem) {
  TILE_COORDS
  char* ws = glaunder(p.ws);
  u16* sA = (u16*)smem; u16* sB = sA + 128 * LDT;
  for (int t = lbid(); t < 512; t += lgdim()) {
    const int chunk = t >> 4, hh = (t >> 2) & 3, nt = t & 3;
    f32x16 acc[2][1];
    zero_acc1(acc);
    gemm_accum_t<1>(acc, (const u16*)(ws + G_SC) + (size_t)(chunk * 4 + hh) * 16384, 128,
                    (const u16*)(ws + G_VRT) + (size_t)(hh * 256 + nt * 64) * TG + chunk * 128, TG, 128, sA, sB, 0);
    gemm_accum_t<1>(acc, (const u16*)(ws + G_QA) + (size_t)(chunk * 128) * 512 + hh * 128, 512,
                    (const u16*)(ws + G_SP) + (size_t)((chunk * 4 + hh) * 2 + 0) * 32768 + (size_t)nt * 64 * 128, 128, 128, sA, sB, 0);
    gemm_accum_t<1>(acc, (const u16*)(ws + G_QB) + (size_t)(chunk * 128) * 512 + hh * 128, 512,
                    (const u16*)(ws + G_SP) + (size_t)((chunk * 4 + hh) * 2 + 1) * 32768 + (size_t)nt * 64 * 128, 128, 128, sA, sB, 0);
    const int rowb = chunk * 128 + wm * 64 + 4 * h;
    float* op = launder((float*)(ws + G_KV) + (size_t)rowb * 1024 + hh * 256 + nt * 64 + wn * 32 + r);
#pragma unroll
    for (int i = 0; i < 2; ++i)
#pragma unroll
      for (int reg = 0; reg < 16; ++reg) op[ROFF(i, reg) * 1024] = acc[i][0][reg];
  }
}

DI void step_gn(const Params& p) {
  const int lane = ltid() & 63, wave = ltid() >> 6;
  const float* OPRE = (const float*)(p.ws + G_KV);
  u16* GR = (u16*)(p.ws + G_GR);
  for (int it = lbid() * 4 + wave; it < TG * 4; it += lgdim() * 4) {
    const int tok = it >> 2, hh = it & 3;
    const size_t o = (size_t)tok * 1024 + hh * 256 + lane * 4;
    const float4 v = *(const float4*)(OPRE + o);
    const float mu = wave_sum(v.x + v.y + v.z + v.w) * (1.f / 256.f);
    const float d0 = v.x - mu, d1 = v.y - mu, d2 = v.z - mu, d3 = v.w - mu;
    const float var = wave_sum(d0 * d0 + d1 * d1 + d2 * d2 + d3 * d3) * (1.f / 256.f);
    const float rstd = rsqrtf(var + 1e-5f);
    const float4 gg = *(const float4*)(p.gn_g + hh * 256 + lane * 4);
    const u32x2 gr = *(const u32x2*)(GR + o);
    u32x2 w;
    w.x = pack2(d0 * rstd * gg.x * bf2f((u16)(gr.x & 0xffff)), d1 * rstd * gg.y * bf2f((u16)(gr.x >> 16)));
    w.y = pack2(d2 * rstd * gg.z * bf2f((u16)(gr.y & 0xffff)), d3 * rstd * gg.w * bf2f((u16)(gr.y >> 16)));
    *(u32x2*)(GR + o) = w;
  }
}

DI void step_branch(const Params& p, char* smem) {
  TILE_COORDS
  char* ws = glaunder(p.ws);
  u16* sA = (u16*)smem; u16* sB = sA + 128 * LDT;
  for (int t = lbid(); t < 512; t += lgdim()) {
    const int ntile = t >> 5, mt = t & 31;
    const int m0 = mt * 128, n0 = ntile * 64;
    const int rowb = m0 + wm * 64 + 4 * h;
    const int col = n0 + wn * 32 + r;
    f32x16 acc[2][1];
    zero_acc1(acc);
    gemm_accum_t<1>(acc, (const u16*)(ws + G_GR) + (size_t)m0 * 1024, 1024, (const u16*)(ws + OFF_WR) + (size_t)n0 * 1024, 1024, 1024, sA, sB, 0);
    {
      const u16* gt = launder((const u16*)(ws + G_GATES) + (size_t)rowb * 2048 + col);
      float* tmp = launder((float*)(ws + G_KV) + (size_t)rowb * 1024 + col);
#pragma unroll
      for (int i = 0; i < 2; ++i)
#pragma unroll
        for (int reg = 0; reg < 16; ++reg) tmp[ROFF(i, reg) * 1024] = acc[i][0][reg] * bf2f(gt[ROFF(i, reg) * 2048]);
      SCHED_FENCE();
    }
    zero_acc1(acc);
    gemm_accum_t<1>(acc, (const u16*)(ws + G_QD) + (size_t)m0 * 1024, 1024, (const u16*)(ws + OFF_WD) + (size_t)n0 * 1024, 1024, 1024, sA, sB, 0);
    {
      const u16* gt = launder((const u16*)(ws + G_GATES) + (size_t)rowb * 2048 + 1024 + col);
      const float* tmp = launder((const float*)(ws + G_KV) + (size_t)rowb * 1024 + col);
      u16* mix = launder((u16*)(ws + G_MIX) + (size_t)rowb * 1024 + col);
#pragma unroll
      for (int i = 0; i < 2; ++i)
#pragma unroll
        for (int reg = 0; reg < 16; ++reg)
          mix[ROFF(i, reg) * 1024] = f2bf(tmp[ROFF(i, reg) * 1024] + acc[i][0][reg] * bf2f(gt[ROFF(i, reg) * 2048]));
      SCHED_FENCE();
    }
  }
}

DI void step_wo(const Params& p, int g, char* smem) {
  TILE_COORDS
  char* ws = glaunder(p.ws);
  u16* sA = (u16*)smem; u16* sB = sA + 128 * LDT;
  const float* gate1 = (const float*)(ws + OFF_MOD) + g * 6144 + 2048;
  for (int t = lbid(); t < 512; t += lgdim()) {
    const int ntile = t >> 5, mt = t & 31;
    const int m0 = mt * 128, n0 = ntile * 64;
    f32x16 acc[2][1];
    zero_acc1(acc);
    gemm_accum_t<1>(acc, (const u16*)(ws + G_MIX) + (size_t)m0 * 1024, 1024, (const u16*)(ws + OFF_WO) + (size_t)n0 * 1024, 1024, 1024, sA, sB, 0);
    const int rowb = g * TG + m0 + wm * 64 + 4 * h;
    const int col = n0 + wn * 32 + r;
    const float g1 = gate1[col];
    const float* xs = launder(xrow(p, rowb) + col);
    float* o = launder(p.out + OUT_Y + (size_t)rowb * D + col);
#pragma unroll
    for (int i = 0; i < 2; ++i)
#pragma unroll
      for (int reg = 0; reg < 16; ++reg) o[ROFF(i, reg) * D] = xs[ROFF(i, reg) * D] + g1 * acc[i][0][reg];
  }
}

DI void step_ffn_up(const Params& p, char* smem) {
  TILE_COORDS
  char* ws = glaunder(p.ws);
  u16* sA = (u16*)smem; u16* sB = sA + 128 * LDT;
  for (int t = lbid(); t < 80 * 44; t += lgdim()) {
    const int ntile = t / 80, mt = t % 80;
    const int m0 = mt * 256, n0 = ntile * 128;
    f32x16 acc[4][2];
    zero_acc4(acc);
    gemm_accum_256(acc, (const u16*)(ws + OFF_HB) + (size_t)m0 * 1024, 1024, 64, 128 * 1024, (const u16*)(ws + OFF_WGU) + (size_t)n0 * 1024, 1024, 64, 1024, sA, 0);
    const int rowb = m0 + wm * 128 + 4 * h;
    u16* act = launder((u16*)(ws + OFF_ACT) + (size_t)rowb * FF + ntile * 64 + 32 * wn + r);
#pragma unroll
    for (int i = 0; i < 4; ++i) {
#pragma unroll
      for (int reg = 0; reg < 16; ++reg) act[ROFF(i, reg) * FF] = f2bf(silu_f(acc[i][0][reg]) * acc[i][1][reg]);
      SCHED_FENCE();
    }
  }
}

DI void step_ffn_down(const Params& p, char* smem) {
  TILE_COORDS
  char* ws = glaunder(p.ws);
  u16* sA = (u16*)smem; u16* sB = sA + 128 * LDT;
  const float* MOD = (const float*)(ws + OFF_MOD);
  for (int t = lbid(); t < 160 * 8; t += lgdim()) {
    const int ntile = t / 160, mt = t % 160;
    const int m0 = mt * 128, n0 = ntile * 128;
    f32x16 acc[2][2];
    zero_acc(acc);
    gemm_accum(acc, (const u16*)(ws + OFF_ACT) + (size_t)m0 * FF, FF, (const u16*)(ws + OFF_WDN) + (size_t)n0 * FF, FF, FF, sA, sB, 0);
    const int mv = m0 < TG ? 0 : 1 + ((m0 - TG) >> 12);
    const float* gate2 = MOD + mv * 6144 + 5120;
    const int rowb = m0 + wm * 64 + 4 * h;
#pragma unroll
    for (int j = 0; j < 2; ++j) {
      const int col = n0 + COL_L(j, 0);
      const float g2 = gate2[col];
      float* o = launder(p.out + OUT_Y + (size_t)rowb * D + col);
#pragma unroll
      for (int i = 0; i < 2; ++i)
#pragma unroll
        for (int reg = 0; reg < 16; ++reg) o[ROFF(i, reg) * D] = o[ROFF(i, reg) * D] + g2 * acc[i][j][reg];
      SCHED_FENCE();
    }
  }
}


#define XB_TMO      128
#define XB_XCNT(j)  (256  + 64 * (j))
#define XB_XSUB(j)  (1280 + 64 * (j))
#define XB_XGEN(j)  (2304 + 64 * (j))
#define XB_TOP      3328
#define XB_TOPGEN   3392
#define XCD_BAR_WORDS 3456
#define XB_SPIN_CAP (1u << 22)
#define LAS __attribute__((address_space(3)))
DI unsigned xb_ld(unsigned* p)              { return __hip_atomic_load(p, __ATOMIC_RELAXED, __HIP_MEMORY_SCOPE_AGENT); }
DI unsigned xb_add(unsigned* p, unsigned v) { return __hip_atomic_fetch_add(p, v, __ATOMIC_RELAXED, __HIP_MEMORY_SCOPE_AGENT); }
DI unsigned xb_xcc_id() { return (unsigned)__builtin_amdgcn_s_getreg((3 << 11) | 20) & 0xFu; }
#define XB_SPIN(cond, bar) do { unsigned _sp = 0; while (cond) { __builtin_amdgcn_s_sleep(1); \
    if ((++_sp & 255u) == 0u) { if (xb_ld(&(bar)[XB_TMO])) break; if (_sp > XB_SPIN_CAP) { atomicAdd(&(bar)[XB_TMO], 1u); break; } } } } while (0)
struct XcdBarrier { unsigned* bar; unsigned x; volatile LAS unsigned* st; };
DI XcdBarrier xcd_barrier_post(unsigned* bar, volatile LAS unsigned* st) {
  XcdBarrier b; b.bar = bar; b.x = xb_xcc_id(); b.st = st;
  if (threadIdx.x == 0) (void)xb_add(&bar[XB_XCNT(b.x)], 1u);
  return b;
}
DI void xcd_barrier_complete(unsigned* bar, unsigned x, unsigned& nloc, unsigned& nx) {
  const unsigned G = gridDim.x * gridDim.y * gridDim.z;
  unsigned sum, cnt, mine, sp = 0u;
  for (;;) {
    sum = 0u; cnt = 0u; mine = 0u;
#pragma unroll
    for (unsigned j = 0; j < 16; ++j) { const unsigned c = xb_ld(&bar[XB_XCNT(j)]); sum += c; cnt += (c > 0u) ? 1u : 0u; mine = (j == x) ? c : mine; }
    if (sum == G) break;
    __builtin_amdgcn_s_sleep(1);
    if ((++sp & 255u) == 0u) { if (xb_ld(&bar[XB_TMO])) break; if (sp > XB_SPIN_CAP) { atomicAdd(&bar[XB_TMO], 1u); break; } }
  }
  nloc = mine > 0u ? mine : 1u; nx = cnt > 0u ? cnt : 1u;
}
DI void xcd_barrier(const XcdBarrier& b) {
  asm volatile("s_waitcnt vmcnt(0)" ::: "memory");
  __syncthreads();
  if (threadIdx.x == 0) {
    unsigned* bar = b.bar;
    __builtin_amdgcn_s_waitcnt(0);
    unsigned nloc = b.st[0], nx = b.st[1];
    if (nloc == 0u) { xcd_barrier_complete(bar, b.x, nloc, nx); b.st[0] = nloc; b.st[1] = nx; }
    const unsigned old = xb_add(&bar[XB_XSUB(b.x)], 1u);
    const unsigned gen = old / nloc;
    if (old + 1u == (gen + 1u) * nloc) {
      __builtin_amdgcn_fence(__ATOMIC_RELEASE, "agent");
      asm volatile("s_waitcnt vmcnt(0)" ::: "memory");
      const unsigned og = xb_add(&bar[XB_TOP], 1u);
      const unsigned tg = og / nx;
      if (og + 1u == (tg + 1u) * nx) xb_add(&bar[XB_TOPGEN], 1u);
      else XB_SPIN(xb_ld(&bar[XB_TOPGEN]) == tg, bar);
      __builtin_amdgcn_fence(__ATOMIC_ACQUIRE, "agent");
      xb_add(&bar[XB_XGEN(b.x)], 1u);
      asm volatile("s_waitcnt vmcnt(0)" ::: "memory");
    } else {
      XB_SPIN(xb_ld(&bar[XB_XGEN(b.x)]) == gen, bar);
      __builtin_amdgcn_fence(__ATOMIC_ACQUIRE, "agent");
      asm volatile("s_waitcnt vmcnt(0)" ::: "memory");
    }
  }
  __syncthreads();
}

constexpr int NSTEPS = 37;

__global__ void __launch_bounds__(256, 2) mega(Params p, int lo, int hi) {
  __shared__ __attribute__((aligned(16))) char smem[SMEM_BYTES];
  __shared__ uint4 xb_words;
  cg::grid_group grid = cg::this_grid();
  if (lo > hi) grid.sync();
  if (threadIdx.x == 0) xb_words = make_uint4(0u, 0u, 0u, 0u);
  __syncthreads();
  XcdBarrier xb = xcd_barrier_post((unsigned*)(p.ws + OFF_BAR), (volatile LAS unsigned*)&xb_words);
  for (int step = lo; step < hi; ++step) {
    if (step == 0) { step_p0(p, smem); if (PROBE_M1) step_p0(p, smem); }
    else if (step == 1) { step_rownorm(p, 0); if (PROBE_M1) step_rownorm(p, 0); }
    else if (step == 2) step_proj(p, 0, smem);
    else if (step < 33) {
      const int g = (step - 3) / 6, s = (step - 3) % 6;
      if (s == 0) step_mix3(p, g, smem);
      else if (s == 1) { step_scan(p, g); if (PROBE_M1) step_scan(p, g); }
      else if (s == 2) { step_retout(p, smem); if (PROBE_M2) step_retout(p, smem); }
      else if (s == 3) step_gn(p);
      else if (s == 4) { step_branch(p, smem); if (PROBE_M2) step_branch(p, smem); }
      else { step_wo(p, g, smem); if (g < 4) step_proj(p, g + 1, smem); }
    } else if (step == 33) { step_rownorm(p, 1); if (PROBE_M1) step_rownorm(p, 1); }
    else if (step == 34) step_ffn_up(p, smem);
    else if (step == 35) step_ffn_down(p, smem);
    else step_rownorm(p, 2);
    if (step + 1 < hi) xcd_barrier(xb);
  }
}

extern "C" void kernel_launch(void* const* d_in, const int* in_sizes, int n_in, void* d_out, int out_size, void* d_ws, size_t ws_size, hipStream_t stream) {
  static int grid_blocks = 0;
  if (!grid_blocks) {
    int dev = 0, cus = 0, per_cu = 0;
    hipGetDevice(&dev);
    hipDeviceGetAttribute(&cus, hipDeviceAttributeMultiprocessorCount, dev);
    hipOccupancyMaxActiveBlocksPerMultiprocessor(&per_cu, mega, 256, 0);
    if (per_cu < 1) per_cu = 1;
    if (per_cu > 2) per_cu = 2;
    grid_blocks = cus * per_cu;
  }
  Params p{};
  const float** f = (const float**)&p;
  for (int i = 0; i < 29; ++i) f[i] = (const float*)d_in[i];
  p.out = (float*)d_out;
  p.ws = (char*)d_ws;
  hipMemsetAsync((char*)d_ws + OFF_BAR, 0, XCD_BAR_WORDS * 4, stream);
#if COOP
  int lo = 0, hi = NSTEPS;
  void* args[] = {&p, &lo, &hi};
  hipError_t e = hipLaunchCooperativeKernel((void*)mega, dim3(grid_blocks), dim3(256), args, 0, stream);
  if (e != hipSuccess) fprintf(stderr, "cooperative launch failed: %s (grid %d)\n", hipGetErrorString(e), grid_blocks);
#else
  for (int s = 0; s < NSTEPS; ++s) hipLaunchKernelGGL(mega, dim3(grid_blocks), dim3(256), 0, stream, p, s, s + 1);
#endif
}
```

```cpp
#include <hip/hip_runtime.h>
#include <hip/hip_cooperative_groups.h>
#include <cstdio>
namespace cg = cooperative_groups;

#ifndef PROBE_M1
#define PROBE_M1 0
#endif
#ifndef PROBE_M2
#define PROBE_M2 0
#endif
#ifndef PROBE_M3
#define PROBE_M3 0
#endif
#ifndef COOP
#define COOP 1
#endif

#define DI __device__ __forceinline__
typedef unsigned short u16;
typedef __attribute__((ext_vector_type(8))) short bf16x8;
typedef __attribute__((ext_vector_type(4))) short s16x4;
typedef __attribute__((ext_vector_type(16))) float f32x16;
typedef __attribute__((ext_vector_type(4))) unsigned u32x4;
typedef __attribute__((ext_vector_type(2))) unsigned u32x2;
#define SCHED_FENCE() asm volatile("" ::: "memory")
#define MFMA(a, b, c) __builtin_amdgcn_mfma_f32_32x32x16_bf16((a), (b), (c), 0, 0, 0)

constexpr int D = 1024;
constexpr int TG = 4096;
constexpr int NG = 5;
constexpr int TT = TG * NG;
constexpr int FF = 2816;
constexpr int WCOLS = 8192;

constexpr size_t OFF_WIN = 0;
constexpr size_t OFF_WR = OFF_WIN + (size_t)8192 * 1024 * 2;
constexpr size_t OFF_WD = OFF_WR + 2097152;
constexpr size_t OFF_WO = OFF_WD + 2097152;
constexpr size_t OFF_WGU = OFF_WO + 2097152;
constexpr size_t OFF_WDN = OFF_WGU + (size_t)5632 * 1024 * 2;
constexpr size_t OFF_MOD = OFF_WDN + (size_t)1024 * 2816 * 2;
constexpr size_t OFF_COSR = OFF_MOD + 122880;
constexpr size_t OFF_SINR = OFF_COSR + 1048576;
constexpr size_t OFF_COSD = OFF_SINR + 1048576;
constexpr size_t OFF_SIND = OFF_COSD + 524288;
constexpr size_t OFF_DEC = OFF_SIND + 524288;
constexpr size_t OFF_KC = OFF_DEC + 16384;
constexpr size_t OFF_VCT = OFF_KC + 2097152;
constexpr size_t OFF_HB = OFF_VCT + 2097152;
constexpr size_t OFF_G = OFF_HB + (size_t)TT * 1024 * 2;
constexpr size_t G_QR = OFF_G;
constexpr size_t G_QA = G_QR + 4194304;
constexpr size_t G_QB = G_QA + 4194304;
constexpr size_t G_KR = G_QB + 4194304;
constexpr size_t G_KRTF = G_KR + 4194304;
constexpr size_t G_KRTB = G_KRTF + 4194304;
constexpr size_t G_VRT = G_KRTB + 4194304;
constexpr size_t G_GR = G_VRT + 8388608;
constexpr size_t G_QD = G_GR + 8388608;
constexpr size_t G_KD = G_QD + 8388608;
constexpr size_t G_VDT = G_KD + 8388608;
constexpr size_t G_GATES = G_VDT + 8388608;
constexpr size_t G_KV = G_GATES + 16777216;
constexpr size_t G_SP = G_KV + 33554432;
constexpr size_t G_SC = G_SP + 16777216;
constexpr size_t G_MIX = G_SC + 4194304;
constexpr size_t G_END = G_MIX + 8388608;
constexpr size_t OFF_BAR = G_END;
constexpr size_t OFF_ACT = OFF_G;
static_assert((size_t)TT * FF * 2 <= G_END - OFF_G, "ACT alias");
static_assert(G_END + 16384 <= (size_t)256 * 1024 * 1024, "ws");

constexpr int DEC_WQF = 0, DEC_WQB = 512, DEC_WKF = 1024, DEC_WKB = 1536, DEC_LGF = 2048, DEC_LGB = 2052, DEC_GCF = 2056, DEC_GCB = 2060, DEC_LAM = 2064;

constexpr size_t OUT_Y = 0;
constexpr size_t OUT_RF = (size_t)TT * 1024;
constexpr size_t OUT_RB = OUT_RF + 2097152;
constexpr size_t OUT_DK = OUT_RB + 2097152;
constexpr size_t OUT_DV = OUT_DK + 4194304;

struct Params {
  const float *x_prompt, *x_sample, *state_f, *state_b, *cache_k, *cache_v, *c, *c_ctx, *norm1_g, *norm2_g, *w_ada, *b_ada, *w_in, *b_gate,
      *decay_f, *decay_b, *gn_g, *w_ret_out, *lq1, *lk1, *lq2, *lk2, *subln_g, *w_diff_out, *w_o, *w_gate, *w_up, *w_down, *final_g;
  float* out;
  char* ws;
};

DI int ltid() { int t = threadIdx.x; asm volatile("" : "+v"(t)); return t; }
DI char* glaunder(char* p) { __attribute__((address_space(1))) char* g = (__attribute__((address_space(1))) char*)p; asm volatile("" : "+s"(g)); return (char*)g; }
DI int lbid() { int b = blockIdx.x; asm volatile("" : "+s"(b)); return b; }
DI int lgdim() { int b = gridDim.x; asm volatile("" : "+s"(b)); return b; }
typedef __bf16 hbf16x2 __attribute__((ext_vector_type(2)));
typedef float f32x2 __attribute__((ext_vector_type(2)));
DI u16 f2bf(float x) { return __builtin_bit_cast(u16, (__bf16)x); }
DI float bf2f(u16 v) { return __uint_as_float(((unsigned)v) << 16); }
DI unsigned pack2(float a, float b) { f32x2 v = {a, b}; return __builtin_bit_cast(unsigned, __builtin_convertvector(v, hbf16x2)); }
DI float silu_f(float x) { return x * __builtin_amdgcn_rcpf(1.f + __expf(-x)); }
DI float sigmoid_f(float x) { return __builtin_amdgcn_rcpf(1.f + __expf(-x)); }
DI float wave_sum(float v) {
#pragma unroll
  for (int o = 32; o > 0; o >>= 1) v += __shfl_xor(v, o, 64);
  return v;
}
DI const float* xrow(const Params& p, int row) { return row < TG ? p.x_prompt + (size_t)row * D : p.x_sample + (size_t)(row - TG) * D; }

constexpr int LDT = 72;
constexpr int SMEM_BYTES = 2 * 2 * 128 * LDT * 2;
constexpr int SMEM_OLD_UNUSED = 0;

template <int NJ>
DI void gemm_accum_t(f32x16 (&acc)[2][NJ], const u16* A, int lda, const u16* Bt, int ldb, int K, u16* sA, u16* sB, int cbmode) {
  constexpr int STG = 2 * 128 * LDT;
  constexpr int NB = 2 * NJ;
  const int tid = ltid(), lane = tid & 63, wave = tid >> 6, wm = wave >> 1, wn = wave & 1, r = lane & 31, h = lane >> 5;
  const int lrow = tid >> 3, lcol = (tid & 7) * 8;
  const u16* ap = A + (size_t)lrow * lda + lcol;
  const u16* bp = Bt + (size_t)lrow * ldb + lcol;
  const int nk = K >> 6;
  u32x4 ra[3][4], rb[3][NB];
#define GEMM_LOAD(SET)                                                                            \
  {                                                                                               \
    _Pragma("unroll") for (int q = 0; q < 4; ++q) ra[SET][q] = *(const u32x4*)(ap + (size_t)(32 * q) * lda);  \
    _Pragma("unroll") for (int q = 0; q < NB; ++q) rb[SET][q] = *(const u32x4*)(bp + (size_t)(32 * q) * ldb); \
    ap += 64; bp += 64;                                                                           \
  }
  GEMM_LOAD(0)
  if (nk > 1) GEMM_LOAD(1)
  if (nk > 2) GEMM_LOAD(2)
  const int cb0 = NJ == 1 ? wn : (cbmode ? wn : 2 * wn), cb1 = cbmode ? wn + 2 : 2 * wn + 1;
  const u16* sa0 = sA + (wm * 64 + r) * LDT + h * 8;
  const u16* sb0 = sB + (cb0 * 32 + r) * LDT + h * 8;
  const u16* sb1 = sB + (cb1 * 32 + r) * LDT + h * 8;
  u16* wa = sA + lrow * LDT + lcol;
  u16* wb = sB + lrow * LDT + lcol;
  __syncthreads();
#pragma unroll
  for (int q = 0; q < 4; ++q) *(u32x4*)(wa + 32 * q * LDT) = ra[0][q];
#pragma unroll
  for (int q = 0; q < NB; ++q) *(u32x4*)(wb + 32 * q * LDT) = rb[0][q];
  __syncthreads();
#define GEMM_ITER(IDX, PAR, SET)                                                                  \
  {                                                                                               \
    const int kk = kt + IDX;                                                                      \
    if (kk + 3 < nk) GEMM_LOAD(SET)                                                               \
                       \
    bf16x8 fa[2][2], fb[2][2];                                                                    \
    fa[0][0] = *(const bf16x8*)(sa0 + PAR * STG);                                                 \
    fa[0][1] = *(const bf16x8*)(sa0 + PAR * STG + 32 * LDT);                                      \
    fb[0][0] = *(const bf16x8*)(sb0 + PAR * STG);                                                 \
    fb[0][1] = *(const bf16x8*)((NJ == 2 ? sb1 : sb0) + PAR * STG);                               \
    _Pragma("unroll") for (int ks = 0; ks < 4; ++ks) {                                            \
      if (ks < 3) {                                                                               \
        fa[(ks + 1) & 1][0] = *(const bf16x8*)(sa0 + PAR * STG + (ks + 1) * 16);                  \
        fa[(ks + 1) & 1][1] = *(const bf16x8*)(sa0 + PAR * STG + 32 * LDT + (ks + 1) * 16);       \
        fb[(ks + 1) & 1][0] = *(const bf16x8*)(sb0 + PAR * STG + (ks + 1) * 16);                  \
        if (NJ == 2) fb[(ks + 1) & 1][1] = *(const bf16x8*)(sb1 + PAR * STG + (ks + 1) * 16);     \
      }                                                                                           \
      __builtin_amdgcn_sched_barrier(0);                                                          \
      acc[0][0] = MFMA(fa[ks & 1][0], fb[ks & 1][0], acc[0][0]);                                  \
      acc[1][0] = MFMA(fa[ks & 1][1], fb[ks & 1][0], acc[1][0]);                                  \
      if (NJ == 2) {                                                                              \
        acc[0][NJ - 1] = MFMA(fa[ks & 1][0], fb[ks & 1][1], acc[0][NJ - 1]);                      \
        acc[1][NJ - 1] = MFMA(fa[ks & 1][1], fb[ks & 1][1], acc[1][NJ - 1]);                      \
      }                                                                                           \
      __builtin_amdgcn_sched_barrier(0);                                                          \
    }                                                                                             \
    if (kk + 1 < nk) {                                                                            \
      _Pragma("unroll") for (int q = 0; q < 4; ++q) *(u32x4*)(wa + (1 - PAR) * STG + 32 * q * LDT) = ra[(SET + 1) % 3][q];  \
      _Pragma("unroll") for (int q = 0; q < NB; ++q) *(u32x4*)(wb + (1 - PAR) * STG + 32 * q * LDT) = rb[(SET + 1) % 3][q]; \
    }                                                                                             \
    __syncthreads();                                                                              \
  }
  for (int kt = 0; kt < nk; kt += 6) {
    GEMM_ITER(0, 0, 0)
    if (kt + 1 < nk) GEMM_ITER(1, 1, 1)
    if (kt + 2 < nk) GEMM_ITER(2, 0, 2)
    if (kt + 3 < nk) GEMM_ITER(3, 1, 0)
    if (kt + 4 < nk) GEMM_ITER(4, 0, 1)
    if (kt + 5 < nk) GEMM_ITER(5, 1, 2)
  }
#undef GEMM_ITER
#undef GEMM_LOAD
}
DI void gemm_accum_256(f32x16 (&acc)[4][2], const u16* A, int a_rs, int a_ks, int a_sub, const u16* Bt, int b_rs, int b_ks, int K, u16* sA, int cbmode) {
  u16* sB = sA + 256 * LDT;
  const int tid = ltid(), lane = tid & 63, wave = tid >> 6, wm = wave >> 1, wn = wave & 1, r = lane & 31, h = lane >> 5;
  const int lrow = tid >> 3, lcol = (tid & 7) * 8;
  const u16* ap = A + (size_t)lrow * a_rs + lcol;
  const u16* bp = Bt + (size_t)lrow * b_rs + lcol;
  const int nk = K >> 6;
  u32x4 ra[8], rb[4];
#define A_OFF(q) ((size_t)((q) >> 2) * a_sub + (size_t)(32 * ((q) & 3)) * a_rs)
#pragma unroll
  for (int q = 0; q < 8; ++q) ra[q] = *(const u32x4*)(ap + A_OFF(q));
#pragma unroll
  for (int q = 0; q < 4; ++q) rb[q] = *(const u32x4*)(bp + (size_t)(32 * q) * b_rs);
  const int cb0 = cbmode ? wn : 2 * wn, cb1 = cbmode ? wn + 2 : 2 * wn + 1;
  const u16* sa0 = sA + (wm * 128 + r) * LDT + h * 8;
  const u16* sb0 = sB + (cb0 * 32 + r) * LDT + h * 8;
  const u16* sb1 = sB + (cb1 * 32 + r) * LDT + h * 8;
  u16* wa = sA + lrow * LDT + lcol;
  u16* wb = sB + lrow * LDT + lcol;
  for (int kt = 0; kt < nk; ++kt) {
    __syncthreads();
#pragma unroll
    for (int q = 0; q < 8; ++q) *(u32x4*)(wa + 32 * q * LDT) = ra[q];
#pragma unroll
    for (int q = 0; q < 4; ++q) *(u32x4*)(wb + 32 * q * LDT) = rb[q];
    __syncthreads();
    if (kt + 1 < nk) {
      ap += a_ks; bp += b_ks;
#pragma unroll
      for (int q = 0; q < 8; ++q) ra[q] = *(const u32x4*)(ap + A_OFF(q));
#pragma unroll
      for (int q = 0; q < 4; ++q) rb[q] = *(const u32x4*)(bp + (size_t)(32 * q) * b_rs);
    }
    bf16x8 fa[4], fb[2][2];
    fb[0][0] = *(const bf16x8*)(sb0);
    fb[0][1] = *(const bf16x8*)(sb1);
#pragma unroll
    for (int i = 0; i < 4; ++i) fa[i] = *(const bf16x8*)(sa0 + i * 32 * LDT);
#pragma unroll
    for (int ks = 0; ks < 4; ++ks) {
      if (ks < 3) {
        fb[(ks + 1) & 1][0] = *(const bf16x8*)(sb0 + (ks + 1) * 16);
        fb[(ks + 1) & 1][1] = *(const bf16x8*)(sb1 + (ks + 1) * 16);
      }
#pragma unroll
      for (int i = 0; i < 4; ++i) {
        __builtin_amdgcn_sched_barrier(0);
        acc[i][0] = MFMA(fa[i], fb[ks & 1][0], acc[i][0]);
        acc[i][1] = MFMA(fa[i], fb[ks & 1][1], acc[i][1]);
        __builtin_amdgcn_sched_barrier(0);
        if (ks < 3) fa[i] = *(const bf16x8*)(sa0 + i * 32 * LDT + (ks + 1) * 16);
      }
    }
  }
}
#undef A_OFF
DI void zero_acc4(f32x16 (&acc)[4][2]) {
#pragma unroll
  for (int i = 0; i < 4; ++i)
#pragma unroll
    for (int j = 0; j < 2; ++j)
#pragma unroll
      for (int e = 0; e < 16; ++e) acc[i][j][e] = 0.f;
}
DI void gemm_accum(f32x16 (&acc)[2][2], const u16* A, int lda, const u16* Bt, int ldb, int K, u16* sA, u16* sB, int cbmode) {
  gemm_accum_t<2>(acc, A, lda, Bt, ldb, K, sA, sB, cbmode);
}
DI void zero_acc1(f32x16 (&acc)[2][1]) {
#pragma unroll
  for (int i = 0; i < 2; ++i)
#pragma unroll
    for (int e = 0; e < 16; ++e) acc[i][0][e] = 0.f;
}

DI void zero_acc(f32x16 (&acc)[2][2]) {
#pragma unroll
  for (int i = 0; i < 2; ++i)
#pragma unroll
    for (int j = 0; j < 2; ++j)
#pragma unroll
      for (int e = 0; e < 16; ++e) acc[i][j][e] = 0.f;
}

#define TILE_COORDS                                                                                  \
  const int tid = ltid(), lane = tid & 63, wave = tid >> 6, wm = wave >> 1, wn = wave & 1;      \
  const int r = lane & 31, h = lane >> 5;                                                            \
  (void)r; (void)h; (void)wm; (void)wn;
#define ROW_L(i, reg) (wm * 64 + (i) * 32 + ((reg) & 3) + 8 * ((reg) >> 2) + 4 * h)
#define COL_L(j, cbmode) (((cbmode) ? (wn + 2 * (j)) : (2 * wn + (j))) * 32 + r)

DI void step_p0(const Params& p, char* smem) {
  const int tid = ltid();
  char* ws = glaunder(p.ws);
  {
    float(*tile)[65] = (float(*)[65])smem;
    constexpr int NT_ALL = 2048 + 768 + 1408 + 704 + 256;
    for (int t = lbid(); t < NT_ALL; t += lgdim()) {
      const float* src; int N; u16* dst; int dld; int mode = 0; int ntl; int tt = t;
      if (tt < 2048) { src = p.w_in; N = 8192; dst = (u16*)(ws + OFF_WIN); dld = 1024; ntl = 128; }
      else if ((tt -= 2048) < 256) { src = p.w_ret_out; N = 1024; dst = (u16*)(ws + OFF_WR); dld = 1024; ntl = 16; }
      else if ((tt -= 256) < 256) { src = p.w_diff_out; N = 1024; dst = (u16*)(ws + OFF_WD); dld = 1024; ntl = 16; }
      else if ((tt -= 256) < 256) { src = p.w_o; N = 1024; dst = (u16*)(ws + OFF_WO); dld = 1024; ntl = 16; }
      else if ((tt -= 256) < 704) { src = p.w_gate; N = FF; dst = (u16*)(ws + OFF_WGU); dld = 1024; mode = 1; ntl = 44; }
      else if ((tt -= 704) < 704) { src = p.w_up; N = FF; dst = (u16*)(ws + OFF_WGU); dld = 1024; mode = 2; ntl = 44; }
      else if ((tt -= 704) < 704) { src = p.w_down; N = 1024; dst = (u16*)(ws + OFF_WDN); dld = FF; ntl = 16; }
      else { tt -= 704; int b = tt >> 6; tt &= 63; src = p.cache_v + (size_t)b * 256 * 1024; N = 1024; dst = (u16*)(ws + OFF_VCT) + (size_t)b * 1024 * 256; dld = 256; ntl = 16; }
      const int kt = tt / ntl, nt = tt % ntl;
      __syncthreads();
#pragma unroll
      for (int q = 0; q < 4; ++q) {
        const int k = (tid >> 4) + 16 * q, n4 = (tid & 15) * 4;
        const float4 v = *(const float4*)(src + (size_t)(kt * 64 + k) * N + nt * 64 + n4);
        tile[k][n4 + 0] = v.x; tile[k][n4 + 1] = v.y; tile[k][n4 + 2] = v.z; tile[k][n4 + 3] = v.w;
      }
      __syncthreads();
#pragma unroll
      for (int q = 0; q < 2; ++q) {
        const int n = (tid >> 3) + 32 * q, k8 = (tid & 7) * 8;
        uint4 o;
        o.x = pack2(tile[k8 + 0][n], tile[k8 + 1][n]);
        o.y = pack2(tile[k8 + 2][n], tile[k8 + 3][n]);
        o.z = pack2(tile[k8 + 4][n], tile[k8 + 5][n]);
        o.w = pack2(tile[k8 + 6][n], tile[k8 + 7][n]);
        const int ng = nt * 64 + n;
        const int drow = mode == 0 ? ng : (64 * (ng >> 5) + (mode == 2 ? 32 : 0) + (ng & 31));
        if (t < 2048) *(uint4*)(dst + ((size_t)((drow >> 7) * 16 + kt) * 128 + (drow & 127)) * 64 + k8) = o;
        else *(uint4*)(dst + (size_t)drow * dld + kt * 64 + k8) = o;
      }
    }
  }
  {
    float* sil = (float*)smem;
    float* red = sil + 5 * 1024;
    float* MOD = (float*)(ws + OFF_MOD);
    for (int t = lbid(); t < 192; t += lgdim()) {
      __syncthreads();
      for (int e = tid; e < 5 * 1024; e += 256) {
        const int v = e >> 10, k = e & 1023;
        const float cv = v == 0 ? p.c_ctx[k] : p.c[(v - 1) * 1024 + k];
        sil[e] = silu_f(cv);
      }
      __syncthreads();
      const int cidx = tid & 31, kg = tid >> 5, n0 = t * 32;
      float a0 = 0, a1 = 0, a2 = 0, a3 = 0, a4 = 0;
      const float* wp = p.w_ada + (size_t)kg * 6144 + n0 + cidx;
      for (int k0 = 0; k0 < 128; k0 += 16) {
        float w[16];
#pragma unroll
        for (int u = 0; u < 16; ++u) w[u] = wp[(size_t)(k0 + u) * (8 * 6144)];
#pragma unroll
        for (int u = 0; u < 16; ++u) {
          const int k = kg + 8 * (k0 + u);
          a0 += sil[k] * w[u]; a1 += sil[1024 + k] * w[u]; a2 += sil[2048 + k] * w[u]; a3 += sil[3072 + k] * w[u]; a4 += sil[4096 + k] * w[u];
        }
      }
      red[(kg * 5 + 0) * 32 + cidx] = a0; red[(kg * 5 + 1) * 32 + cidx] = a1; red[(kg * 5 + 2) * 32 + cidx] = a2;
      red[(kg * 5 + 3) * 32 + cidx] = a3; red[(kg * 5 + 4) * 32 + cidx] = a4;
      __syncthreads();
      if (tid < 160) {
        const int v = tid >> 5, cc = tid & 31;
        float s = p.b_ada[n0 + cc];
#pragma unroll
        for (int g8 = 0; g8 < 8; ++g8) s += red[(g8 * 5 + v) * 32 + cc];
        MOD[v * 6144 + n0 + cc] = s;
      }
    }
  }
  {
    const int gt = lbid() * 256 + tid, gn = lgdim() * 256;
    u16* KC = (u16*)(ws + OFF_KC);
    for (int e = gt; e < 4 * 256 * 1024 / 4; e += gn) {
      const float4 v = *(const float4*)(p.cache_k + (size_t)e * 4);
      uint2 o; o.x = pack2(v.x, v.y); o.y = pack2(v.z, v.w);
      *(uint2*)(KC + (size_t)e * 4) = o;
    }
    float* cosR = (float*)(ws + OFF_COSR); float* sinR = (float*)(ws + OFF_SINR);
    for (int e = gt; e < 4096 * 64; e += gn) {
      const int pos = e >> 6, d = e & 63;
      const int fi = d & 31;
      const float inv = powf(10000.0f, -(float)fi / 32.0f);
      const float pp = d < 32 ? (float)(pos >> 6) : (float)(pos & 63);
      const float ang = pp * inv;
      cosR[e] = cosf(ang); sinR[e] = sinf(ang);
    }
    float* cosD = (float*)(ws + OFF_COSD); float* sinD = (float*)(ws + OFF_SIND);
    for (int e = gt; e < 4096 * 32; e += gn) {
      const int pos = e >> 5, d = e & 31;
      const int fi = d & 15;
      const float inv = powf(10000.0f, -(float)fi / 16.0f);
      const float pp = d < 16 ? (float)(pos >> 6) : (float)(pos & 63);
      const float ang = pp * inv;
      cosD[e] = cosf(ang); sinD[e] = sinf(ang);
    }
  }
  if (lbid() == 0) {
    float* DEC = (float*)(ws + OFF_DEC);
    for (int e = tid; e < 512; e += 256) {
      const int hh = e >> 7, i = e & 127;
      const float df = p.decay_f[hh], db = p.decay_b[hh];
      const float lgf = fminf(df, 0.f) - log1pf(expf(-fabsf(df)));
      const float lgb = fminf(db, 0.f) - log1pf(expf(-fabsf(db)));
      DEC[DEC_WQF + e] = expf(lgf * (float)(i + 1));
      DEC[DEC_WQB + e] = expf(lgb * (float)(128 - i));
      DEC[DEC_WKF + e] = expf(lgf * (float)(127 - i));
      DEC[DEC_WKB + e] = expf(lgb * (float)i);
      if (i == 0) {
        DEC[DEC_LGF + hh] = lgf; DEC[DEC_LGB + hh] = lgb;
        DEC[DEC_GCF + hh] = expf(lgf * 128.f); DEC[DEC_GCB + hh] = expf(lgb * 128.f);
      }
    }
    if (tid < 64) {
      float s1 = p.lq1[tid] * p.lk1[tid], s2 = p.lq2[tid] * p.lk2[tid];
      s1 = wave_sum(s1); s2 = wave_sum(s2);
      if (tid == 0) DEC[DEC_LAM] = expf(s1) - expf(s2) + 0.2f;
    }
  }
}

DI void step_rownorm(const Params& p, int mode) {
  const int lane = ltid() & 63, wave = ltid() >> 6;
  const float* MOD = (const float*)(p.ws + OFF_MOD);
  u16* HB = (u16*)(p.ws + OFF_HB);
  for (int row = lbid() * 4 + wave; row < TT; row += lgdim() * 4) {
    const float* src = mode == 0 ? xrow(p, row) : p.out + OUT_Y + (size_t)row * D;
    float4 v[4];
    float ss = 0.f;
#pragma unroll
    for (int i = 0; i < 4; ++i) {
      v[i] = *(const float4*)(src + lane * 4 + 256 * i);
      ss += v[i].x * v[i].x + v[i].y * v[i].y + v[i].z * v[i].z + v[i].w * v[i].w;
    }
    ss = wave_sum(ss);
    const float rstd = rsqrtf(ss * (1.f / 1024.f) + 1e-6f);
    const int mv = row < TG ? 0 : 1 + ((row - TG) >> 12);
    const float* md = MOD + mv * 6144;
#pragma unroll
    for (int i = 0; i < 4; ++i) {
      const int col = lane * 4 + 256 * i;
      if (mode == 2) {
        const float4 g = *(const float4*)(p.final_g + col);
        float4 o; o.x = v[i].x * rstd * g.x; o.y = v[i].y * rstd * g.y; o.z = v[i].z * rstd * g.z; o.w = v[i].w * rstd * g.w;
        *(float4*)(p.out + OUT_Y + (size_t)row * D + col) = o;
      } else {
        const float4 g = *(const float4*)((mode == 0 ? p.norm1_g : p.norm2_g) + col);
        const float4 sh = *(const float4*)(md + (mode == 0 ? 0 : 3072) + col);
        const float4 sc = *(const float4*)(md + (mode == 0 ? 1024 : 4096) + col);
        uint2 o;
        o.x = pack2(v[i].x * rstd * g.x * (1.f + sc.x) + sh.x, v[i].y * rstd * g.y * (1.f + sc.y) + sh.y);
        o.y = pack2(v[i].z * rstd * g.z * (1.f + sc.z) + sh.z, v[i].w * rstd * g.w * (1.f + sc.w) + sh.w);
        if (mode == 0) *(uint2*)(HB + ((size_t)((row >> 7) * 16 + (col >> 6)) * 128 + (row & 127)) * 64 + (col & 63)) = o;
        else *(uint2*)(HB + (size_t)row * D + col) = o;
      }
    }
  }
}

template <typename T> DI T* launder(T* p) { __attribute__((address_space(1))) T* g = (__attribute__((address_space(1))) T*)p; asm volatile("" : "+v"(g)); return (T*)g; }
#define ROFF(i, reg) ((i) * 32 + ((reg) & 3) + 8 * ((reg) >> 2))

DI void step_proj(const Params& p, int g, char* smem) {
  TILE_COORDS
  char* ws = glaunder(p.ws);
  u16* sA = (u16*)smem; u16* sB = sA + 128 * LDT;
  const u16* HBg = (const u16*)(ws + OFF_HB) + (size_t)g * TG * D;
  const u16* WIN = (const u16*)(ws + OFF_WIN);
  const float* DEC = (const float*)(ws + OFF_DEC);
  const bool lat = g > 0;
  for (int t = lbid(); t < 16 * 64; t += lgdim()) {
    const int ntile = t >> 4, mt = t & 15;
    const int m0 = mt * 256, n0 = ntile * 128;
    const int cbmode = n0 < 1024 ? 1 : 0;
    f32x16 acc[4][2];
    zero_acc4(acc);
    gemm_accum_256(acc, HBg + (size_t)(m0 >> 7) * 16 * 8192, 64, 8192, 16 * 8192, WIN + (size_t)ntile * 16 * 8192, 64, 8192, D, sA, cbmode);
    const int rowb = m0 + wm * 128 + 4 * h;
    if (n0 < 1024) {
      const bool isk = n0 >= 512;
      const int hh = (n0 & 511) >> 7;
      const int d1 = 32 * wn + r;
      const float* cosb = launder((const float*)(ws + OFF_COSR) + (size_t)rowb * 64 + d1);
      const float* sinb = launder((const float*)(ws + OFF_SINR) + (size_t)rowb * 64 + d1);
      const int ib = rowb & 127;
      const float* wfb = launder(DEC + (isk ? DEC_WKF : DEC_WQF) + hh * 128 + ib);
      const float* wbb = launder(DEC + (isk ? DEC_WKB : DEC_WQB) + hh * 128 + ib);
      const size_t o512 = (size_t)rowb * 512 + hh * 128 + d1;
      if (!isk) {
        u16* qr = launder((u16*)(ws + G_QR) + o512); u16* qa = launder((u16*)(ws + G_QA) + o512); u16* qb = launder((u16*)(ws + G_QB) + o512);
#pragma unroll
        for (int i = 0; i < 4; ++i) {
#pragma unroll
          for (int reg = 0; reg < 16; ++reg) {
            const int ro = ROFF(i, reg);
            const float x1 = acc[i][0][reg], x2 = acc[i][1][reg];
            float a = x1, b = x2;
            if (lat) { const float cs = cosb[ro * 64], sn = sinb[ro * 64]; a = x1 * cs - x2 * sn; b = x1 * sn + x2 * cs; }
            const float wf = wfb[ro], wb = wbb[ro];
            qr[ro * 512] = f2bf(a); qr[ro * 512 + 64] = f2bf(b);
            qa[ro * 512] = f2bf(a * wf); qa[ro * 512 + 64] = f2bf(b * wf);
            qb[ro * 512] = f2bf(a * wb); qb[ro * 512 + 64] = f2bf(b * wb);
          }
          SCHED_FENCE();
        }
      } else {
        u16* kr = launder((u16*)(ws + G_KR) + o512);
        const size_t ot = (size_t)(hh * 128 + d1) * TG + rowb;
        u16* kf = launder((u16*)(ws + G_KRTF) + ot); u16* kb = launder((u16*)(ws + G_KRTB) + ot);
#pragma unroll
        for (int i = 0; i < 4; ++i) {
#pragma unroll
          for (int rg = 0; rg < 4; ++rg) {
            float o1[4], o2[4], wf[4], wb[4];
#pragma unroll
            for (int e = 0; e < 4; ++e) {
              const int ro = ROFF(i, rg * 4 + e);
              const float x1 = acc[i][0][rg * 4 + e], x2 = acc[i][1][rg * 4 + e];
              float a = x1, b = x2;
              if (lat) { const float cs = cosb[ro * 64], sn = sinb[ro * 64]; a = x1 * cs - x2 * sn; b = x1 * sn + x2 * cs; }
              a *= 0.08838834764831845f; b *= 0.08838834764831845f;
              wf[e] = wfb[ro]; wb[e] = wbb[ro];
              o1[e] = a; o2[e] = b;
              kr[ro * 512] = f2bf(a); kr[ro * 512 + 64] = f2bf(b);
            }
            const int to = i * 32 + 8 * rg;
            u32x2 v;
            v.x = pack2(o1[0] * wf[0], o1[1] * wf[1]); v.y = pack2(o1[2] * wf[2], o1[3] * wf[3]); *(u32x2*)(kf + to) = v;
            v.x = pack2(o2[0] * wf[0], o2[1] * wf[1]); v.y = pack2(o2[2] * wf[2], o2[3] * wf[3]); *(u32x2*)(kf + to + 64 * TG) = v;
            v.x = pack2(o1[0] * wb[0], o1[1] * wb[1]); v.y = pack2(o1[2] * wb[2], o1[3] * wb[3]); *(u32x2*)(kb + to) = v;
            v.x = pack2(o2[0] * wb[0], o2[1] * wb[1]); v.y = pack2(o2[2] * wb[2], o2[3] * wb[3]); *(u32x2*)(kb + to + 64 * TG) = v;
          }
          SCHED_FENCE();
        }
      }
    } else if (n0 < 2048 || (n0 >= 5120 && n0 < 6144)) {
      const bool isd = n0 >= 5120;
      const int cbase = isd ? n0 - 5120 : n0 - 1024;
#pragma unroll
      for (int j = 0; j < 2; ++j) {
        const int col = cbase + COL_L(j, 0);
        u16* vt = launder((isd ? (u16*)(ws + G_VDT) : (u16*)(ws + G_VRT)) + (size_t)col * TG + rowb);
        float* ov = launder(p.out + OUT_DV + (size_t)rowb * 1024 + col);
#pragma unroll
        for (int i = 0; i < 4; ++i) {
#pragma unroll
          for (int rg = 0; rg < 4; ++rg) {
            u32x2 v;
            v.x = pack2(acc[i][j][rg * 4 + 0], acc[i][j][rg * 4 + 1]);
            v.y = pack2(acc[i][j][rg * 4 + 2], acc[i][j][rg * 4 + 3]);
            *(u32x2*)(vt + i * 32 + 8 * rg) = v;
            if (isd && !lat) {
#pragma unroll
              for (int e = 0; e < 4; ++e) ov[(i * 32 + 8 * rg + e) * 1024] = acc[i][j][rg * 4 + e];
            }
          }
        }
        SCHED_FENCE();
      }
    } else if (n0 < 3072) {
#pragma unroll
      for (int j = 0; j < 2; ++j) {
        u16* gr = launder((u16*)(ws + G_GR) + (size_t)rowb * 1024 + n0 - 2048 + COL_L(j, 0));
#pragma unroll
        for (int i = 0; i < 4; ++i)
#pragma unroll
          for (int reg = 0; reg < 16; ++reg) gr[ROFF(i, reg) * 1024] = f2bf(silu_f(acc[i][j][reg]));
        SCHED_FENCE();
      }
    } else if (n0 < 5120) {
      const bool isk = n0 >= 4096;
      const int cbase = (isk ? n0 - 4096 : n0 - 3072) + 64 * wn + r;
      const float* cosb = launder((const float*)(ws + OFF_COSD) + (size_t)rowb * 32 + r);
      const float* sinb = launder((const float*)(ws + OFF_SIND) + (size_t)rowb * 32 + r);
      u16* dst = launder((isk ? (u16*)(ws + G_KD) : (u16*)(ws + G_QD)) + (size_t)rowb * 1024 + cbase);
      float* ok = launder(p.out + OUT_DK + (size_t)rowb * 1024 + cbase);
      const float qs = isk ? 1.f : 0.125f * 1.4426950408889634f;
#pragma unroll
      for (int i = 0; i < 4; ++i) {
#pragma unroll
        for (int reg = 0; reg < 16; ++reg) {
          const int ro = ROFF(i, reg);
          const float x1 = acc[i][0][reg], x2 = acc[i][1][reg];
          float a = x1, b = x2;
          if (lat) { const float cs = cosb[ro * 32], sn = sinb[ro * 32]; a = x1 * cs - x2 * sn; b = x1 * sn + x2 * cs; }
          else if (isk) { ok[ro * 1024] = x1; ok[ro * 1024 + 32] = x2; }
          dst[ro * 1024] = f2bf(a * qs);
          dst[ro * 1024 + 32] = f2bf(b * qs);
        }
        SCHED_FENCE();
      }
    } else {
#pragma unroll
      for (int j = 0; j < 2; ++j) {
        const int col = n0 - 6144 + COL_L(j, 0);
        const float bg = p.b_gate[col];
        u16* gt = launder((u16*)(ws + G_GATES) + (size_t)rowb * 2048 + col);
#pragma unroll
        for (int i = 0; i < 4; ++i)
#pragma unroll
          for (int reg = 0; reg < 16; ++reg) gt[ROFF(i, reg) * 2048] = f2bf(sigmoid_f(acc[i][j][reg] + bg));
        SCHED_FENCE();
      }
    }
  }
}

constexpr int LDK = 136, LDV = 72, LDC = 132;
DI void attn_item(const Params& p, int g, int item, char* smem, bool dummy = false) {
  const int tid = ltid(), lane = tid & 63, wave = tid >> 6, r = lane & 31, h = lane >> 5;
  const int m = wave >> 1, rw = wave & 1;
  char* ws = glaunder(p.ws);
  u16* sK = (u16*)smem; u16* sV = sK + 64 * LDK;
  float* cmb = (float*)smem;
  const int head = item & 7, rest = item >> 3;
  int q0, kbase, nt0, nt1;
  if (g == 0) { const int seq = rest >> 2; q0 = seq * 256 + (rest & 3) * 64; kbase = seq * 256; nt0 = 4; nt1 = 0; }
  else { q0 = rest * 64; kbase = 0; nt0 = 64; nt1 = 4; }
  u16* QD = (u16*)(ws + G_QD);
  const u16* KD = (const u16*)(ws + G_KD);
  const u16* VDT = (const u16*)(ws + G_VDT);
  const u16* KCb = (const u16*)(ws + OFF_KC) + (size_t)(g > 0 ? g - 1 : 0) * 256 * 1024;
  const u16* VCb = (const u16*)(ws + OFF_VCT) + (size_t)(g > 0 ? g - 1 : 0) * 1024 * 256;
  const float lam = ((const float*)(ws + OFF_DEC))[DEC_LAM];
  const int qrow = q0 + rw * 32 + r;
  bf16x8 qf[4];
#pragma unroll
  for (int ks = 0; ks < 4; ++ks) qf[ks] = *(const bf16x8*)(QD + (size_t)qrow * 1024 + head * 128 + m * 64 + ks * 16 + h * 8);
  f32x16 O[4];
#pragma unroll
  for (int d = 0; d < 4; ++d)
#pragma unroll
    for (int e = 0; e < 16; ++e) O[d][e] = 0.f;
  float mrun = -1e30f, lsum = 0.f;
  const int ntiles = nt0 + nt1;
  constexpr int ASTG = 64 * LDK + 128 * LDV;
  const u16* sKw = sK + r * LDK + m * 64 + h * 8;
  const u16* sVw = sV + r * LDV + 8 * h;
  const int krow_l = tid >> 4;
  const int krow_p = (krow_l & 3) | ((krow_l & 4) << 1) | ((krow_l & 8) >> 1);
  u16* wK = sK + krow_p * LDK + (tid & 15) * 8;
  u16* wV = sV + (tid >> 3) * LDV + (tid & 7) * 8;
  u32x4 rk[4], rv[4];
#define ATTN_LOAD(T)                                                                                                   \
  {                                                                                                                    \
    const u16* kp; const u16* vp; int ldv;                                                                             \
    if ((T) < nt0) { kp = KD + (size_t)(kbase + (T) * 64) * 1024 + head * 128; vp = VDT + (size_t)(head * 128) * TG + kbase + (T) * 64; ldv = TG; } \
    else { const int t2 = (T) - nt0; kp = KCb + (size_t)(t2 * 64) * 1024 + head * 128; vp = VCb + (size_t)(head * 128) * 256 + t2 * 64; ldv = 256; } \
    _Pragma("unroll") for (int q = 0; q < 4; ++q) {                                                                    \
      rk[q] = *(const u32x4*)(kp + (size_t)((tid >> 4) + 16 * q) * 1024 + (tid & 15) * 8);                             \
      rv[q] = *(const u32x4*)(vp + (size_t)((tid >> 3) + 32 * q) * ldv + (tid & 7) * 8);                               \
    }                                                                                                                  \
  }
#define ATTN_STORE(STAGE)                                                                                              \
  {                                                                                                                    \
    _Pragma("unroll") for (int q = 0; q < 4; ++q) {                                                                    \
      *(u32x4*)(wK + (STAGE) * ASTG + 16 * q * LDK) = rk[q];                                                           \
      *(u32x4*)(wV + (STAGE) * ASTG + 32 * q * LDV) = rv[q];                                                           \
    }                                                                                                                  \
  }
  ATTN_LOAD(0)
  __syncthreads();
  ATTN_STORE(0)
  __syncthreads();
  if (ntiles > 1) ATTN_LOAD(1)
  for (int t = 0; t < ntiles; ++t) {
    const int cur = t & 1;
    const u16* sKc = sKw + cur * ASTG;
    const u16* sVc = sVw + cur * ASTG;
    bf16x8 ka[2][4];
#pragma unroll
    for (int kb = 0; kb < 2; ++kb)
#pragma unroll
      for (int ks = 0; ks < 4; ++ks) ka[kb][ks] = *(const bf16x8*)(sKc + kb * 32 * LDK + ks * 16);
    __builtin_amdgcn_sched_barrier(0);
    f32x16 st[2];
#pragma unroll
    for (int e = 0; e < 16; ++e) { st[0][e] = 0.f; st[1][e] = 0.f; }
#pragma unroll
    for (int ks = 0; ks < 4; ++ks) {
      st[0] = MFMA(ka[0][ks], qf[ks], st[0]);
      st[1] = MFMA(ka[1][ks], qf[ks], st[1]);
    }
    bf16x8 va[2][4];
#define ATTN_LOADV(BUF, GI)                                                                       \
  {                                                                                               \
    _Pragma("unroll") for (int d = 0; d < 4; ++d) {                                               \
      va[BUF][d] = *(const bf16x8*)(sVc + d * 32 * LDV + (GI) * 16);                              \
    }                                                                                             \
  }
    ATTN_LOADV(0, 0)
    __builtin_amdgcn_sched_barrier(0);
    float mx = fmaxf(st[0][0], st[1][0]);
#pragma unroll
    for (int e = 1; e < 16; ++e) mx = fmaxf(mx, fmaxf(st[0][e], st[1][e]));
    mx = fmaxf(mx, __shfl_xor(mx, 32, 64));
    if (__any(mx > mrun + 8.0f)) {
      const float mnew = fmaxf(mrun, mx);
      const float alpha = __builtin_amdgcn_exp2f(mrun - mnew);
      mrun = mnew;
      lsum *= alpha;
#pragma unroll
      for (int d = 0; d < 4; ++d)
#pragma unroll
        for (int e = 0; e < 16; ++e) O[d][e] *= alpha;
    }
    float rs = 0.f;
#pragma unroll
    for (int kb = 0; kb < 2; ++kb)
#pragma unroll
      for (int e = 0; e < 16; ++e) { const float pv = __builtin_amdgcn_exp2f(st[kb][e] - mrun); st[kb][e] = pv; rs += pv; }
    rs += __shfl_xor(rs, 32, 64);
    lsum += rs;
    union { bf16x8 v; unsigned u[4]; } pf[4];
#pragma unroll
    for (int gi = 0; gi < 4; ++gi) {
      const int kb = gi >> 1, s2 = gi & 1;
      pf[gi].u[0] = pack2(st[kb][8 * s2 + 0], st[kb][8 * s2 + 1]);
      pf[gi].u[1] = pack2(st[kb][8 * s2 + 2], st[kb][8 * s2 + 3]);
      pf[gi].u[2] = pack2(st[kb][8 * s2 + 4], st[kb][8 * s2 + 5]);
      pf[gi].u[3] = pack2(st[kb][8 * s2 + 6], st[kb][8 * s2 + 7]);
    }
    __builtin_amdgcn_sched_barrier(0);
    __builtin_amdgcn_s_setprio(1);
#pragma unroll
    for (int gi = 0; gi < 4; ++gi) {
      if (gi < 3) ATTN_LOADV((gi + 1) & 1, gi + 1)
      __builtin_amdgcn_sched_barrier(0);
#pragma unroll
      for (int d = 0; d < 4; ++d) O[d] = MFMA(va[gi & 1][d], pf[gi].v, O[d]);
      __builtin_amdgcn_sched_barrier(0);
    }
    __builtin_amdgcn_s_setprio(0);
#undef ATTN_LOADV
    if (t + 1 < ntiles) ATTN_STORE(cur ^ 1)
    __syncthreads();
    if (t + 2 < ntiles) ATTN_LOAD(t + 2)
  }
#undef ATTN_LOAD
#undef ATTN_STORE
  __syncthreads();
  float* crow_p = cmb + (rw * 32 + r) * LDC + 4 * h;
  if (m == 1) {
    const float sc = lam / lsum;
#pragma unroll
    for (int d = 0; d < 4; ++d)
#pragma unroll
      for (int rg = 0; rg < 4; ++rg) {
        float4 v; v.x = O[d][rg * 4 + 0] * sc; v.y = O[d][rg * 4 + 1] * sc; v.z = O[d][rg * 4 + 2] * sc; v.w = O[d][rg * 4 + 3] * sc;
        *(float4*)(crow_p + d * 32 + 8 * rg) = v;
      }
  }
  __syncthreads();
  if (m == 0) {
    const float i0 = 1.f / lsum;
    float ss = 0.f;
#pragma unroll
    for (int d = 0; d < 4; ++d)
#pragma unroll
      for (int rg = 0; rg < 4; ++rg) {
        const float4 c = *(const float4*)(crow_p + d * 32 + 8 * rg);
        const float o0 = O[d][rg * 4 + 0] * i0 - c.x, o1 = O[d][rg * 4 + 1] * i0 - c.y, o2 = O[d][rg * 4 + 2] * i0 - c.z, o3 = O[d][rg * 4 + 3] * i0 - c.w;
        O[d][rg * 4 + 0] = o0; O[d][rg * 4 + 1] = o1; O[d][rg * 4 + 2] = o2; O[d][rg * 4 + 3] = o3;
        ss += o0 * o0 + o1 * o1 + o2 * o2 + o3 * o3;
      }
    ss += __shfl_xor(ss, 32, 64);
    const float rstd = rsqrtf(ss * (1.f / 128.f) + 1e-6f) * 0.8f;
#pragma unroll
    for (int d = 0; d < 4; ++d)
#pragma unroll
      for (int rg = 0; rg < 4; ++rg) {
        const int e0 = d * 32 + 8 * rg + 4 * h;
        const float4 gg = *(const float4*)(p.subln_g + e0);
        u32x2 v;
        v.x = pack2(O[d][rg * 4 + 0] * rstd * gg.x, O[d][rg * 4 + 1] * rstd * gg.y);
        v.y = pack2(O[d][rg * 4 + 2] * rstd * gg.z, O[d][rg * 4 + 3] * rstd * gg.w);
        *(u32x2*)((dummy ? (u16*)(ws + G_SP) : QD) + (size_t)qrow * 1024 + head * 128 + e0) = v;
      }
  }
}

DI void step_mix3(const Params& p, int g, char* smem) {
  TILE_COORDS
  char* ws = glaunder(p.ws);
  u16* sA = (u16*)smem; u16* sB = sA + 128 * LDT;
  const float* DEC = (const float*)(ws + OFF_DEC);
  for (int t = lbid(); t < 512 + 512 + 128; t += lgdim()) {
    if (t < 512) {
#if PROBE_M3
      attn_item(p, g, t, smem, true);
#endif
      attn_item(p, g, t, smem); continue; }
    f32x16 acc[2][2];
    zero_acc(acc);
    const int rowb = wm * 64 + 4 * h;
    if (t < 1024) {
      const int tt = t - 512;
      const int chunk = tt >> 4, hh = (tt >> 2) & 3, dir = (tt >> 1) & 1, mt = tt & 1;
      const u16* A = (const u16*)(ws + G_VRT) + (size_t)(hh * 256 + mt * 128) * TG + chunk * 128;
      const u16* Bt = (const u16*)(ws + (dir ? G_KRTB : G_KRTF)) + (size_t)(hh * 128) * TG + chunk * 128;
      gemm_accum(acc, A, TG, Bt, TG, 128, sA, sB, 0);
#pragma unroll
      for (int j = 0; j < 2; ++j) {
        float* kv = launder((float*)(ws + G_KV) + (size_t)((chunk * 4 + hh) * 2 + dir) * 32768 + (size_t)(mt * 128 + rowb) * 128 + COL_L(j, 0));
#pragma unroll
        for (int i = 0; i < 2; ++i)
#pragma unroll
          for (int reg = 0; reg < 16; ++reg) kv[ROFF(i, reg) * 128] = acc[i][j][reg];
        SCHED_FENCE();
      }
    } else {
      const int tt = t - 1024;
      const int chunk = tt >> 2, hh = tt & 3;
      const u16* A = (const u16*)(ws + G_QR) + (size_t)(chunk * 128) * 512 + hh * 128;
      const u16* Bt = (const u16*)(ws + G_KR) + (size_t)(chunk * 128) * 512 + hh * 128;
      gemm_accum(acc, A, 512, Bt, 512, 128, sA, sB, 0);
      const float lgf = DEC[DEC_LGF + hh], lgb = DEC[DEC_LGB + hh];
      int rbl = rowb;
      asm volatile("" : "+v"(rbl));
#pragma unroll
      for (int j = 0; j < 2; ++j) {
        const int cj = COL_L(j, 0);
        u16* sc = launder((u16*)(ws + G_SC) + (size_t)(chunk * 4 + hh) * 16384 + rowb * 128 + cj);
#pragma unroll
        for (int i = 0; i < 2; ++i)
#pragma unroll
          for (int reg = 0; reg < 16; ++reg) {
            const int ri = rbl + ROFF(i, reg);
            const float dd = (float)(ri - cj);
            const float dec = cj <= ri ? __expf(lgf * dd) : __expf(-lgb * dd);
            sc[ROFF(i, reg) * 128] = f2bf(acc[i][j][reg] * dec);
          }
        SCHED_FENCE();
      }
    }
  }
}

template <int NCH> DI void scan_body(const Params& p, int g, char* ws) {
  const float* DEC = (const float*)(ws + OFF_DEC);
  const float* KV = (const float*)(ws + G_KV);
  u16* SP = (u16*)(ws + G_SP);
  const int nseq = (4096 / 128) / NCH;
  const int total = nseq * 262144;
  for (int e = lbid() * 256 + ltid(); e < total; e += lgdim() * 256) {
    const int idx = e & 32767, hd = (e >> 15) & 7, hh = hd >> 1, dir = hd & 1, seq = e >> 18;
    const int dv = idx >> 7, dk = idx & 127;
    float s = 0.f;
    if (g > 0) s = (dir ? p.state_b : p.state_f)[(size_t)((g - 1) * 4 + hh) * 32768 + dk * 256 + dv];
    const float gc = DEC[(dir ? DEC_GCB : DEC_GCF) + hh];
    const int c0 = seq * NCH;
    const size_t ob = (size_t)(((dir ? c0 + NCH - 1 : c0) * 4 + hh) * 2 + dir) * 32768 + idx;
    const ptrdiff_t stp = (ptrdiff_t)(dir ? -1 : 1) * (4 * 2 * 32768);
    float kvv[NCH];
#pragma unroll
    for (int n = 0; n < NCH; ++n) kvv[n] = KV[ob + n * stp];
#pragma unroll
    for (int n = 0; n < NCH; ++n) {
      SP[ob + n * stp] = f2bf(s);
      s = gc * s + kvv[n];
    }
    if (g == 0) (p.out + (dir ? OUT_RB : OUT_RF))[(size_t)(seq * 4 + hh) * 32768 + dk * 256 + dv] = s;
  }
}
DI void step_scan(const Params& p, int g) {
  char* ws = glaunder(p.ws);
  if (g == 0) scan_body<2>(p, g, ws); else scan_body<32>(p, g, ws);
}

DI void step_retout(const Params& p, char* smem) {
  TILE_COORDS
  char* ws = glaunder(p.ws);
  u16* sA = (u16*)smem; u16* sB = sA + 128 * LDT;
  for (int t = lbid(); t < 512; t += lgdim()) {
    const int chunk = t >> 4, hh = (t >> 2) & 3, nt = t & 3;
    f32x16 acc[2][1];
    zero_acc1(acc);
    gemm_accum_t<1>(acc, (const u16*)(ws + G_SC) + (size_t)(chunk * 4 + hh) * 16384, 128,
                    (const u16*)(ws + G_VRT) + (size_t)(hh * 256 + nt * 64) * TG + chunk * 128, TG, 128, sA, sB, 0);
    gemm_accum_t<1>(acc, (const u16*)(ws + G_QA) + (size_t)(chunk * 128) * 512 + hh * 128, 512,
                    (const u16*)(ws + G_SP) + (size_t)((chunk * 4 + hh) * 2 + 0) * 32768 + (size_t)nt * 64 * 128, 128, 128, sA, sB, 0);
    gemm_accum_t<1>(acc, (const u16*)(ws + G_QB) + (size_t)(chunk * 128) * 512 + hh * 128, 512,
                    (const u16*)(ws + G_SP) + (size_t)((chunk * 4 + hh) * 2 + 1) * 32768 + (size_t)nt * 64 * 128, 128, 128, sA, sB, 0);
    const int rowb = chunk * 128 + wm * 64 + 4 * h;
    float* op = launder((float*)(ws + G_KV) + (size_t)rowb * 1024 + hh * 256 + nt * 64 + wn * 32 + r);
#pragma unroll
    for (int i = 0; i < 2; ++i)
#pragma unroll
      for (int reg = 0; reg < 16; ++reg) op[ROFF(i, reg) * 1024] = acc[i][0][reg];
  }
}

DI void step_gn(const Params& p) {
  const int lane = ltid() & 63, wave = ltid() >> 6;
  const float* OPRE = (const float*)(p.ws + G_KV);
  u16* GR = (u16*)(p.ws + G_GR);
  for (int it = lbid() * 4 + wave; it < TG * 4; it += lgdim() * 4) {
    const int tok = it >> 2, hh = it & 3;
    const size_t o = (size_t)tok * 1024 + hh * 256 + lane * 4;
    const float4 v = *(const float4*)(OPRE + o);
    const float mu = wave_sum(v.x + v.y + v.z + v.w) * (1.f / 256.f);
    const float d0 = v.x - mu, d1 = v.y - mu, d2 = v.z - mu, d3 = v.w - mu;
    const float var = wave_sum(d0 * d0 + d1 * d1 + d2 * d2 + d3 * d3) * (1.f / 256.f);
    const float rstd = rsqrtf(var + 1e-5f);
    const float4 gg = *(const float4*)(p.gn_g + hh * 256 + lane * 4);
    const u32x2 gr = *(const u32x2*)(GR + o);
    u32x2 w;
    w.x = pack2(d0 * rstd * gg.x * bf2f((u16)(gr.x & 0xffff)), d1 * rstd * gg.y * bf2f((u16)(gr.x >> 16)));
    w.y = pack2(d2 * rstd * gg.z * bf2f((u16)(gr.y & 0xffff)), d3 * rstd * gg.w * bf2f((u16)(gr.y >> 16)));
    *(u32x2*)(GR + o) = w;
  }
}

DI void step_branch(const Params& p, char* smem) {
  TILE_COORDS
  char* ws = glaunder(p.ws);
  u16* sA = (u16*)smem; u16* sB = sA + 128 * LDT;
  for (int t = lbid(); t < 512; t += lgdim()) {
    const int ntile = t >> 5, mt = t & 31;
    const int m0 = mt * 128, n0 = ntile * 64;
    const int rowb = m0 + wm * 64 + 4 * h;
    const int col = n0 + wn * 32 + r;
    f32x16 acc[2][1];
    zero_acc1(acc);
    gemm_accum_t<1>(acc, (const u16*)(ws + G_GR) + (size_t)m0 * 1024, 1024, (const u16*)(ws + OFF_WR) + (size_t)n0 * 1024, 1024, 1024, sA, sB, 0);
    {
      const u16* gt = launder((const u16*)(ws + G_GATES) + (size_t)rowb * 2048 + col);
      float* tmp = launder((float*)(ws + G_KV) + (size_t)rowb * 1024 + col);
#pragma unroll
      for (int i = 0; i < 2; ++i)
#pragma unroll
        for (int reg = 0; reg < 16; ++reg) tmp[ROFF(i, reg) * 1024] = acc[i][0][reg] * bf2f(gt[ROFF(i, reg) * 2048]);
      SCHED_FENCE();
    }
    zero_acc1(acc);
    gemm_accum_t<1>(acc, (const u16*)(ws + G_QD) + (size_t)m0 * 1024, 1024, (const u16*)(ws + OFF_WD) + (size_t)n0 * 1024, 1024, 1024, sA, sB, 0);
    {
      const u16* gt = launder((const u16*)(ws + G_GATES) + (size_t)rowb * 2048 + 1024 + col);
      const float* tmp = launder((const float*)(ws + G_KV) + (size_t)rowb * 1024 + col);
      u16* mix = launder((u16*)(ws + G_MIX) + (size_t)rowb * 1024 + col);
#pragma unroll
      for (int i = 0; i < 2; ++i)
#pragma unroll
        for (int reg = 0; reg < 16; ++reg)
          mix[ROFF(i, reg) * 1024] = f2bf(tmp[ROFF(i, reg) * 1024] + acc[i][0][reg] * bf2f(gt[ROFF(i, reg) * 2048]));
      SCHED_FENCE();
    }
  }
}

DI void step_wo(const Params& p, int g, char* smem) {
  TILE_COORDS
  char* ws = glaunder(p.ws);
  u16* sA = (u16*)smem; u16* sB = sA + 128 * LDT;
  const float* gate1 = (const float*)(ws + OFF_MOD) + g * 6144 + 2048;
  for (int t = lbid(); t < 512; t += lgdim()) {
    const int ntile = t >> 5, mt = t & 31;
    const int m0 = mt * 128, n0 = ntile * 64;
    f32x16 acc[2][1];
    zero_acc1(acc);
    gemm_accum_t<1>(acc, (const u16*)(ws + G_MIX) + (size_t)m0 * 1024, 1024, (const u16*)(ws + OFF_WO) + (size_t)n0 * 1024, 1024, 1024, sA, sB, 0);
    const int rowb = g * TG + m0 + wm * 64 + 4 * h;
    const int col = n0 + wn * 32 + r;
    const float g1 = gate1[col];
    const float* xs = launder(xrow(p, rowb) + col);
    float* o = launder(p.out + OUT_Y + (size_t)rowb * D + col);
#pragma unroll
    for (int i = 0; i < 2; ++i)
#pragma unroll
      for (int reg = 0; reg < 16; ++reg) o[ROFF(i, reg) * D] = xs[ROFF(i, reg) * D] + g1 * acc[i][0][reg];
  }
}

DI void step_ffn_up(const Params& p, char* smem) {
  TILE_COORDS
  char* ws = glaunder(p.ws);
  u16* sA = (u16*)smem; u16* sB = sA + 128 * LDT;
  for (int t = lbid(); t < 80 * 44; t += lgdim()) {
    const int ntile = t / 80, mt = t % 80;
    const int m0 = mt * 256, n0 = ntile * 128;
    f32x16 acc[4][2];
    zero_acc4(acc);
    gemm_accum_256(acc, (const u16*)(ws + OFF_HB) + (size_t)m0 * 1024, 1024, 64, 128 * 1024, (const u16*)(ws + OFF_WGU) + (size_t)n0 * 1024, 1024, 64, 1024, sA, 0);
    const int rowb = m0 + wm * 128 + 4 * h;
    u16* act = launder((u16*)(ws + OFF_ACT) + (size_t)rowb * FF + ntile * 64 + 32 * wn + r);
#pragma unroll
    for (int i = 0; i < 4; ++i) {
#pragma unroll
      for (int reg = 0; reg < 16; ++reg) act[ROFF(i, reg) * FF] = f2bf(silu_f(acc[i][0][reg]) * acc[i][1][reg]);
      SCHED_FENCE();
    }
  }
}

DI void step_ffn_down(const Params& p, char* smem) {
  TILE_COORDS
  char* ws = glaunder(p.ws);
  u16* sA = (u16*)smem; u16* sB = sA + 128 * LDT;
  const float* MOD = (const float*)(ws + OFF_MOD);
  for (int t = lbid(); t < 160 * 8; t += lgdim()) {
    const int ntile = t / 160, mt = t % 160;
    const int m0 = mt * 128, n0 = ntile * 128;
    f32x16 acc[2][2];
    zero_acc(acc);
    gemm_accum(acc, (const u16*)(ws + OFF_ACT) + (size_t)m0 * FF, FF, (const u16*)(ws + OFF_WDN) + (size_t)n0 * FF, FF, FF, sA, sB, 0);
    const int mv = m0 < TG ? 0 : 1 + ((m0 - TG) >> 12);
    const float* gate2 = MOD + mv * 6144 + 5120;
    const int rowb = m0 + wm * 64 + 4 * h;
#pragma unroll
    for (int j = 0; j < 2; ++j) {
      const int col = n0 + COL_L(j, 0);
      const float g2 = gate2[col];
      float* o = launder(p.out + OUT_Y + (size_t)rowb * D + col);
#pragma unroll
      for (int i = 0; i < 2; ++i)
#pragma unroll
        for (int reg = 0; reg < 16; ++reg) o[ROFF(i, reg) * D] = o[ROFF(i, reg) * D] + g2 * acc[i][j][reg];
      SCHED_FENCE();
    }
  }
}


#define XB_TMO      128
#define XB_XCNT(j)  (256  + 64 * (j))
#define XB_XSUB(j)  (1280 + 64 * (j))
#define XB_XGEN(j)  (2304 + 64 * (j))
#define XB_TOP      3328
#define XB_TOPGEN   3392
#define XCD_BAR_WORDS 3456
#define XB_SPIN_CAP (1u << 22)
#define LAS __attribute__((address_space(3)))
DI unsigned xb_ld(unsigned* p)              { return __hip_atomic_load(p, __ATOMIC_RELAXED, __HIP_MEMORY_SCOPE_AGENT); }
DI unsigned xb_add(unsigned* p, unsigned v) { return __hip_atomic_fetch_add(p, v, __ATOMIC_RELAXED, __HIP_MEMORY_SCOPE_AGENT); }
DI unsigned xb_xcc_id() { return (unsigned)__builtin_amdgcn_s_getreg((3 << 11) | 20) & 0xFu; }
#define XB_SPIN(cond, bar) do { unsigned _sp = 0; while (cond) { __builtin_amdgcn_s_sleep(1); \
    if ((++_sp & 255u) == 0u) { if (xb_ld(&(bar)[XB_TMO])) break; if (_sp > XB_SPIN_CAP) { atomicAdd(&(bar)[XB_TMO], 1u); break; } } } } while (0)
struct XcdBarrier { unsigned* bar; unsigned x; volatile LAS unsigned* st; };
DI XcdBarrier xcd_barrier_post(unsigned* bar, volatile LAS unsigned* st) {
  XcdBarrier b; b.bar = bar; b.x = xb_xcc_id(); b.st = st;
  if (threadIdx.x == 0) (void)xb_add(&bar[XB_XCNT(b.x)], 1u);
  return b;
}
DI void xcd_barrier_complete(unsigned* bar, unsigned x, unsigned& nloc, unsigned& nx) {
  const unsigned G = gridDim.x * gridDim.y * gridDim.z;
  unsigned sum, cnt, mine, sp = 0u;
  for (;;) {
    sum = 0u; cnt = 0u; mine = 0u;
#pragma unroll
    for (unsigned j = 0; j < 16; ++j) { const unsigned c = xb_ld(&bar[XB_XCNT(j)]); sum += c; cnt += (c > 0u) ? 1u : 0u; mine = (j == x) ? c : mine; }
    if (sum == G) break;
    __builtin_amdgcn_s_sleep(1);
    if ((++sp & 255u) == 0u) { if (xb_ld(&bar[XB_TMO])) break; if (sp > XB_SPIN_CAP) { atomicAdd(&bar[XB_TMO], 1u); break; } }
  }
  nloc = mine > 0u ? mine : 1u; nx = cnt > 0u ? cnt : 1u;
}
DI void xcd_barrier(const XcdBarrier& b) {
  asm volatile("s_waitcnt vmcnt(0)" ::: "memory");
  __syncthreads();
  if (threadIdx.x == 0) {
    unsigned* bar = b.bar;
    __builtin_amdgcn_s_waitcnt(0);
    unsigned nloc = b.st[0], nx = b.st[1];
    if (nloc == 0u) { xcd_barrier_complete(bar, b.x, nloc, nx); b.st[0] = nloc; b.st[1] = nx; }
    const unsigned old = xb_add(&bar[XB_XSUB(b.x)], 1u);
    const unsigned gen = old / nloc;
    if (old + 1u == (gen + 1u) * nloc) {
      __builtin_amdgcn_fence(__ATOMIC_RELEASE, "agent");
      asm volatile("s_waitcnt vmcnt(0)" ::: "memory");
      const unsigned og = xb_add(&bar[XB_TOP], 1u);
      const unsigned tg = og / nx;
      if (og + 1u == (tg + 1u) * nx) xb_add(&bar[XB_TOPGEN], 1u);
      else XB_SPIN(xb_ld(&bar[XB_TOPGEN]) == tg, bar);
      __builtin_amdgcn_fence(__ATOMIC_ACQUIRE, "agent");
      xb_add(&bar[XB_XGEN(b.x)], 1u);
      asm volatile("s_waitcnt vmcnt(0)" ::: "memory");
    } else {
      XB_SPIN(xb_ld(&bar[XB_XGEN(b.x)]) == gen, bar);
      __builtin_amdgcn_fence(__ATOMIC_ACQUIRE, "agent");
      asm volatile("s_waitcnt vmcnt(0)" ::: "memory");
    }
  }
  __syncthreads();
}

constexpr int NSTEPS = 37;

__global__ void __launch_bounds__(256, 2) mega(Params p, int lo, int hi) {
  __shared__ __attribute__((aligned(16))) char smem[SMEM_BYTES];
  __shared__ uint4 xb_words;
  cg::grid_group grid = cg::this_grid();
  if (lo > hi) grid.sync();
  if (threadIdx.x == 0) xb_words = make_uint4(0u, 0u, 0u, 0u);
  __syncthreads();
  XcdBarrier xb = xcd_barrier_post((unsigned*)(p.ws + OFF_BAR), (volatile LAS unsigned*)&xb_words);
  for (int step = lo; step < hi; ++step) {
    if (step == 0) { step_p0(p, smem); if (PROBE_M1) step_p0(p, smem); }
    else if (step == 1) { step_rownorm(p, 0); if (PROBE_M1) step_rownorm(p, 0); }
    else if (step == 2) step_proj(p, 0, smem);
    else if (step < 33) {
      const int g = (step - 3) / 6, s = (step - 3) % 6;
      if (s == 0) step_mix3(p, g, smem);
      else if (s == 1) { step_scan(p, g); if (PROBE_M1) step_scan(p, g); }
      else if (s == 2) { step_retout(p, smem); if (PROBE_M2) step_retout(p, smem); }
      else if (s == 3) step_gn(p);
      else if (s == 4) { step_branch(p, smem); if (PROBE_M2) step_branch(p, smem); }
      else { step_wo(p, g, smem); if (g < 4) step_proj(p, g + 1, smem); }
    } else if (step == 33) { step_rownorm(p, 1); if (PROBE_M1) step_rownorm(p, 1); }
    else if (step == 34) step_ffn_up(p, smem);
    else if (step == 35) step_ffn_down(p, smem);
    else step_rownorm(p, 2);
    if (step + 1 < hi) xcd_barrier(xb);
  }
}

extern "C" void kernel_launch(void* const* d_in, const int* in_sizes, int n_in, void* d_out, int out_size, void* d_ws, size_t ws_size, hipStream_t stream) {
  static int grid_blocks = 0;
  if (!grid_blocks) {
    int dev = 0, cus = 0, per_cu = 0;
    hipGetDevice(&dev);
    hipDeviceGetAttribute(&cus, hipDeviceAttributeMultiprocessorCount, dev);
    hipOccupancyMaxActiveBlocksPerMultiprocessor(&per_cu, mega, 256, 0);
    if (per_cu < 1) per_cu = 1;
    if (per_cu > 2) per_cu = 2;
    grid_blocks = cus * per_cu;
  }
  Params p{};
  const float** f = (const float**)&p;
  for (int i = 0; i < 29; ++i) f[i] = (const float*)d_in[i];
  p.out = (float*)d_out;
  p.ws = (char*)d_ws;
  hipMemsetAsync((char*)d_ws + OFF_BAR, 0, XCD_BAR_WORDS * 4, stream);
#if COOP
  int lo = 0, hi = NSTEPS;
  void* args[] = {&p, &lo, &hi};
  hipError_t e = hipLaunchCooperativeKernel((void*)mega, dim3(grid_blocks), dim3(256), args, 0, stream);
  if (e != hipSuccess) fprintf(stderr, "cooperative launch failed: %s (grid %d)\n", hipGetErrorString(e), grid_blocks);
#else
  for (int s = 0; s < NSTEPS; ++s) hipLaunchKernelGGL(mega, dim3(grid_blocks), dim3(256), 0, stream, p, s, s + 1);
#endif
}
```

```cpp
#include <hip/hip_runtime.h>
#include <hip/hip_cooperative_groups.h>
#include <cstdio>
namespace cg = cooperative_groups;

#ifndef PROBE_M1
#define PROBE_M1 0
#endif
#ifndef PROBE_M2
#define PROBE_M2 0
#endif
#ifndef PROBE_M3
#define PROBE_M3 0
#endif
#ifndef COOP
#define COOP 1
#endif

#define DI __device__ __forceinline__
typedef unsigned short u16;
typedef __attribute__((ext_vector_type(8))) short bf16x8;
typedef __attribute__((ext_vector_type(4))) short s16x4;
typedef __attribute__((ext_vector_type(16))) float f32x16;
typedef __attribute__((ext_vector_type(4))) unsigned u32x4;
typedef __attribute__((ext_vector_type(2))) unsigned u32x2;
#define SCHED_FENCE() asm volatile("" ::: "memory")
#define MFMA(a, b, c) __builtin_amdgcn_mfma_f32_32x32x16_bf16((a), (b), (c), 0, 0, 0)

constexpr int D = 1024;
constexpr int TG = 4096;
constexpr int NG = 5;
constexpr int TT = TG * NG;
constexpr int FF = 2816;
constexpr int WCOLS = 8192;

constexpr size_t OFF_WIN = 0;
constexpr size_t OFF_WR = OFF_WIN + (size_t)8192 * 1024 * 2;
constexpr size_t OFF_WD = OFF_WR + 2097152;
constexpr size_t OFF_WO = OFF_WD + 2097152;
constexpr size_t OFF_WGU = OFF_WO + 2097152;
constexpr size_t OFF_WDN = OFF_WGU + (size_t)5632 * 1024 * 2;
constexpr size_t OFF_MOD = OFF_WDN + (size_t)1024 * 2816 * 2;
constexpr size_t OFF_COSR = OFF_MOD + 122880;
constexpr size_t OFF_SINR = OFF_COSR + 1048576;
constexpr size_t OFF_COSD = OFF_SINR + 1048576;
constexpr size_t OFF_SIND = OFF_COSD + 524288;
constexpr size_t OFF_DEC = OFF_SIND + 524288;
constexpr size_t OFF_KC = OFF_DEC + 16384;
constexpr size_t OFF_VCT = OFF_KC + 2097152;
constexpr size_t OFF_HB = OFF_VCT + 2097152;
constexpr size_t OFF_G = OFF_HB + (size_t)TT * 1024 * 2;
constexpr size_t G_QR = OFF_G;
constexpr size_t G_QA = G_QR + 4194304;
constexpr size_t G_QB = G_QA + 4194304;
constexpr size_t G_KR = G_QB + 4194304;
constexpr size_t G_KRTF = G_KR + 4194304;
constexpr size_t G_KRTB = G_KRTF + 4194304;
constexpr size_t G_VRT = G_KRTB + 4194304;
constexpr size_t G_GR = G_VRT + 8388608;
constexpr size_t G_QD = G_GR + 8388608;
constexpr size_t G_KD = G_QD + 8388608;
constexpr size_t G_VDT = G_KD + 8388608;
constexpr size_t G_GATES = G_VDT + 8388608;
constexpr size_t G_KV = G_GATES + 16777216;
constexpr size_t G_SP = G_KV + 33554432;
constexpr size_t G_SC = G_SP + 16777216;
constexpr size_t G_MIX = G_SC + 4194304;
constexpr size_t G_END = G_MIX + 8388608;
constexpr size_t OFF_BAR = G_END;
constexpr size_t OFF_ACT = OFF_G;
static_assert((size_t)TT * FF * 2 <= G_END - OFF_G, "ACT alias");
static_assert(G_END + 16384 <= (size_t)256 * 1024 * 1024, "ws");

constexpr int DEC_WQF = 0, DEC_WQB = 512, DEC_WKF = 1024, DEC_WKB = 1536, DEC_LGF = 2048, DEC_LGB = 2052, DEC_GCF = 2056, DEC_GCB = 2060, DEC_LAM = 2064;

constexpr size_t OUT_Y = 0;
constexpr size_t OUT_RF = (size_t)TT * 1024;
constexpr size_t OUT_RB = OUT_RF + 2097152;
constexpr size_t OUT_DK = OUT_RB + 2097152;
constexpr size_t OUT_DV = OUT_DK + 4194304;

struct Params {
  const float *x_prompt, *x_sample, *state_f, *state_b, *cache_k, *cache_v, *c, *c_ctx, *norm1_g, *norm2_g, *w_ada, *b_ada, *w_in, *b_gate,
      *decay_f, *decay_b, *gn_g, *w_ret_out, *lq1, *lk1, *lq2, *lk2, *subln_g, *w_diff_out, *w_o, *w_gate, *w_up, *w_down, *final_g;
  float* out;
  char* ws;
};

DI int ltid() { int t = threadIdx.x; asm volatile("" : "+v"(t)); return t; }
DI char* glaunder(char* p) { __attribute__((address_space(1))) char* g = (__attribute__((address_space(1))) char*)p; asm volatile("" : "+s"(g)); return (char*)g; }
DI int lbid() { int b = blockIdx.x; asm volatile("" : "+s"(b)); return b; }
DI int lgdim() { int b = gridDim.x; asm volatile("" : "+s"(b)); return b; }
typedef __bf16 hbf16x2 __attribute__((ext_vector_type(2)));
typedef float f32x2 __attribute__((ext_vector_type(2)));
DI u16 f2bf(float x) { return __builtin_bit_cast(u16, (__bf16)x); }
DI float bf2f(u16 v) { return __uint_as_float(((unsigned)v) << 16); }
DI unsigned pack2(float a, float b) { f32x2 v = {a, b}; return __builtin_bit_cast(unsigned, __builtin_convertvector(v, hbf16x2)); }
DI float silu_f(float x) { return x * __builtin_amdgcn_rcpf(1.f + __expf(-x)); }
DI float sigmoid_f(float x) { return __builtin_amdgcn_rcpf(1.f + __expf(-x)); }
DI float wave_sum(float v) {
#pragma unroll
  for (int o = 32; o > 0; o >>= 1) v += __shfl_xor(v, o, 64);
  return v;
}
DI const float* xrow(const Params& p, int row) { return row < TG ? p.x_prompt + (size_t)row * D : p.x_sample + (size_t)(row - TG) * D; }

constexpr int LDT = 72;
constexpr int SMEM_BYTES = 2 * 2 * 128 * LDT * 2;
constexpr int SMEM_OLD_UNUSED = 0;

template <int NJ>
DI void gemm_accum_t(f32x16 (&acc)[2][NJ], const u16* A, int lda, const u16* Bt, int ldb, int K, u16* sA, u16* sB, int cbmode) {
  constexpr int STG = 2 * 128 * LDT;
  constexpr int NB = 2 * NJ;
  const int tid = ltid(), lane = tid & 63, wave = tid >> 6, wm = wave >> 1, wn = wave & 1, r = lane & 31, h = lane >> 5;
  const int lrow = tid >> 3, lcol = (tid & 7) * 8;
  const u16* ap = A + (size_t)lrow * lda + lcol;
  const u16* bp = Bt + (size_t)lrow * ldb + lcol;
  const int nk = K >> 6;
  u32x4 ra[3][4], rb[3][NB];
#define GEMM_LOAD(SET)                                                                            \
  {                                                                                               \
    _Pragma("unroll") for (int q = 0; q < 4; ++q) ra[SET][q] = *(const u32x4*)(ap + (size_t)(32 * q) * lda);  \
    _Pragma("unroll") for (int q = 0; q < NB; ++q) rb[SET][q] = *(const u32x4*)(bp + (size_t)(32 * q) * ldb); \
    ap += 64; bp += 64;                                                                           \
  }
  GEMM_LOAD(0)
  if (nk > 1) GEMM_LOAD(1)
  if (nk > 2) GEMM_LOAD(2)
  const int cb0 = NJ == 1 ? wn : (cbmode ? wn : 2 * wn), cb1 = cbmode ? wn + 2 : 2 * wn + 1;
  const u16* sa0 = sA + (wm * 64 + r) * LDT + h * 8;
  const u16* sb0 = sB + (cb0 * 32 + r) * LDT + h * 8;
  const u16* sb1 = sB + (cb1 * 32 + r) * LDT + h * 8;
  u16* wa = sA + lrow * LDT + lcol;
  u16* wb = sB + lrow * LDT + lcol;
  __syncthreads();
#pragma unroll
  for (int q = 0; q < 4; ++q) *(u32x4*)(wa + 32 * q * LDT) = ra[0][q];
#pragma unroll
  for (int q = 0; q < NB; ++q) *(u32x4*)(wb + 32 * q * LDT) = rb[0][q];
  __syncthreads();
#define GEMM_ITER(IDX, PAR, SET)                                                                  \
  {                                                                                               \
    const int kk = kt + IDX;                                                                      \
    if (kk + 3 < nk) GEMM_LOAD(SET)                                                               \
                       \
    bf16x8 fa[2][2], fb[2][2];                                                                    \
    fa[0][0] = *(const bf16x8*)(sa0 + PAR * STG);                                                 \
    fa[0][1] = *(const bf16x8*)(sa0 + PAR * STG + 32 * LDT);                                      \
    fb[0][0] = *(const bf16x8*)(sb0 + PAR * STG);                                                 \
    fb[0][1] = *(const bf16x8*)((NJ == 2 ? sb1 : sb0) + PAR * STG);                               \
    _Pragma("unroll") for (int ks = 0; ks < 4; ++ks) {                                            \
      if (ks < 3) {                                                                               \
        fa[(ks + 1) & 1][0] = *(const bf16x8*)(sa0 + PAR * STG + (ks + 1) * 16);                  \
        fa[(ks + 1) & 1][1] = *(const bf16x8*)(sa0 + PAR * STG + 32 * LDT + (ks + 1) * 16);       \
        fb[(ks + 1) & 1][0] = *(const bf16x8*)(sb0 + PAR * STG + (ks + 1) * 16);                  \
        if (NJ == 2) fb[(ks + 1) & 1][1] = *(const bf16x8*)(sb1 + PAR * STG + (ks + 1) * 16);     \
      }                                                                                           \
      __builtin_amdgcn_sched_barrier(0);                                                          \
      acc[0][0] = MFMA(fa[ks & 1][0], fb[ks & 1][0], acc[0][0]);                                  \
      acc[1][0] = MFMA(fa[ks & 1][1], fb[ks & 1][0], acc[1][0]);                                  \
      if (NJ == 2) {                                                                              \
        acc[0][NJ - 1] = MFMA(fa[ks & 1][0], fb[ks & 1][1], acc[0][NJ - 1]);                      \
        acc[1][NJ - 1] = MFMA(fa[ks & 1][1], fb[ks & 1][1], acc[1][NJ - 1]);                      \
      }                                                                                           \
      __builtin_amdgcn_sched_barrier(0);                                                          \
    }                                                                                             \
    if (kk + 1 < nk) {                                                                            \
      _Pragma("unroll") for (int q = 0; q < 4; ++q) *(u32x4*)(wa + (1 - PAR) * STG + 32 * q * LDT) = ra[(SET + 1) % 3][q];  \
      _Pragma("unroll") for (int q = 0; q < NB; ++q) *(u32x4*)(wb + (1 - PAR) * STG + 32 * q * LDT) = rb[(SET + 1) % 3][q]; \
    }                                                                                             \
    __syncthreads();                                                                              \
  }
  for (int kt = 0; kt < nk; kt += 6) {
    GEMM_ITER(0, 0, 0)
    if (kt + 1 < nk) GEMM_ITER(1, 1, 1)
    if (kt + 2 < nk) GEMM_ITER(2, 0, 2)
    if (kt + 3 < nk) GEMM_ITER(3, 1, 0)
    if (kt + 4 < nk) GEMM_ITER(4, 0, 1)
    if (kt + 5 < nk) GEMM_ITER(5, 1, 2)
  }
#undef GEMM_ITER
#undef GEMM_LOAD
}
DI void gemm_accum_256(f32x16 (&acc)[4][2], const u16* A, int a_rs, int a_ks, int a_sub, const u16* Bt, int b_rs, int b_ks, int K, u16* sA, int cbmode) {
  u16* sB = sA + 256 * LDT;
  const int tid = ltid(), lane = tid & 63, wave = tid >> 6, wm = wave >> 1, wn = wave & 1, r = lane & 31, h = lane >> 5;
  const int lrow = tid >> 3, lcol = (tid & 7) * 8;
  const u16* ap = A + (size_t)lrow * a_rs + lcol;
  const u16* bp = Bt + (size_t)lrow * b_rs + lcol;
  const int nk = K >> 6;
  u32x4 ra[8], rb[4];
#define A_OFF(q) ((size_t)((q) >> 2) * a_sub + (size_t)(32 * ((q) & 3)) * a_rs)
#pragma unroll
  for (int q = 0; q < 8; ++q) ra[q] = *(const u32x4*)(ap + A_OFF(q));
#pragma unroll
  for (int q = 0; q < 4; ++q) rb[q] = *(const u32x4*)(bp + (size_t)(32 * q) * b_rs);
  const int cb0 = cbmode ? wn : 2 * wn, cb1 = cbmode ? wn + 2 : 2 * wn + 1;
  const u16* sa0 = sA + (wm * 128 + r) * LDT + h * 8;
  const u16* sb0 = sB + (cb0 * 32 + r) * LDT + h * 8;
  const u16* sb1 = sB + (cb1 * 32 + r) * LDT + h * 8;
  u16* wa = sA + lrow * LDT + lcol;
  u16* wb = sB + lrow * LDT + lcol;
  for (int kt = 0; kt < nk; ++kt) {
    __syncthreads();
#pragma unroll
    for (int q = 0; q < 8; ++q) *(u32x4*)(wa + 32 * q * LDT) = ra[q];
#pragma unroll
    for (int q = 0; q < 4; ++q) *(u32x4*)(wb + 32 * q * LDT) = rb[q];
    __syncthreads();
    if (kt + 1 < nk) {
      ap += a_ks; bp += b_ks;
#pragma unroll
      for (int q = 0; q < 8; ++q) ra[q] = *(const u32x4*)(ap + A_OFF(q));
#pragma unroll
      for (int q = 0; q < 4; ++q) rb[q] = *(const u32x4*)(bp + (size_t)(32 * q) * b_rs);
    }
    bf16x8 fa[4], fb[2][2];
    fb[0][0] = *(const bf16x8*)(sb0);
    fb[0][1] = *(const bf16x8*)(sb1);
#pragma unroll
    for (int i = 0; i < 4; ++i) fa[i] = *(const bf16x8*)(sa0 + i * 32 * LDT);
#pragma unroll
    for (int ks = 0; ks < 4; ++ks) {
      if (ks < 3) {
        fb[(ks + 1) & 1][0] = *(const bf16x8*)(sb0 + (ks + 1) * 16);
        fb[(ks + 1) & 1][1] = *(const bf16x8*)(sb1 + (ks + 1) * 16);
      }
#pragma unroll
      for (int i = 0; i < 4; ++i) {
        __builtin_amdgcn_sched_barrier(0);
        acc[i][0] = MFMA(fa[i], fb[ks & 1][0], acc[i][0]);
        acc[i][1] = MFMA(fa[i], fb[ks & 1][1], acc[i][1]);
        __builtin_amdgcn_sched_barrier(0);
        if (ks < 3) fa[i] = *(const bf16x8*)(sa0 + i * 32 * LDT + (ks + 1) * 16);
      }
    }
  }
}
#undef A_OFF
DI void zero_acc4(f32x16 (&acc)[4][2]) {
#pragma unroll
  for (int i = 0; i < 4; ++i)
#pragma unroll
    for (int j = 0; j < 2; ++j)
#pragma unroll
      for (int e = 0; e < 16; ++e) acc[i][j][e] = 0.f;
}
DI void gemm_accum(f32x16 (&acc)[2][2], const u16* A, int lda, const u16* Bt, int ldb, int K, u16* sA, u16* sB, int cbmode) {
  gemm_accum_t<2>(acc, A, lda, Bt, ldb, K, sA, sB, cbmode);
}
DI void zero_acc1(f32x16 (&acc)[2][1]) {
#pragma unroll
  for (int i = 0; i < 2; ++i)
#pragma unroll
    for (int e = 0; e < 16; ++e) acc[i][0][e] = 0.f;
}

DI void zero_acc(f32x16 (&acc)[2][2]) {
#pragma unroll
  for (int i = 0; i < 2; ++i)
#pragma unroll
    for (int j = 0; j < 2; ++j)
#pragma unroll
      for (int e = 0; e < 16; ++e) acc[i][j][e] = 0.f;
}

#define TILE_COORDS                                                                                  \
  const int tid = ltid(), lane = tid & 63, wave = tid >> 6, wm = wave >> 1, wn = wave & 1;      \
  const int r = lane & 31, h = lane >> 5;                                                            \
  (void)r; (void)h; (void)wm; (void)wn;
#define ROW_L(i, reg) (wm * 64 + (i) * 32 + ((reg) & 3) + 8 * ((reg) >> 2) + 4 * h)
#define COL_L(j, cbmode) (((cbmode) ? (wn + 2 * (j)) : (2 * wn + (j))) * 32 + r)

DI void step_p0(const Params& p, char* smem) {
  const int tid = ltid();
  char* ws = glaunder(p.ws);
  {
    float(*tile)[65] = (float(*)[65])smem;
    constexpr int NT_ALL = 2048 + 768 + 1408 + 704 + 256;
    for (int t = lbid(); t < NT_ALL; t += lgdim()) {
      const float* src; int N; u16* dst; int dld; int mode = 0; int ntl; int tt = t;
      if (tt < 2048) { src = p.w_in; N = 8192; dst = (u16*)(ws + OFF_WIN); dld = 1024; ntl = 128; }
      else if ((tt -= 2048) < 256) { src = p.w_ret_out; N = 1024; dst = (u16*)(ws + OFF_WR); dld = 1024; ntl = 16; }
      else if ((tt -= 256) < 256) { src = p.w_diff_out; N = 1024; dst = (u16*)(ws + OFF_WD); dld = 1024; ntl = 16; }
      else if ((tt -= 256) < 256) { src = p.w_o; N = 1024; dst = (u16*)(ws + OFF_WO); dld = 1024; ntl = 16; }
      else if ((tt -= 256) < 704) { src = p.w_gate; N = FF; dst = (u16*)(ws + OFF_WGU); dld = 1024; mode = 1; ntl = 44; }
      else if ((tt -= 704) < 704) { src = p.w_up; N = FF; dst = (u16*)(ws + OFF_WGU); dld = 1024; mode = 2; ntl = 44; }
      else if ((tt -= 704) < 704) { src = p.w_down; N = 1024; dst = (u16*)(ws + OFF_WDN); dld = FF; ntl = 16; }
      else { tt -= 704; int b = tt >> 6; tt &= 63; src = p.cache_v + (size_t)b * 256 * 1024; N = 1024; dst = (u16*)(ws + OFF_VCT) + (size_t)b * 1024 * 256; dld = 256; ntl = 16; }
      const int kt = tt / ntl, nt = tt % ntl;
      __syncthreads();
#pragma unroll
      for (int q = 0; q < 4; ++q) {
        const int k = (tid >> 4) + 16 * q, n4 = (tid & 15) * 4;
        const float4 v = *(const float4*)(src + (size_t)(kt * 64 + k) * N + nt * 64 + n4);
        tile[k][n4 + 0] = v.x; tile[k][n4 + 1] = v.y; tile[k][n4 + 2] = v.z; tile[k][n4 + 3] = v.w;
      }
      __syncthreads();
#pragma unroll
      for (int q = 0; q < 2; ++q) {
        const int n = (tid >> 3) + 32 * q, k8 = (tid & 7) * 8;
        uint4 o;
        o.x = pack2(tile[k8 + 0][n], tile[k8 + 1][n]);
        o.y = pack2(tile[k8 + 2][n], tile[k8 + 3][n]);
        o.z = pack2(tile[k8 + 4][n], tile[k8 + 5][n]);
        o.w = pack2(tile[k8 + 6][n], tile[k8 + 7][n]);
        const int ng = nt * 64 + n;
        const int drow = mode == 0 ? ng : (64 * (ng >> 5) + (mode == 2 ? 32 : 0) + (ng & 31));
        if (t < 2048) *(uint4*)(dst + ((size_t)((drow >> 7) * 16 + kt) * 128 + (drow & 127)) * 64 + k8) = o;
        else *(uint4*)(dst + (size_t)drow * dld + kt * 64 + k8) = o;
      }
    }
  }
  {
    float* sil = (float*)smem;
    float* red = sil + 5 * 1024;
    float* MOD = (float*)(ws + OFF_MOD);
    for (int t = lbid(); t < 192; t += lgdim()) {
      __syncthreads();
      for (int e = tid; e < 5 * 1024; e += 256) {
        const int v = e >> 10, k = e & 1023;
        const float cv = v == 0 ? p.c_ctx[k] : p.c[(v - 1) * 1024 + k];
        sil[e] = silu_f(cv);
      }
      __syncthreads();
      const int cidx = tid & 31, kg = tid >> 5, n0 = t * 32;
      float a0 = 0, a1 = 0, a2 = 0, a3 = 0, a4 = 0;
      const float* wp = p.w_ada + (size_t)kg * 6144 + n0 + cidx;
      for (int k0 = 0; k0 < 128; k0 += 16) {
        float w[16];
#pragma unroll
        for (int u = 0; u < 16; ++u) w[u] = wp[(size_t)(k0 + u) * (8 * 6144)];
#pragma unroll
        for (int u = 0; u < 16; ++u) {
          const int k = kg + 8 * (k0 + u);
          a0 += sil[k] * w[u]; a1 += sil[1024 + k] * w[u]; a2 += sil[2048 + k] * w[u]; a3 += sil[3072 + k] * w[u]; a4 += sil[4096 + k] * w[u];
        }
      }
      red[(kg * 5 + 0) * 32 + cidx] = a0; red[(kg * 5 + 1) * 32 + cidx] = a1; red[(kg * 5 + 2) * 32 + cidx] = a2;
      red[(kg * 5 + 3) * 32 + cidx] = a3; red[(kg * 5 + 4) * 32 + cidx] = a4;
      __syncthreads();
      if (tid < 160) {
        const int v = tid >> 5, cc = tid & 31;
        float s = p.b_ada[n0 + cc];
#pragma unroll
        for (int g8 = 0; g8 < 8; ++g8) s += red[(g8 * 5 + v) * 32 + cc];
        MOD[v * 6144 + n0 + cc] = s;
      }
    }
  }
  {
    const int gt = lbid() * 256 + tid, gn = lgdim() * 256;
    u16* KC = (u16*)(ws + OFF_KC);
    for (int e = gt; e < 4 * 256 * 1024 / 4; e += gn) {
      const float4 v = *(const float4*)(p.cache_k + (size_t)e * 4);
      uint2 o; o.x = pack2(v.x, v.y); o.y = pack2(v.z, v.w);
      *(uint2*)(KC + (size_t)e * 4) = o;
    }
    float* cosR = (float*)(ws + OFF_COSR); float* sinR = (float*)(ws + OFF_SINR);
    for (int e = gt; e < 4096 * 64; e += gn) {
      const int pos = e >> 6, d = e & 63;
      const int fi = d & 31;
      const float inv = powf(10000.0f, -(float)fi / 32.0f);
      const float pp = d < 32 ? (float)(pos >> 6) : (float)(pos & 63);
      const float ang = pp * inv;
      cosR[e] = cosf(ang); sinR[e] = sinf(ang);
    }
    float* cosD = (float*)(ws + OFF_COSD); float* sinD = (float*)(ws + OFF_SIND);
    for (int e = gt; e < 4096 * 32; e += gn) {
      const int pos = e >> 5, d = e & 31;
      const int fi = d & 15;
      const float inv = powf(10000.0f, -(float)fi / 16.0f);
      const float pp = d < 16 ? (float)(pos >> 6) : (float)(pos & 63);
      const float ang = pp * inv;
      cosD[e] = cosf(ang); sinD[e] = sinf(ang);
    }
  }
  if (lbid() == 0) {
    float* DEC = (float*)(ws + OFF_DEC);
    for (int e = tid; e < 512; e += 256) {
      const int hh = e >> 7, i = e & 127;
      const float df = p.decay_f[hh], db = p.decay_b[hh];
      const float lgf = fminf(df, 0.f) - log1pf(expf(-fabsf(df)));
      const float lgb = fminf(db, 0.f) - log1pf(expf(-fabsf(db)));
      DEC[DEC_WQF + e] = expf(lgf * (float)(i + 1));
      DEC[DEC_WQB + e] = expf(lgb * (float)(128 - i));
      DEC[DEC_WKF + e] = expf(lgf * (float)(127 - i));
      DEC[DEC_WKB + e] = expf(lgb * (float)i);
      if (i == 0) {
        DEC[DEC_LGF + hh] = lgf; DEC[DEC_LGB + hh] = lgb;
        DEC[DEC_GCF + hh] = expf(lgf * 128.f); DEC[DEC_GCB + hh] = expf(lgb * 128.f);
      }
    }
    if (tid < 64) {
      float s1 = p.lq1[tid] * p.lk1[tid], s2 = p.lq2[tid] * p.lk2[tid];
      s1 = wave_sum(s1); s2 = wave_sum(s2);
      if (tid == 0) DEC[DEC_LAM] = expf(s1) - expf(s2) + 0.2f;
    }
  }
}

DI void step_rownorm(const Params& p, int mode) {
  const int lane = ltid() & 63, wave = ltid() >> 6;
  const float* MOD = (const float*)(p.ws + OFF_MOD);
  u16* HB = (u16*)(p.ws + OFF_HB);
  for (int row = lbid() * 4 + wave; row < TT; row += lgdim() * 4) {
    const float* src = mode == 0 ? xrow(p, row) : p.out + OUT_Y + (size_t)row * D;
    float4 v[4];
    float ss = 0.f;
#pragma unroll
    for (int i = 0; i < 4; ++i) {
      v[i] = *(const float4*)(src + lane * 4 + 256 * i);
      ss += v[i].x * v[i].x + v[i].y * v[i].y + v[i].z * v[i].z + v[i].w * v[i].w;
    }
    ss = wave_sum(ss);
    const float rstd = rsqrtf(ss * (1.f / 1024.f) + 1e-6f);
    const int mv = row < TG ? 0 : 1 + ((row - TG) >> 12);
    const float* md = MOD + mv * 6144;
#pragma unroll
    for (int i = 0; i < 4; ++i) {
      const int col = lane * 4 + 256 * i;
      if (mode == 2) {
        const float4 g = *(const float4*)(p.final_g + col);
        float4 o; o.x = v[i].x * rstd * g.x; o.y = v[i].y * rstd * g.y; o.z = v[i].z * rstd * g.z; o.w = v[i].w * rstd * g.w;
        *(float4*)(p.out + OUT_Y + (size_t)row * D + col) = o;
      } else {
        const float4 g = *(const float4*)((mode == 0 ? p.norm1_g : p.norm2_g) + col);
        const float4 sh = *(const float4*)(md + (mode == 0 ? 0 : 3072) + col);
        const float4 sc = *(const float4*)(md + (mode == 0 ? 1024 : 4096) + col);
        uint2 o;
        o.x = pack2(v[i].x * rstd * g.x * (1.f + sc.x) + sh.x, v[i].y * rstd * g.y * (1.f + sc.y) + sh.y);
        o.y = pack2(v[i].z * rstd * g.z * (1.f + sc.z) + sh.z, v[i].w * rstd * g.w * (1.f + sc.w) + sh.w);
        if (mode == 0) *(uint2*)(HB + ((size_t)((row >> 7) * 16 + (col >> 6)) * 128 + (row & 127)) * 64 + (col & 63)) = o;
        else *(uint2*)(HB + (size_t)row * D + col) = o;
      }
    }
  }
}

template <typename T> DI T* launder(T* p) { __attribute__((address_space(1))) T* g = (__attribute__((address_space(1))) T*)p; asm volatile("" : "+v"(g)); return (T*)g; }
#define ROFF(i, reg) ((i) * 32 + ((reg) & 3) + 8 * ((reg) >> 2))

DI void step_proj(const Params& p, int g, char* smem) {
  TILE_COORDS
  char* ws = glaunder(p.ws);
  u16* sA = (u16*)smem; u16* sB = sA + 128 * LDT;
  const u16* HBg = (const u16*)(ws + OFF_HB) + (size_t)g * TG * D;
  const u16* WIN = (const u16*)(ws + OFF_WIN);
  const float* DEC = (const float*)(ws + OFF_DEC);
  const bool lat = g > 0;
  for (int t = lbid(); t < 16 * 64; t += lgdim()) {
    const int nraw = t >> 4, mt = t & 15;
    const int ntile = nraw < 32 ? nraw : 32 + ((nraw - 32 + 16) & 31);
    const int m0 = mt * 256, n0 = ntile * 128;
    const int cbmode = n0 < 1024 ? 1 : 0;
    f32x16 acc[4][2];
    zero_acc4(acc);
    gemm_accum_256(acc, HBg + (size_t)(m0 >> 7) * 16 * 8192, 64, 8192, 16 * 8192, WIN + (size_t)ntile * 16 * 8192, 64, 8192, D, sA, cbmode);
    const int rowb = m0 + wm * 128 + 4 * h;
    if (n0 < 1024) {
      const bool isk = n0 >= 512;
      const int hh = (n0 & 511) >> 7;
      const int d1 = 32 * wn + r;
      const float* cosb = launder((const float*)(ws + OFF_COSR) + (size_t)rowb * 64 + d1);
      const float* sinb = launder((const float*)(ws + OFF_SINR) + (size_t)rowb * 64 + d1);
      const int ib = rowb & 127;
      const float* wfb = launder(DEC + (isk ? DEC_WKF : DEC_WQF) + hh * 128 + ib);
      const float* wbb = launder(DEC + (isk ? DEC_WKB : DEC_WQB) + hh * 128 + ib);
      const size_t o512 = (size_t)rowb * 512 + hh * 128 + d1;
      if (!isk) {
        u16* qr = launder((u16*)(ws + G_QR) + o512); u16* qa = launder((u16*)(ws + G_QA) + o512); u16* qb = launder((u16*)(ws + G_QB) + o512);
#pragma unroll
        for (int i = 0; i < 4; ++i) {
#pragma unroll
          for (int reg = 0; reg < 16; ++reg) {
            const int ro = ROFF(i, reg);
            const float x1 = acc[i][0][reg], x2 = acc[i][1][reg];
            float a = x1, b = x2;
            if (lat) { const float cs = cosb[ro * 64], sn = sinb[ro * 64]; a = x1 * cs - x2 * sn; b = x1 * sn + x2 * cs; }
            const float wf = wfb[ro], wb = wbb[ro];
            qr[ro * 512] = f2bf(a); qr[ro * 512 + 64] = f2bf(b);
            qa[ro * 512] = f2bf(a * wf); qa[ro * 512 + 64] = f2bf(b * wf);
            qb[ro * 512] = f2bf(a * wb); qb[ro * 512 + 64] = f2bf(b * wb);
          }
          SCHED_FENCE();
        }
      } else {
        u16* kr = launder((u16*)(ws + G_KR) + o512);
        const size_t ot = (size_t)(hh * 128 + d1) * TG + rowb;
        u16* kf = launder((u16*)(ws + G_KRTF) + ot); u16* kb = launder((u16*)(ws + G_KRTB) + ot);
#pragma unroll
        for (int i = 0; i < 4; ++i) {
#pragma unroll
          for (int rg = 0; rg < 4; ++rg) {
            float o1[4], o2[4], wf[4], wb[4];
#pragma unroll
            for (int e = 0; e < 4; ++e) {
              const int ro = ROFF(i, rg * 4 + e);
              const float x1 = acc[i][0][rg * 4 + e], x2 = acc[i][1][rg * 4 + e];
              float a = x1, b = x2;
              if (lat) { const float cs = cosb[ro * 64], sn = sinb[ro * 64]; a = x1 * cs - x2 * sn; b = x1 * sn + x2 * cs; }
              a *= 0.08838834764831845f; b *= 0.08838834764831845f;
              wf[e] = wfb[ro]; wb[e] = wbb[ro];
              o1[e] = a; o2[e] = b;
              kr[ro * 512] = f2bf(a); kr[ro * 512 + 64] = f2bf(b);
            }
            const int to = i * 32 + 8 * rg;
            u32x2 v;
            v.x = pack2(o1[0] * wf[0], o1[1] * wf[1]); v.y = pack2(o1[2] * wf[2], o1[3] * wf[3]); *(u32x2*)(kf + to) = v;
            v.x = pack2(o2[0] * wf[0], o2[1] * wf[1]); v.y = pack2(o2[2] * wf[2], o2[3] * wf[3]); *(u32x2*)(kf + to + 64 * TG) = v;
            v.x = pack2(o1[0] * wb[0], o1[1] * wb[1]); v.y = pack2(o1[2] * wb[2], o1[3] * wb[3]); *(u32x2*)(kb + to) = v;
            v.x = pack2(o2[0] * wb[0], o2[1] * wb[1]); v.y = pack2(o2[2] * wb[2], o2[3] * wb[3]); *(u32x2*)(kb + to + 64 * TG) = v;
          }
          SCHED_FENCE();
        }
      }
    } else if (n0 < 2048 || (n0 >= 5120 && n0 < 6144)) {
      const bool isd = n0 >= 5120;
      const int cbase = isd ? n0 - 5120 : n0 - 1024;
#pragma unroll
      for (int j = 0; j < 2; ++j) {
        const int col = cbase + COL_L(j, 0);
        u16* vt = launder((isd ? (u16*)(ws + G_VDT) : (u16*)(ws + G_VRT)) + (size_t)col * TG + rowb);
        float* ov = launder(p.out + OUT_DV + (size_t)rowb * 1024 + col);
#pragma unroll
        for (int i = 0; i < 4; ++i) {
#pragma unroll
          for (int rg = 0; rg < 4; ++rg) {
            u32x2 v;
            v.x = pack2(acc[i][j][rg * 4 + 0], acc[i][j][rg * 4 + 1]);
            v.y = pack2(acc[i][j][rg * 4 + 2], acc[i][j][rg * 4 + 3]);
            *(u32x2*)(vt + i * 32 + 8 * rg) = v;
            if (isd && !lat) {
#pragma unroll
              for (int e = 0; e < 4; ++e) ov[(i * 32 + 8 * rg + e) * 1024] = acc[i][j][rg * 4 + e];
            }
          }
        }
        SCHED_FENCE();
      }
    } else if (n0 < 3072) {
#pragma unroll
      for (int j = 0; j < 2; ++j) {
        u16* gr = launder((u16*)(ws + G_GR) + (size_t)rowb * 1024 + n0 - 2048 + COL_L(j, 0));
#pragma unroll
        for (int i = 0; i < 4; ++i)
#pragma unroll
          for (int reg = 0; reg < 16; ++reg) gr[ROFF(i, reg) * 1024] = f2bf(silu_f(acc[i][j][reg]));
        SCHED_FENCE();
      }
    } else if (n0 < 5120) {
      const bool isk = n0 >= 4096;
      const int cbase = (isk ? n0 - 4096 : n0 - 3072) + 64 * wn + r;
      const float* cosb = launder((const float*)(ws + OFF_COSD) + (size_t)rowb * 32 + r);
      const float* sinb = launder((const float*)(ws + OFF_SIND) + (size_t)rowb * 32 + r);
      u16* dst = launder((isk ? (u16*)(ws + G_KD) : (u16*)(ws + G_QD)) + (size_t)rowb * 1024 + cbase);
      float* ok = launder(p.out + OUT_DK + (size_t)rowb * 1024 + cbase);
      const float qs = isk ? 1.f : 0.125f * 1.4426950408889634f;
#pragma unroll
      for (int i = 0; i < 4; ++i) {
#pragma unroll
        for (int reg = 0; reg < 16; ++reg) {
          const int ro = ROFF(i, reg);
          const float x1 = acc[i][0][reg], x2 = acc[i][1][reg];
          float a = x1, b = x2;
          if (lat) { const float cs = cosb[ro * 32], sn = sinb[ro * 32]; a = x1 * cs - x2 * sn; b = x1 * sn + x2 * cs; }
          else if (isk) { ok[ro * 1024] = x1; ok[ro * 1024 + 32] = x2; }
          dst[ro * 1024] = f2bf(a * qs);
          dst[ro * 1024 + 32] = f2bf(b * qs);
        }
        SCHED_FENCE();
      }
    } else {
#pragma unroll
      for (int j = 0; j < 2; ++j) {
        const int col = n0 - 6144 + COL_L(j, 0);
        const float bg = p.b_gate[col];
        u16* gt = launder((u16*)(ws + G_GATES) + (size_t)rowb * 2048 + col);
#pragma unroll
        for (int i = 0; i < 4; ++i)
#pragma unroll
          for (int reg = 0; reg < 16; ++reg) gt[ROFF(i, reg) * 2048] = f2bf(sigmoid_f(acc[i][j][reg] + bg));
        SCHED_FENCE();
      }
    }
  }
}

constexpr int LDK = 136, LDV = 72, LDC = 132;
DI void attn_item(const Params& p, int g, int item, char* smem, bool dummy = false) {
  const int tid = ltid(), lane = tid & 63, wave = tid >> 6, r = lane & 31, h = lane >> 5;
  const int m = wave >> 1, rw = wave & 1;
  char* ws = glaunder(p.ws);
  u16* sK = (u16*)smem; u16* sV = sK + 64 * LDK;
  float* cmb = (float*)smem;
  const int head = item & 7, rest = item >> 3;
  int q0, kbase, nt0, nt1;
  if (g == 0) { const int seq = rest >> 2; q0 = seq * 256 + (rest & 3) * 64; kbase = seq * 256; nt0 = 4; nt1 = 0; }
  else { q0 = rest * 64; kbase = 0; nt0 = 64; nt1 = 4; }
  u16* QD = (u16*)(ws + G_QD);
  const u16* KD = (const u16*)(ws + G_KD);
  const u16* VDT = (const u16*)(ws + G_VDT);
  const u16* KCb = (const u16*)(ws + OFF_KC) + (size_t)(g > 0 ? g - 1 : 0) * 256 * 1024;
  const u16* VCb = (const u16*)(ws + OFF_VCT) + (size_t)(g > 0 ? g - 1 : 0) * 1024 * 256;
  const float lam = ((const float*)(ws + OFF_DEC))[DEC_LAM];
  const int qrow = q0 + rw * 32 + r;
  bf16x8 qf[4];
#pragma unroll
  for (int ks = 0; ks < 4; ++ks) qf[ks] = *(const bf16x8*)(QD + (size_t)qrow * 1024 + head * 128 + m * 64 + ks * 16 + h * 8);
  f32x16 O[4];
#pragma unroll
  for (int d = 0; d < 4; ++d)
#pragma unroll
    for (int e = 0; e < 16; ++e) O[d][e] = 0.f;
  float mrun = -1e30f, lsum = 0.f;
  const int ntiles = nt0 + nt1;
  constexpr int ASTG = 64 * LDK + 128 * LDV;
  const u16* sKw = sK + r * LDK + m * 64 + h * 8;
  const u16* sVw = sV + r * LDV + 8 * h;
  const int krow_l = tid >> 4;
  const int krow_p = (krow_l & 3) | ((krow_l & 4) << 1) | ((krow_l & 8) >> 1);
  u16* wK = sK + krow_p * LDK + (tid & 15) * 8;
  u16* wV = sV + (tid >> 3) * LDV + (tid & 7) * 8;
  u32x4 rk[4], rv[4];
#define ATTN_LOAD(T)                                                                                                   \
  {                                                                                                                    \
    const u16* kp; const u16* vp; int ldv;                                                                             \
    if ((T) < nt0) { kp = KD + (size_t)(kbase + (T) * 64) * 1024 + head * 128; vp = VDT + (size_t)(head * 128) * TG + kbase + (T) * 64; ldv = TG; } \
    else { const int t2 = (T) - nt0; kp = KCb + (size_t)(t2 * 64) * 1024 + head * 128; vp = VCb + (size_t)(head * 128) * 256 + t2 * 64; ldv = 256; } \
    _Pragma("unroll") for (int q = 0; q < 4; ++q) {                                                                    \
      rk[q] = *(const u32x4*)(kp + (size_t)((tid >> 4) + 16 * q) * 1024 + (tid & 15) * 8);                             \
      rv[q] = *(const u32x4*)(vp + (size_t)((tid >> 3) + 32 * q) * ldv + (tid & 7) * 8);                               \
    }                                                                                                                  \
  }
#define ATTN_STORE(STAGE)                                                                                              \
  {                                                                                                                    \
    _Pragma("unroll") for (int q = 0; q < 4; ++q) {                                                                    \
      *(u32x4*)(wK + (STAGE) * ASTG + 16 * q * LDK) = rk[q];                                                           \
      *(u32x4*)(wV + (STAGE) * ASTG + 32 * q * LDV) = rv[q];                                                           \
    }                                                                                                                  \
  }
  ATTN_LOAD(0)
  __syncthreads();
  ATTN_STORE(0)
  __syncthreads();
  if (ntiles > 1) ATTN_LOAD(1)
  for (int t = 0; t < ntiles; ++t) {
    const int cur = t & 1;
    const u16* sKc = sKw + cur * ASTG;
    const u16* sVc = sVw + cur * ASTG;
    bf16x8 ka[2][4];
#pragma unroll
    for (int kb = 0; kb < 2; ++kb)
#pragma unroll
      for (int ks = 0; ks < 4; ++ks) ka[kb][ks] = *(const bf16x8*)(sKc + kb * 32 * LDK + ks * 16);
    __builtin_amdgcn_sched_barrier(0);
    f32x16 st[2];
#pragma unroll
    for (int e = 0; e < 16; ++e) { st[0][e] = 0.f; st[1][e] = 0.f; }
#pragma unroll
    for (int ks = 0; ks < 4; ++ks) {
      st[0] = MFMA(ka[0][ks], qf[ks], st[0]);
      st[1] = MFMA(ka[1][ks], qf[ks], st[1]);
    }
    bf16x8 va[2][4];
#define ATTN_LOADV(BUF, GI)                                                                       \
  {                                                                                               \
    _Pragma("unroll") for (int d = 0; d < 4; ++d) {                                               \
      va[BUF][d] = *(const bf16x8*)(sVc + d * 32 * LDV + (GI) * 16);                              \
    }                                                                                             \
  }
    ATTN_LOADV(0, 0)
    __builtin_amdgcn_sched_barrier(0);
    float mx = fmaxf(st[0][0], st[1][0]);
#pragma unroll
    for (int e = 1; e < 16; ++e) mx = fmaxf(mx, fmaxf(st[0][e], st[1][e]));
    mx = fmaxf(mx, __shfl_xor(mx, 32, 64));
    if (__any(mx > mrun + 8.0f)) {
      const float mnew = fmaxf(mrun, mx);
      const float alpha = __builtin_amdgcn_exp2f(mrun - mnew);
      mrun = mnew;
      lsum *= alpha;
#pragma unroll
      for (int d = 0; d < 4; ++d)
#pragma unroll
        for (int e = 0; e < 16; ++e) O[d][e] *= alpha;
    }
    float rs = 0.f;
#pragma unroll
    for (int kb = 0; kb < 2; ++kb)
#pragma unroll
      for (int e = 0; e < 16; ++e) { const float pv = __builtin_amdgcn_exp2f(st[kb][e] - mrun); st[kb][e] = pv; rs += pv; }
    rs += __shfl_xor(rs, 32, 64);
    lsum += rs;
    union { bf16x8 v; unsigned u[4]; } pf[4];
#pragma unroll
    for (int gi = 0; gi < 4; ++gi) {
      const int kb = gi >> 1, s2 = gi & 1;
      pf[gi].u[0] = pack2(st[kb][8 * s2 + 0], st[kb][8 * s2 + 1]);
      pf[gi].u[1] = pack2(st[kb][8 * s2 + 2], st[kb][8 * s2 + 3]);
      pf[gi].u[2] = pack2(st[kb][8 * s2 + 4], st[kb][8 * s2 + 5]);
      pf[gi].u[3] = pack2(st[kb][8 * s2 + 6], st[kb][8 * s2 + 7]);
    }
    __builtin_amdgcn_sched_barrier(0);
    __builtin_amdgcn_s_setprio(1);
#pragma unroll
    for (int gi = 0; gi < 4; ++gi) {
      if (gi < 3) ATTN_LOADV((gi + 1) & 1, gi + 1)
      __builtin_amdgcn_sched_barrier(0);
#pragma unroll
      for (int d = 0; d < 4; ++d) O[d] = MFMA(va[gi & 1][d], pf[gi].v, O[d]);
      __builtin_amdgcn_sched_barrier(0);
    }
    __builtin_amdgcn_s_setprio(0);
#undef ATTN_LOADV
    if (t + 1 < ntiles) ATTN_STORE(cur ^ 1)
    __syncthreads();
    if (t + 2 < ntiles) ATTN_LOAD(t + 2)
  }
#undef ATTN_LOAD
#undef ATTN_STORE
  __syncthreads();
  float* crow_p = cmb + (rw * 32 + r) * LDC + 4 * h;
  if (m == 1) {
    const float sc = lam / lsum;
#pragma unroll
    for (int d = 0; d < 4; ++d)
#pragma unroll
      for (int rg = 0; rg < 4; ++rg) {
        float4 v; v.x = O[d][rg * 4 + 0] * sc; v.y = O[d][rg * 4 + 1] * sc; v.z = O[d][rg * 4 + 2] * sc; v.w = O[d][rg * 4 + 3] * sc;
        *(float4*)(crow_p + d * 32 + 8 * rg) = v;
      }
  }
  __syncthreads();
  if (m == 0) {
    const float i0 = 1.f / lsum;
    float ss = 0.f;
#pragma unroll
    for (int d = 0; d < 4; ++d)
#pragma unroll
      for (int rg = 0; rg < 4; ++rg) {
        const float4 c = *(const float4*)(crow_p + d * 32 + 8 * rg);
        const float o0 = O[d][rg * 4 + 0] * i0 - c.x, o1 = O[d][rg * 4 + 1] * i0 - c.y, o2 = O[d][rg * 4 + 2] * i0 - c.z, o3 = O[d][rg * 4 + 3] * i0 - c.w;
        O[d][rg * 4 + 0] = o0; O[d][rg * 4 + 1] = o1; O[d][rg * 4 + 2] = o2; O[d][rg * 4 + 3] = o3;
        ss += o0 * o0 + o1 * o1 + o2 * o2 + o3 * o3;
      }
    ss += __shfl_xor(ss, 32, 64);
    const float rstd = rsqrtf(ss * (1.f / 128.f) + 1e-6f) * 0.8f;
#pragma unroll
    for (int d = 0; d < 4; ++d)
#pragma unroll
      for (int rg = 0; rg < 4; ++rg) {
        const int e0 = d * 32 + 8 * rg + 4 * h;
        const float4 gg = *(const float4*)(p.subln_g + e0);
        u32x2 v;
        v.x = pack2(O[d][rg * 4 + 0] * rstd * gg.x, O[d][rg * 4 + 1] * rstd * gg.y);
        v.y = pack2(O[d][rg * 4 + 2] * rstd * gg.z, O[d][rg * 4 + 3] * rstd * gg.w);
        *(u32x2*)((dummy ? (u16*)(ws + G_SP) : QD) + (size_t)qrow * 1024 + head * 128 + e0) = v;
      }
  }
}

DI void step_mix3(const Params& p, int g, char* smem) {
  TILE_COORDS
  char* ws = glaunder(p.ws);
  u16* sA = (u16*)smem; u16* sB = sA + 128 * LDT;
  const float* DEC = (const float*)(ws + OFF_DEC);
  for (int t = lbid(); t < 512 + 512 + 128; t += lgdim()) {
    if (t < 512) {
#if PROBE_M3
      attn_item(p, g, t, smem, true);
#endif
      attn_item(p, g, t, smem); continue; }
    f32x16 acc[2][2];
    zero_acc(acc);
    const int rowb = wm * 64 + 4 * h;
    if (t < 1024) {
      const int tt = t - 512;
      const int chunk = tt >> 4, hh = (tt >> 2) & 3, dir = (tt >> 1) & 1, mt = tt & 1;
      const u16* A = (const u16*)(ws + G_VRT) + (size_t)(hh * 256 + mt * 128) * TG + chunk * 128;
      const u16* Bt = (const u16*)(ws + (dir ? G_KRTB : G_KRTF)) + (size_t)(hh * 128) * TG + chunk * 128;
      gemm_accum(acc, A, TG, Bt, TG, 128, sA, sB, 0);
#pragma unroll
      for (int j = 0; j < 2; ++j) {
        float* kv = launder((float*)(ws + G_KV) + (size_t)((chunk * 4 + hh) * 2 + dir) * 32768 + (size_t)(mt * 128 + rowb) * 128 + COL_L(j, 0));
#pragma unroll
        for (int i = 0; i < 2; ++i)
#pragma unroll
          for (int reg = 0; reg < 16; ++reg) kv[ROFF(i, reg) * 128] = acc[i][j][reg];
        SCHED_FENCE();
      }
    } else {
      const int tt = t - 1024;
      const int chunk = tt >> 2, hh = tt & 3;
      const u16* A = (const u16*)(ws + G_QR) + (size_t)(chunk * 128) * 512 + hh * 128;
      const u16* Bt = (const u16*)(ws + G_KR) + (size_t)(chunk * 128) * 512 + hh * 128;
      gemm_accum(acc, A, 512, Bt, 512, 128, sA, sB, 0);
      const float lgf = DEC[DEC_LGF + hh], lgb = DEC[DEC_LGB + hh];
      int rbl = rowb;
      asm volatile("" : "+v"(rbl));
#pragma unroll
      for (int j = 0; j < 2; ++j) {
        const int cj = COL_L(j, 0);
        u16* sc = launder((u16*)(ws + G_SC) + (size_t)(chunk * 4 + hh) * 16384 + rowb * 128 + cj);
#pragma unroll
        for (int i = 0; i < 2; ++i)
#pragma unroll
          for (int reg = 0; reg < 16; ++reg) {
            const int ri = rbl + ROFF(i, reg);
            const float dd = (float)(ri - cj);
            const float dec = cj <= ri ? __expf(lgf * dd) : __expf(-lgb * dd);
            sc[ROFF(i, reg) * 128] = f2bf(acc[i][j][reg] * dec);
          }
        SCHED_FENCE();
      }
    }
  }
}

template <int NCH> DI void scan_body(const Params& p, int g, char* ws) {
  const float* DEC = (const float*)(ws + OFF_DEC);
  const float* KV = (const float*)(ws + G_KV);
  u16* SP = (u16*)(ws + G_SP);
  const int nseq = (4096 / 128) / NCH;
  const int total = nseq * 262144;
  for (int e = lbid() * 256 + ltid(); e < total; e += lgdim() * 256) {
    const int idx = e & 32767, hd = (e >> 15) & 7, hh = hd >> 1, dir = hd & 1, seq = e >> 18;
    const int dv = idx >> 7, dk = idx & 127;
    float s = 0.f;
    if (g > 0) s = (dir ? p.state_b : p.state_f)[(size_t)((g - 1) * 4 + hh) * 32768 + dk * 256 + dv];
    const float gc = DEC[(dir ? DEC_GCB : DEC_GCF) + hh];
    const int c0 = seq * NCH;
    const size_t ob = (size_t)(((dir ? c0 + NCH - 1 : c0) * 4 + hh) * 2 + dir) * 32768 + idx;
    const ptrdiff_t stp = (ptrdiff_t)(dir ? -1 : 1) * (4 * 2 * 32768);
    float kvv[NCH];
#pragma unroll
    for (int n = 0; n < NCH; ++n) kvv[n] = KV[ob + n * stp];
#pragma unroll
    for (int n = 0; n < NCH; ++n) {
      SP[ob + n * stp] = f2bf(s);
      s = gc * s + kvv[n];
    }
    if (g == 0) (p.out + (dir ? OUT_RB : OUT_RF))[(size_t)(seq * 4 + hh) * 32768 + dk * 256 + dv] = s;
  }
}
DI void step_scan(const Params& p, int g) {
  char* ws = glaunder(p.ws);
  if (g == 0) scan_body<2>(p, g, ws); else scan_body<32>(p, g, ws);
}

DI void step_retout(const Params& p, char* smem) {
  TILE_COORDS
  char* ws = glaunder(p.ws);
  u16* sA = (u16*)smem; u16* sB = sA + 128 * LDT;
  for (int t = lbid(); t < 512; t += lgdim()) {
    const int chunk = t >> 4, hh = (t >> 2) & 3, nt = t & 3;
    f32x16 acc[2][1];
    zero_acc1(acc);
    gemm_accum_t<1>(acc, (const u16*)(ws + G_SC) + (size_t)(chunk * 4 + hh) * 16384, 128,
                    (const u16*)(ws + G_VRT) + (size_t)(hh * 256 + nt * 64) * TG + chunk * 128, TG, 128, sA, sB, 0);
    gemm_accum_t<1>(acc, (const u16*)(ws + G_QA) + (size_t)(chunk * 128) * 512 + hh * 128, 512,
                    (const u16*)(ws + G_SP) + (size_t)((chunk * 4 + hh) * 2 + 0) * 32768 + (size_t)nt * 64 * 128, 128, 128, sA, sB, 0);
    gemm_accum_t<1>(acc, (const u16*)(ws + G_QB) + (size_t)(chunk * 128) * 512 + hh * 128, 512,
                    (const u16*)(ws + G_SP) + (size_t)((chunk * 4 + hh) * 2 + 1) * 32768 + (size_t)nt * 64 * 128, 128, 128, sA, sB, 0);
    const int rowb = chunk * 128 + wm * 64 + 4 * h;
    float* op = launder((float*)(ws + G_KV) + (size_t)rowb * 1024 + hh * 256 + nt * 64 + wn * 32 + r);
#pragma unroll
    for (int i = 0; i < 2; ++i)
#pragma unroll
      for (int reg = 0; reg < 16; ++reg) op[ROFF(i, reg) * 1024] = acc[i][0][reg];
  }
}

DI void step_gn(const Params& p) {
  const int lane = ltid() & 63, wave = ltid() >> 6;
  const float* OPRE = (const float*)(p.ws + G_KV);
  u16* GR = (u16*)(p.ws + G_GR);
  for (int it = lbid() * 4 + wave; it < TG * 4; it += lgdim() * 4) {
    const int tok = it >> 2, hh = it & 3;
    const size_t o = (size_t)tok * 1024 + hh * 256 + lane * 4;
    const float4 v = *(const float4*)(OPRE + o);
    const float mu = wave_sum(v.x + v.y + v.z + v.w) * (1.f / 256.f);
    const float d0 = v.x - mu, d1 = v.y - mu, d2 = v.z - mu, d3 = v.w - mu;
    const float var = wave_sum(d0 * d0 + d1 * d1 + d2 * d2 + d3 * d3) * (1.f / 256.f);
    const float rstd = rsqrtf(var + 1e-5f);
    const float4 gg = *(const float4*)(p.gn_g + hh * 256 + lane * 4);
    const u32x2 gr = *(const u32x2*)(GR + o);
    u32x2 w;
    w.x = pack2(d0 * rstd * gg.x * bf2f((u16)(gr.x & 0xffff)), d1 * rstd * gg.y * bf2f((u16)(gr.x >> 16)));
    w.y = pack2(d2 * rstd * gg.z * bf2f((u16)(gr.y & 0xffff)), d3 * rstd * gg.w * bf2f((u16)(gr.y >> 16)));
    *(u32x2*)(GR + o) = w;
  }
}

DI void step_branch(const Params& p, char* smem) {
  TILE_COORDS
  char* ws = glaunder(p.ws);
  u16* sA = (u16*)smem; u16* sB = sA + 128 * LDT;
  for (int t = lbid(); t < 512; t += lgdim()) {
    const int ntile = t >> 5, mt = t & 31;
    const int m0 = mt * 128, n0 = ntile * 64;
    const int rowb = m0 + wm * 64 + 4 * h;
    const int col = n0 + wn * 32 + r;
    f32x16 acc[2][1];
    zero_acc1(acc);
    gemm_accum_t<1>(acc, (const u16*)(ws + G_GR) + (size_t)m0 * 1024, 1024, (const u16*)(ws + OFF_WR) + (size_t)n0 * 1024, 1024, 1024, sA, sB, 0);
    {
      const u16* gt = launder((const u16*)(ws + G_GATES) + (size_t)rowb * 2048 + col);
      float* tmp = launder((float*)(ws + G_KV) + (size_t)rowb * 1024 + col);
#pragma unroll
      for (int i = 0; i < 2; ++i)
#pragma unroll
        for (int reg = 0; reg < 16; ++reg) tmp[ROFF(i, reg) * 1024] = acc[i][0][reg] * bf2f(gt[ROFF(i, reg) * 2048]);
      SCHED_FENCE();
    }
    zero_acc1(acc);
    gemm_accum_t<1>(acc, (const u16*)(ws + G_QD) + (size_t)m0 * 1024, 1024, (const u16*)(ws + OFF_WD) + (size_t)n0 * 1024, 1024, 1024, sA, sB, 0);
    {
      const u16* gt = launder((const u16*)(ws + G_GATES) + (size_t)rowb * 2048 + 1024 + col);
      const float* tmp = launder((const float*)(ws + G_KV) + (size_t)rowb * 1024 + col);
      u16* mix = launder((u16*)(ws + G_MIX) + (size_t)rowb * 1024 + col);
#pragma unroll
      for (int i = 0; i < 2; ++i)
#pragma unroll
        for (int reg = 0; reg < 16; ++reg)
          mix[ROFF(i, reg) * 1024] = f2bf(tmp[ROFF(i, reg) * 1024] + acc[i][0][reg] * bf2f(gt[ROFF(i, reg) * 2048]));
      SCHED_FENCE();
    }
  }
}

DI void step_wo(const Params& p, int g, char* smem) {
  TILE_COORDS
  char* ws = glaunder(p.ws);
  u16* sA = (u16*)smem; u16* sB = sA + 128 * LDT;
  const float* gate1 = (const float*)(ws + OFF_MOD) + g * 6144 + 2048;
  for (int t = lbid(); t < 512; t += lgdim()) {
    const int ntile = t >> 5, mt = t & 31;
    const int m0 = mt * 128, n0 = ntile * 64;
    f32x16 acc[2][1];
    zero_acc1(acc);
    gemm_accum_t<1>(acc, (const u16*)(ws + G_MIX) + (size_t)m0 * 1024, 1024, (const u16*)(ws + OFF_WO) + (size_t)n0 * 1024, 1024, 1024, sA, sB, 0);
    const int rowb = g * TG + m0 + wm * 64 + 4 * h;
    const int col = n0 + wn * 32 + r;
    const float g1 = gate1[col];
    const float* xs = launder(xrow(p, rowb) + col);
    float* o = launder(p.out + OUT_Y + (size_t)rowb * D + col);
#pragma unroll
    for (int i = 0; i < 2; ++i)
#pragma unroll
      for (int reg = 0; reg < 16; ++reg) o[ROFF(i, reg) * D] = xs[ROFF(i, reg) * D] + g1 * acc[i][0][reg];
  }
}

DI void step_ffn_up(const Params& p, char* smem) {
  TILE_COORDS
  char* ws = glaunder(p.ws);
  u16* sA = (u16*)smem; u16* sB = sA + 128 * LDT;
  for (int t = lbid(); t < 80 * 44; t += lgdim()) {
    const int ntile = t / 80, mt = t % 80;
    const int m0 = mt * 256, n0 = ntile * 128;
    f32x16 acc[4][2];
    zero_acc4(acc);
    gemm_accum_256(acc, (const u16*)(ws + OFF_HB) + (size_t)m0 * 1024, 1024, 64, 128 * 1024, (const u16*)(ws + OFF_WGU) + (size_t)n0 * 1024, 1024, 64, 1024, sA, 0);
    const int rowb = m0 + wm * 128 + 4 * h;
    u16* act = launder((u16*)(ws + OFF_ACT) + (size_t)rowb * FF + ntile * 64 + 32 * wn + r);
#pragma unroll
    for (int i = 0; i < 4; ++i) {
#pragma unroll
      for (int reg = 0; reg < 16; ++reg) act[ROFF(i, reg) * FF] = f2bf(silu_f(acc[i][0][reg]) * acc[i][1][reg]);
      SCHED_FENCE();
    }
  }
}

DI void step_ffn_down(const Params& p, char* smem) {
  TILE_COORDS
  char* ws = glaunder(p.ws);
  u16* sA = (u16*)smem; u16* sB = sA + 128 * LDT;
  const float* MOD = (const float*)(ws + OFF_MOD);
  for (int t = lbid(); t < 160 * 8; t += lgdim()) {
    const int ntile = t / 160, mt = t % 160;
    const int m0 = mt * 128, n0 = ntile * 128;
    f32x16 acc[2][2];
    zero_acc(acc);
    gemm_accum(acc, (const u16*)(ws + OFF_ACT) + (size_t)m0 * FF, FF, (const u16*)(ws + OFF_WDN) + (size_t)n0 * FF, FF, FF, sA, sB, 0);
    const int mv = m0 < TG ? 0 : 1 + ((m0 - TG) >> 12);
    const float* gate2 = MOD + mv * 6144 + 5120;
    const int rowb = m0 + wm * 64 + 4 * h;
#pragma unroll
    for (int j = 0; j < 2; ++j) {
      const int col = n0 + COL_L(j, 0);
      const float g2 = gate2[col];
      float* o = launder(p.out + OUT_Y + (size_t)rowb * D + col);
#pragma unroll
      for (int i = 0; i < 2; ++i)
#pragma unroll
        for (int reg = 0; reg < 16; ++reg) o[ROFF(i, reg) * D] = o[ROFF(i, reg) * D] + g2 * acc[i][j][reg];
      SCHED_FENCE();
    }
  }
}


#define XB_TMO      128
#define XB_XCNT(j)  (256  + 64 * (j))
#define XB_XSUB(j)  (1280 + 64 * (j))
#define XB_XGEN(j)  (2304 + 64 * (j))
#define XB_TOP      3328
#define XB_TOPGEN   3392
#define XCD_BAR_WORDS 3456
#define XB_SPIN_CAP (1u << 22)
#define LAS __attribute__((address_space(3)))
DI unsigned xb_ld(unsigned* p)              { return __hip_atomic_load(p, __ATOMIC_RELAXED, __HIP_MEMORY_SCOPE_AGENT); }
DI unsigned xb_add(unsigned* p, unsigned v) { return __hip_atomic_fetch_add(p, v, __ATOMIC_RELAXED, __HIP_MEMORY_SCOPE_AGENT); }
DI unsigned xb_xcc_id() { return (unsigned)__builtin_amdgcn_s_getreg((3 << 11) | 20) & 0xFu; }
#define XB_SPIN(cond, bar) do { unsigned _sp = 0; while (cond) { __builtin_amdgcn_s_sleep(1); \
    if ((++_sp & 255u) == 0u) { if (xb_ld(&(bar)[XB_TMO])) break; if (_sp > XB_SPIN_CAP) { atomicAdd(&(bar)[XB_TMO], 1u); break; } } } } while (0)
struct XcdBarrier { unsigned* bar; unsigned x; volatile LAS unsigned* st; };
DI XcdBarrier xcd_barrier_post(unsigned* bar, volatile LAS unsigned* st) {
  XcdBarrier b; b.bar = bar; b.x = xb_xcc_id(); b.st = st;
  if (threadIdx.x == 0) (void)xb_add(&bar[XB_XCNT(b.x)], 1u);
  return b;
}
DI void xcd_barrier_complete(unsigned* bar, unsigned x, unsigned& nloc, unsigned& nx) {
  const unsigned G = gridDim.x * gridDim.y * gridDim.z;
  unsigned sum, cnt, mine, sp = 0u;
  for (;;) {
    sum = 0u; cnt = 0u; mine = 0u;
#pragma unroll
    for (unsigned j = 0; j < 16; ++j) { const unsigned c = xb_ld(&bar[XB_XCNT(j)]); sum += c; cnt += (c > 0u) ? 1u : 0u; mine = (j == x) ? c : mine; }
    if (sum == G) break;
    __builtin_amdgcn_s_sleep(1);
    if ((++sp & 255u) == 0u) { if (xb_ld(&bar[XB_TMO])) break; if (sp > XB_SPIN_CAP) { atomicAdd(&bar[XB_TMO], 1u); break; } }
  }
  nloc = mine > 0u ? mine : 1u; nx = cnt > 0u ? cnt : 1u;
}
DI void xcd_barrier(const XcdBarrier& b) {
  asm volatile("s_waitcnt vmcnt(0)" ::: "memory");
  __syncthreads();
  if (threadIdx.x == 0) {
    unsigned* bar = b.bar;
    __builtin_amdgcn_s_waitcnt(0);
    unsigned nloc = b.st[0], nx = b.st[1];
    if (nloc == 0u) { xcd_barrier_complete(bar, b.x, nloc, nx); b.st[0] = nloc; b.st[1] = nx; }
    const unsigned old = xb_add(&bar[XB_XSUB(b.x)], 1u);
    const unsigned gen = old / nloc;
    if (old + 1u == (gen + 1u) * nloc) {
      __builtin_amdgcn_fence(__ATOMIC_RELEASE, "agent");
      asm volatile("s_waitcnt vmcnt(0)" ::: "memory");
      const unsigned og = xb_add(&bar[XB_TOP], 1u);
      const unsigned tg = og / nx;
      if (og + 1u == (tg + 1u) * nx) xb_add(&bar[XB_TOPGEN], 1u);
      else XB_SPIN(xb_ld(&bar[XB_TOPGEN]) == tg, bar);
      __builtin_amdgcn_fence(__ATOMIC_ACQUIRE, "agent");
      xb_add(&bar[XB_XGEN(b.x)], 1u);
      asm volatile("s_waitcnt vmcnt(0)" ::: "memory");
    } else {
      XB_SPIN(xb_ld(&bar[XB_XGEN(b.x)]) == gen, bar);
      __builtin_amdgcn_fence(__ATOMIC_ACQUIRE, "agent");
      asm volatile("s_waitcnt vmcnt(0)" ::: "memory");
    }
  }
  __syncthreads();
}

constexpr int NSTEPS = 37;

__global__ void __launch_bounds__(256, 2) mega(Params p, int lo, int hi) {
  __shared__ __attribute__((aligned(16))) char smem[SMEM_BYTES];
  __shared__ uint4 xb_words;
  cg::grid_group grid = cg::this_grid();
  if (lo > hi) grid.sync();
  if (threadIdx.x == 0) xb_words = make_uint4(0u, 0u, 0u, 0u);
  __syncthreads();
  XcdBarrier xb = xcd_barrier_post((unsigned*)(p.ws + OFF_BAR), (volatile LAS unsigned*)&xb_words);
  for (int step = lo; step < hi; ++step) {
    if (step == 0) { step_p0(p, smem); if (PROBE_M1) step_p0(p, smem); }
    else if (step == 1) { step_rownorm(p, 0); if (PROBE_M1) step_rownorm(p, 0); }
    else if (step == 2) step_proj(p, 0, smem);
    else if (step < 33) {
      const int g = (step - 3) / 6, s = (step - 3) % 6;
      if (s == 0) step_mix3(p, g, smem);
      else if (s == 1) { step_scan(p, g); if (PROBE_M1) step_scan(p, g); }
      else if (s == 2) { step_retout(p, smem); if (PROBE_M2) step_retout(p, smem); }
      else if (s == 3) step_gn(p);
      else if (s == 4) { step_branch(p, smem); if (PROBE_M2) step_branch(p, smem); }
      else { step_wo(p, g, smem); if (g < 4) step_proj(p, g + 1, smem); }
    } else if (step == 33) { step_rownorm(p, 1); if (PROBE_M1) step_rownorm(p, 1); }
    else if (step == 34) step_ffn_up(p, smem);
    else if (step == 35) step_ffn_down(p, smem);
    else step_rownorm(p, 2);
    if (step + 1 < hi) xcd_barrier(xb);
  }
}

extern "C" void kernel_launch(void* const* d_in, const int* in_sizes, int n_in, void* d_out, int out_size, void* d_ws, size_t ws_size, hipStream_t stream) {
  static int grid_blocks = 0;
  if (!grid_blocks) {
    int dev = 0, cus = 0, per_cu = 0;
    hipGetDevice(&dev);
    hipDeviceGetAttribute(&cus, hipDeviceAttributeMultiprocessorCount, dev);
    hipOccupancyMaxActiveBlocksPerMultiprocessor(&per_cu, mega, 256, 0);
    if (per_cu < 1) per_cu = 1;
    if (per_cu > 2) per_cu = 2;
    grid_blocks = cus * per_cu;
  }
  Params p{};
  const float** f = (const float**)&p;
  for (int i = 0; i < 29; ++i) f[i] = (const float*)d_in[i];
  p.out = (float*)d_out;
  p.ws = (char*)d_ws;
  hipMemsetAsync((char*)d_ws + OFF_BAR, 0, XCD_BAR_WORDS * 4, stream);
#if COOP
  int lo = 0, hi = NSTEPS;
  void* args[] = {&p, &lo, &hi};
  hipError_t e = hipLaunchCooperativeKernel((void*)mega, dim3(grid_blocks), dim3(256), args, 0, stream);
  if (e != hipSuccess) fprintf(stderr, "cooperative launch failed: %s (grid %d)\n", hipGetErrorString(e), grid_blocks);
#else
  for (int s = 0; s < NSTEPS; ++s) hipLaunchKernelGGL(mega, dim3(grid_blocks), dim3(256), 0, stream, p, s, s + 1);
#endif
}
```

```cpp
#include <hip/hip_runtime.h>
#include <hip/hip_cooperative_groups.h>
#include <cstdio>
namespace cg = cooperative_groups;

#ifndef PROBE_M1
#define PROBE_M1 0
#endif
#ifndef PROBE_M2
#define PROBE_M2 0
#endif
#ifndef PROBE_M3
#define PROBE_M3 0
#endif
#ifndef COOP
#define COOP 1
#endif

#define DI __device__ __forceinline__
typedef unsigned short u16;
typedef __attribute__((ext_vector_type(8))) short bf16x8;
typedef __attribute__((ext_vector_type(4))) short s16x4;
typedef __attribute__((ext_vector_type(16))) float f32x16;
typedef __attribute__((ext_vector_type(4))) unsigned u32x4;
typedef __attribute__((ext_vector_type(2))) unsigned u32x2;
#define SCHED_FENCE() asm volatile("" ::: "memory")
#define MFMA(a, b, c) __builtin_amdgcn_mfma_f32_32x32x16_bf16((a), (b), (c), 0, 0, 0)

constexpr int D = 1024;
constexpr int TG = 4096;
constexpr int NG = 5;
constexpr int TT = TG * NG;
constexpr int FF = 2816;
constexpr int WCOLS = 8192;

constexpr size_t OFF_WIN = 0;
constexpr size_t OFF_WR = OFF_WIN + (size_t)8192 * 1024 * 2;
constexpr size_t OFF_WD = OFF_WR + 2097152;
constexpr size_t OFF_WO = OFF_WD + 2097152;
constexpr size_t OFF_WGU = OFF_WO + 2097152;
constexpr size_t OFF_WDN = OFF_WGU + (size_t)5632 * 1024 * 2;
constexpr size_t OFF_MOD = OFF_WDN + (size_t)1024 * 2816 * 2;
constexpr size_t OFF_COSR = OFF_MOD + 122880;
constexpr size_t OFF_SINR = OFF_COSR + 1048576;
constexpr size_t OFF_COSD = OFF_SINR + 1048576;
constexpr size_t OFF_SIND = OFF_COSD + 524288;
constexpr size_t OFF_DEC = OFF_SIND + 524288;
constexpr size_t OFF_KC = OFF_DEC + 16384;
constexpr size_t OFF_VCT = OFF_KC + 2097152;
constexpr size_t OFF_HB = OFF_VCT + 2097152;
constexpr size_t OFF_G = OFF_HB + (size_t)TT * 1024 * 2;
constexpr size_t G_QR = OFF_G;
constexpr size_t G_QA = G_QR + 4194304;
constexpr size_t G_QB = G_QA + 4194304;
constexpr size_t G_KR = G_QB + 4194304;
constexpr size_t G_KRTF = G_KR + 4194304;
constexpr size_t G_KRTB = G_KRTF + 4194304;
constexpr size_t G_VRT = G_KRTB + 4194304;
constexpr size_t G_GR = G_VRT + 8388608;
constexpr size_t G_QD = G_GR + 8388608;
constexpr size_t G_KD = G_QD + 8388608;
constexpr size_t G_VDT = G_KD + 8388608;
constexpr size_t G_GATES = G_VDT + 8388608;
constexpr size_t G_KV = G_GATES + 16777216;
constexpr size_t G_SP = G_KV + 33554432;
constexpr size_t G_SC = G_SP + 16777216;
constexpr size_t G_MIX = G_SC + 4194304;
constexpr size_t G_END = G_MIX + 8388608;
constexpr size_t OFF_BAR = G_END;
constexpr size_t OFF_ACT = OFF_G;
static_assert((size_t)TT * FF * 2 <= G_END - OFF_G, "ACT alias");
static_assert(G_END + 16384 <= (size_t)256 * 1024 * 1024, "ws");

constexpr int DEC_WQF = 0, DEC_WQB = 512, DEC_WKF = 1024, DEC_WKB = 1536, DEC_LGF = 2048, DEC_LGB = 2052, DEC_GCF = 2056, DEC_GCB = 2060, DEC_LAM = 2064;

constexpr size_t OUT_Y = 0;
constexpr size_t OUT_RF = (size_t)TT * 1024;
constexpr size_t OUT_RB = OUT_RF + 2097152;
constexpr size_t OUT_DK = OUT_RB + 2097152;
constexpr size_t OUT_DV = OUT_DK + 4194304;

struct Params {
  const float *x_prompt, *x_sample, *state_f, *state_b, *cache_k, *cache_v, *c, *c_ctx, *norm1_g, *norm2_g, *w_ada, *b_ada, *w_in, *b_gate,
      *decay_f, *decay_b, *gn_g, *w_ret_out, *lq1, *lk1, *lq2, *lk2, *subln_g, *w_diff_out, *w_o, *w_gate, *w_up, *w_down, *final_g;
  float* out;
  char* ws;
};

DI int ltid() { int t = threadIdx.x; asm volatile("" : "+v"(t)); return t; }
DI char* glaunder(char* p) { __attribute__((address_space(1))) char* g = (__attribute__((address_space(1))) char*)p; asm volatile("" : "+s"(g)); return (char*)g; }
DI int lbid() { int b = blockIdx.x; asm volatile("" : "+s"(b)); return b; }
DI int lgdim() { int b = gridDim.x; asm volatile("" : "+s"(b)); return b; }
typedef __bf16 hbf16x2 __attribute__((ext_vector_type(2)));
typedef float f32x2 __attribute__((ext_vector_type(2)));
DI u16 f2bf(float x) { return __builtin_bit_cast(u16, (__bf16)x); }
DI float bf2f(u16 v) { return __uint_as_float(((unsigned)v) << 16); }
DI unsigned pack2(float a, float b) { f32x2 v = {a, b}; return __builtin_bit_cast(unsigned, __builtin_convertvector(v, hbf16x2)); }
DI float silu_f(float x) { return x * __builtin_amdgcn_rcpf(1.f + __expf(-x)); }
DI float sigmoid_f(float x) { return __builtin_amdgcn_rcpf(1.f + __expf(-x)); }
DI float wave_sum(float v) {
#pragma unroll
  for (int o = 32; o > 0; o >>= 1) v += __shfl_xor(v, o, 64);
  return v;
}
DI const float* xrow(const Params& p, int row) { return row < TG ? p.x_prompt + (size_t)row * D : p.x_sample + (size_t)(row - TG) * D; }

constexpr int LDT = 72;
constexpr int SMEM_BYTES = 2 * 2 * 128 * LDT * 2;
constexpr int SMEM_OLD_UNUSED = 0;

template <int NJ>
DI void gemm_accum_t(f32x16 (&acc)[2][NJ], const u16* A, int lda, const u16* Bt, int ldb, int K, u16* sA, u16* sB, int cbmode) {
  constexpr int STG = 2 * 128 * LDT;
  constexpr int NB = 2 * NJ;
  const int tid = ltid(), lane = tid & 63, wave = tid >> 6, wm = wave >> 1, wn = wave & 1, r = lane & 31, h = lane >> 5;
  const int lrow = tid >> 3, lcol = (tid & 7) * 8;
  const u16* ap = A + (size_t)lrow * lda + lcol;
  const u16* bp = Bt + (size_t)lrow * ldb + lcol;
  const int nk = K >> 6;
  u32x4 ra[3][4], rb[3][NB];
#define GEMM_LOAD(SET)                                                                            \
  {                                                                                               \
    _Pragma("unroll") for (int q = 0; q < 4; ++q) ra[SET][q] = *(const u32x4*)(ap + (size_t)(32 * q) * lda);  \
    _Pragma("unroll") for (int q = 0; q < NB; ++q) rb[SET][q] = *(const u32x4*)(bp + (size_t)(32 * q) * ldb); \
    ap += 64; bp += 64;                                                                           \
  }
  GEMM_LOAD(0)
  if (nk > 1) GEMM_LOAD(1)
  if (nk > 2) GEMM_LOAD(2)
  const int cb0 = NJ == 1 ? wn : (cbmode ? wn : 2 * wn), cb1 = cbmode ? wn + 2 : 2 * wn + 1;
  const u16* sa0 = sA + (wm * 64 + r) * LDT + h * 8;
  const u16* sb0 = sB + (cb0 * 32 + r) * LDT + h * 8;
  const u16* sb1 = sB + (cb1 * 32 + r) * LDT + h * 8;
  u16* wa = sA + lrow * LDT + lcol;
  u16* wb = sB + lrow * LDT + lcol;
  __syncthreads();
#pragma unroll
  for (int q = 0; q < 4; ++q) *(u32x4*)(wa + 32 * q * LDT) = ra[0][q];
#pragma unroll
  for (int q = 0; q < NB; ++q) *(u32x4*)(wb + 32 * q * LDT) = rb[0][q];
  __syncthreads();
#define GEMM_ITER(IDX, PAR, SET)                                                                  \
  {                                                                                               \
    const int kk = kt + IDX;                                                                      \
    if (kk + 3 < nk) GEMM_LOAD(SET)                                                               \
                       \
    bf16x8 fa[2][2], fb[2][2];                                                                    \
    fa[0][0] = *(const bf16x8*)(sa0 + PAR * STG);                                                 \
    fa[0][1] = *(const bf16x8*)(sa0 + PAR * STG + 32 * LDT);                                      \
    fb[0][0] = *(const bf16x8*)(sb0 + PAR * STG);                                                 \
    fb[0][1] = *(const bf16x8*)((NJ == 2 ? sb1 : sb0) + PAR * STG);                               \
    _Pragma("unroll") for (int ks = 0; ks < 4; ++ks) {                                            \
      if (ks < 3) {                                                                               \
        fa[(ks + 1) & 1][0] = *(const bf16x8*)(sa0 + PAR * STG + (ks + 1) * 16);                  \
        fa[(ks + 1) & 1][1] = *(const bf16x8*)(sa0 + PAR * STG + 32 * LDT + (ks + 1) * 16);       \
        fb[(ks + 1) & 1][0] = *(const bf16x8*)(sb0 + PAR * STG + (ks + 1) * 16);                  \
        if (NJ == 2) fb[(ks + 1) & 1][1] = *(const bf16x8*)(sb1 + PAR * STG + (ks + 1) * 16);     \
      }                                                                                           \
      __builtin_amdgcn_sched_barrier(0);                                                          \
      acc[0][0] = MFMA(fa[ks & 1][0], fb[ks & 1][0], acc[0][0]);                                  \
      acc[1][0] = MFMA(fa[ks & 1][1], fb[ks & 1][0], acc[1][0]);                                  \
      if (NJ == 2) {                                                                              \
        acc[0][NJ - 1] = MFMA(fa[ks & 1][0], fb[ks & 1][1], acc[0][NJ - 1]);                      \
        acc[1][NJ - 1] = MFMA(fa[ks & 1][1], fb[ks & 1][1], acc[1][NJ - 1]);                      \
      }                                                                                           \
      __builtin_amdgcn_sched_barrier(0);                                                          \
    }                                                                                             \
    if (kk + 1 < nk) {                                                                            \
      _Pragma("unroll") for (int q = 0; q < 4; ++q) *(u32x4*)(wa + (1 - PAR) * STG + 32 * q * LDT) = ra[(SET + 1) % 3][q];  \
      _Pragma("unroll") for (int q = 0; q < NB; ++q) *(u32x4*)(wb + (1 - PAR) * STG + 32 * q * LDT) = rb[(SET + 1) % 3][q]; \
    }                                                                                             \
    __syncthreads();                                                                              \
  }
  for (int kt = 0; kt < nk; kt += 6) {
    GEMM_ITER(0, 0, 0)
    if (kt + 1 < nk) GEMM_ITER(1, 1, 1)
    if (kt + 2 < nk) GEMM_ITER(2, 0, 2)
    if (kt + 3 < nk) GEMM_ITER(3, 1, 0)
    if (kt + 4 < nk) GEMM_ITER(4, 0, 1)
    if (kt + 5 < nk) GEMM_ITER(5, 1, 2)
  }
#undef GEMM_ITER
#undef GEMM_LOAD
}
DI void gemm_accum_256(f32x16 (&acc)[4][2], const u16* A, int a_rs, int a_ks, int a_sub, const u16* Bt, int b_rs, int b_ks, int K, u16* sA, int cbmode) {
  u16* sB = sA + 256 * LDT;
  const int tid = ltid(), lane = tid & 63, wave = tid >> 6, wm = wave >> 1, wn = wave & 1, r = lane & 31, h = lane >> 5;
  const int lrow = tid >> 3, lcol = (tid & 7) * 8;
  const u16* ap = A + (size_t)lrow * a_rs + lcol;
  const u16* bp = Bt + (size_t)lrow * b_rs + lcol;
  const int nk = K >> 6;
  u32x4 ra[8], rb[4];
#define A_OFF(q) ((size_t)((q) >> 2) * a_sub + (size_t)(32 * ((q) & 3)) * a_rs)
#pragma unroll
  for (int q = 0; q < 8; ++q) ra[q] = *(const u32x4*)(ap + A_OFF(q));
#pragma unroll
  for (int q = 0; q < 4; ++q) rb[q] = *(const u32x4*)(bp + (size_t)(32 * q) * b_rs);
  const int cb0 = cbmode ? wn : 2 * wn, cb1 = cbmode ? wn + 2 : 2 * wn + 1;
  const u16* sa0 = sA + (wm * 128 + r) * LDT + h * 8;
  const u16* sb0 = sB + (cb0 * 32 + r) * LDT + h * 8;
  const u16* sb1 = sB + (cb1 * 32 + r) * LDT + h * 8;
  u16* wa = sA + lrow * LDT + lcol;
  u16* wb = sB + lrow * LDT + lcol;
  for (int kt = 0; kt < nk; ++kt) {
    __syncthreads();
#pragma unroll
    for (int q = 0; q < 8; ++q) *(u32x4*)(wa + 32 * q * LDT) = ra[q];
#pragma unroll
    for (int q = 0; q < 4; ++q) *(u32x4*)(wb + 32 * q * LDT) = rb[q];
    __syncthreads();
    if (kt + 1 < nk) {
      ap += a_ks; bp += b_ks;
#pragma unroll
      for (int q = 0; q < 8; ++q) ra[q] = *(const u32x4*)(ap + A_OFF(q));
#pragma unroll
      for (int q = 0; q < 4; ++q) rb[q] = *(const u32x4*)(bp + (size_t)(32 * q) * b_rs);
    }
    bf16x8 fa[4], fb[2][2];
    fb[0][0] = *(const bf16x8*)(sb0);
    fb[0][1] = *(const bf16x8*)(sb1);
#pragma unroll
    for (int i = 0; i < 4; ++i) fa[i] = *(const bf16x8*)(sa0 + i * 32 * LDT);
#pragma unroll
    for (int ks = 0; ks < 4; ++ks) {
      if (ks < 3) {
        fb[(ks + 1) & 1][0] = *(const bf16x8*)(sb0 + (ks + 1) * 16);
        fb[(ks + 1) & 1][1] = *(const bf16x8*)(sb1 + (ks + 1) * 16);
      }
#pragma unroll
      for (int i = 0; i < 4; ++i) {
        __builtin_amdgcn_sched_barrier(0);
        acc[i][0] = MFMA(fa[i], fb[ks & 1][0], acc[i][0]);
        acc[i][1] = MFMA(fa[i], fb[ks & 1][1], acc[i][1]);
        __builtin_amdgcn_sched_barrier(0);
        if (ks < 3) fa[i] = *(const bf16x8*)(sa0 + i * 32 * LDT + (ks + 1) * 16);
      }
    }
  }
}
#undef A_OFF
DI void zero_acc4(f32x16 (&acc)[4][2]) {
#pragma unroll
  for (int i = 0; i < 4; ++i)
#pragma unroll
    for (int j = 0; j < 2; ++j)
#pragma unroll
      for (int e = 0; e < 16; ++e) acc[i][j][e] = 0.f;
}
DI void gemm_accum(f32x16 (&acc)[2][2], const u16* A, int lda, const u16* Bt, int ldb, int K, u16* sA, u16* sB, int cbmode) {
  gemm_accum_t<2>(acc, A, lda, Bt, ldb, K, sA, sB, cbmode);
}
DI void zero_acc1(f32x16 (&acc)[2][1]) {
#pragma unroll
  for (int i = 0; i < 2; ++i)
#pragma unroll
    for (int e = 0; e < 16; ++e) acc[i][0][e] = 0.f;
}

DI void zero_acc(f32x16 (&acc)[2][2]) {
#pragma unroll
  for (int i = 0; i < 2; ++i)
#pragma unroll
    for (int j = 0; j < 2; ++j)
#pragma unroll
      for (int e = 0; e < 16; ++e) acc[i][j][e] = 0.f;
}

#define TILE_COORDS                                                                                  \
  const int tid = ltid(), lane = tid & 63, wave = tid >> 6, wm = wave >> 1, wn = wave & 1;      \
  const int r = lane & 31, h = lane >> 5;                                                            \
  (void)r; (void)h; (void)wm; (void)wn;
#define ROW_L(i, reg) (wm * 64 + (i) * 32 + ((reg) & 3) + 8 * ((reg) >> 2) + 4 * h)
#define COL_L(j, cbmode) (((cbmode) ? (wn + 2 * (j)) : (2 * wn + (j))) * 32 + r)

DI void step_p0(const Params& p, char* smem) {
  const int tid = ltid();
  char* ws = glaunder(p.ws);
  {
    float(*tile)[65] = (float(*)[65])smem;
    constexpr int NT_ALL = 2048 + 768 + 1408 + 704 + 256;
    for (int t = lbid(); t < NT_ALL; t += lgdim()) {
      const float* src; int N; u16* dst; int dld; int mode = 0; int ntl; int tt = t;
      if (tt < 2048) { src = p.w_in; N = 8192; dst = (u16*)(ws + OFF_WIN); dld = 1024; ntl = 128; }
      else if ((tt -= 2048) < 256) { src = p.w_ret_out; N = 1024; dst = (u16*)(ws + OFF_WR); dld = 1024; ntl = 16; }
      else if ((tt -= 256) < 256) { src = p.w_diff_out; N = 1024; dst = (u16*)(ws + OFF_WD); dld = 1024; ntl = 16; }
      else if ((tt -= 256) < 256) { src = p.w_o; N = 1024; dst = (u16*)(ws + OFF_WO); dld = 1024; ntl = 16; }
      else if ((tt -= 256) < 704) { src = p.w_gate; N = FF; dst = (u16*)(ws + OFF_WGU); dld = 1024; mode = 1; ntl = 44; }
      else if ((tt -= 704) < 704) { src = p.w_up; N = FF; dst = (u16*)(ws + OFF_WGU); dld = 1024; mode = 2; ntl = 44; }
      else if ((tt -= 704) < 704) { src = p.w_down; N = 1024; dst = (u16*)(ws + OFF_WDN); dld = FF; ntl = 16; }
      else { tt -= 704; int b = tt >> 6; tt &= 63; src = p.cache_v + (size_t)b * 256 * 1024; N = 1024; dst = (u16*)(ws + OFF_VCT) + (size_t)b * 1024 * 256; dld = 256; ntl = 16; }
      const int kt = tt / ntl, nt = tt % ntl;
      __syncthreads();
#pragma unroll
      for (int q = 0; q < 4; ++q) {
        const int k = (tid >> 4) + 16 * q, n4 = (tid & 15) * 4;
        const float4 v = *(const float4*)(src + (size_t)(kt * 64 + k) * N + nt * 64 + n4);
        tile[k][n4 + 0] = v.x; tile[k][n4 + 1] = v.y; tile[k][n4 + 2] = v.z; tile[k][n4 + 3] = v.w;
      }
      __syncthreads();
#pragma unroll
      for (int q = 0; q < 2; ++q) {
        const int n = (tid >> 3) + 32 * q, k8 = (tid & 7) * 8;
        uint4 o;
        o.x = pack2(tile[k8 + 0][n], tile[k8 + 1][n]);
        o.y = pack2(tile[k8 + 2][n], tile[k8 + 3][n]);
        o.z = pack2(tile[k8 + 4][n], tile[k8 + 5][n]);
        o.w = pack2(tile[k8 + 6][n], tile[k8 + 7][n]);
        const int ng = nt * 64 + n;
        const int drow = mode == 0 ? ng : (64 * (ng >> 5) + (mode == 2 ? 32 : 0) + (ng & 31));
        if (t < 2048) *(uint4*)(dst + ((size_t)((drow >> 7) * 16 + kt) * 128 + (drow & 127)) * 64 + k8) = o;
        else *(uint4*)(dst + (size_t)drow * dld + kt * 64 + k8) = o;
      }
    }
  }
  {
    float* sil = (float*)smem;
    float* red = sil + 5 * 1024;
    float* MOD = (float*)(ws + OFF_MOD);
    for (int t = lbid(); t < 192; t += lgdim()) {
      __syncthreads();
      for (int e = tid; e < 5 * 1024; e += 256) {
        const int v = e >> 10, k = e & 1023;
        const float cv = v == 0 ? p.c_ctx[k] : p.c[(v - 1) * 1024 + k];
        sil[e] = silu_f(cv);
      }
      __syncthreads();
      const int cidx = tid & 31, kg = tid >> 5, n0 = t * 32;
      float a0 = 0, a1 = 0, a2 = 0, a3 = 0, a4 = 0;
      const float* wp = p.w_ada + (size_t)kg * 6144 + n0 + cidx;
      for (int k0 = 0; k0 < 128; k0 += 16) {
        float w[16];
#pragma unroll
        for (int u = 0; u < 16; ++u) w[u] = wp[(size_t)(k0 + u) * (8 * 6144)];
#pragma unroll
        for (int u = 0; u < 16; ++u) {
          const int k = kg + 8 * (k0 + u);
          a0 += sil[k] * w[u]; a1 += sil[1024 + k] * w[u]; a2 += sil[2048 + k] * w[u]; a3 += sil[3072 + k] * w[u]; a4 += sil[4096 + k] * w[u];
        }
      }
      red[(kg * 5 + 0) * 32 + cidx] = a0; red[(kg * 5 + 1) * 32 + cidx] = a1; red[(kg * 5 + 2) * 32 + cidx] = a2;
      red[(kg * 5 + 3) * 32 + cidx] = a3; red[(kg * 5 + 4) * 32 + cidx] = a4;
      __syncthreads();
      if (tid < 160) {
        const int v = tid >> 5, cc = tid & 31;
        float s = p.b_ada[n0 + cc];
#pragma unroll
        for (int g8 = 0; g8 < 8; ++g8) s += red[(g8 * 5 + v) * 32 + cc];
        MOD[v * 6144 + n0 + cc] = s;
      }
    }
  }
  {
    const int gt = lbid() * 256 + tid, gn = lgdim() * 256;
    u16* KC = (u16*)(ws + OFF_KC);
    for (int e = gt; e < 4 * 256 * 1024 / 4; e += gn) {
      const float4 v = *(const float4*)(p.cache_k + (size_t)e * 4);
      uint2 o; o.x = pack2(v.x, v.y); o.y = pack2(v.z, v.w);
      *(uint2*)(KC + (size_t)e * 4) = o;
    }
    float* cosR = (float*)(ws + OFF_COSR); float* sinR = (float*)(ws + OFF_SINR);
    for (int e = gt; e < 4096 * 64; e += gn) {
      const int pos = e >> 6, d = e & 63;
      const int fi = d & 31;
      const float inv = powf(10000.0f, -(float)fi / 32.0f);
      const float pp = d < 32 ? (float)(pos >> 6) : (float)(pos & 63);
      const float ang = pp * inv;
      cosR[e] = cosf(ang); sinR[e] = sinf(ang);
    }
    float* cosD = (float*)(ws + OFF_COSD); float* sinD = (float*)(ws + OFF_SIND);
    for (int e = gt; e < 4096 * 32; e += gn) {
      const int pos = e >> 5, d = e & 31;
      const int fi = d & 15;
      const float inv = powf(10000.0f, -(float)fi / 16.0f);
      const float pp = d < 16 ? (float)(pos >> 6) : (float)(pos & 63);
      const float ang = pp * inv;
      cosD[e] = cosf(ang); sinD[e] = sinf(ang);
    }
  }
  if (lbid() == 0) {
    float* DEC = (float*)(ws + OFF_DEC);
    for (int e = tid; e < 512; e += 256) {
      const int hh = e >> 7, i = e & 127;
      const float df = p.decay_f[hh], db = p.decay_b[hh];
      const float lgf = fminf(df, 0.f) - log1pf(expf(-fabsf(df)));
      const float lgb = fminf(db, 0.f) - log1pf(expf(-fabsf(db)));
      DEC[DEC_WQF + e] = expf(lgf * (float)(i + 1));
      DEC[DEC_WQB + e] = expf(lgb * (float)(128 - i));
      DEC[DEC_WKF + e] = expf(lgf * (float)(127 - i));
      DEC[DEC_WKB + e] = expf(lgb * (float)i);
      if (i == 0) {
        DEC[DEC_LGF + hh] = lgf; DEC[DEC_LGB + hh] = lgb;
        DEC[DEC_GCF + hh] = expf(lgf * 128.f); DEC[DEC_GCB + hh] = expf(lgb * 128.f);
      }
    }
    if (tid < 64) {
      float s1 = p.lq1[tid] * p.lk1[tid], s2 = p.lq2[tid] * p.lk2[tid];
      s1 = wave_sum(s1); s2 = wave_sum(s2);
      if (tid == 0) DEC[DEC_LAM] = expf(s1) - expf(s2) + 0.2f;
    }
  }
}

DI void step_rownorm(const Params& p, int mode) {
  const int lane = ltid() & 63, wave = ltid() >> 6;
  const float* MOD = (const float*)(p.ws + OFF_MOD);
  u16* HB = (u16*)(p.ws + OFF_HB);
  for (int row = lbid() * 4 + wave; row < TT; row += lgdim() * 4) {
    const float* src = mode == 0 ? xrow(p, row) : p.out + OUT_Y + (size_t)row * D;
    float4 v[4];
    float ss = 0.f;
#pragma unroll
    for (int i = 0; i < 4; ++i) {
      v[i] = *(const float4*)(src + lane * 4 + 256 * i);
      ss += v[i].x * v[i].x + v[i].y * v[i].y + v[i].z * v[i].z + v[i].w * v[i].w;
    }
    ss = wave_sum(ss);
    const float rstd = rsqrtf(ss * (1.f / 1024.f) + 1e-6f);
    const int mv = row < TG ? 0 : 1 + ((row - TG) >> 12);
    const float* md = MOD + mv * 6144;
#pragma unroll
    for (int i = 0; i < 4; ++i) {
      const int col = lane * 4 + 256 * i;
      if (mode == 2) {
        const float4 g = *(const float4*)(p.final_g + col);
        float4 o; o.x = v[i].x * rstd * g.x; o.y = v[i].y * rstd * g.y; o.z = v[i].z * rstd * g.z; o.w = v[i].w * rstd * g.w;
        *(float4*)(p.out + OUT_Y + (size_t)row * D + col) = o;
      } else {
        const float4 g = *(const float4*)((mode == 0 ? p.norm1_g : p.norm2_g) + col);
        const float4 sh = *(const float4*)(md + (mode == 0 ? 0 : 3072) + col);
        const float4 sc = *(const float4*)(md + (mode == 0 ? 1024 : 4096) + col);
        uint2 o;
        o.x = pack2(v[i].x * rstd * g.x * (1.f + sc.x) + sh.x, v[i].y * rstd * g.y * (1.f + sc.y) + sh.y);
        o.y = pack2(v[i].z * rstd * g.z * (1.f + sc.z) + sh.z, v[i].w * rstd * g.w * (1.f + sc.w) + sh.w);
        if (mode == 0) *(uint2*)(HB + ((size_t)((row >> 7) * 16 + (col >> 6)) * 128 + (row & 127)) * 64 + (col & 63)) = o;
        else *(uint2*)(HB + (size_t)row * D + col) = o;
      }
    }
  }
}

DI void st_pair_bf16(u16* basep, int ro0, int ld, float a0, float a1, int odd) {
  const float send = odd ? a0 : a1;
  const float recv = __int_as_float(__builtin_amdgcn_mov_dpp(__float_as_int(send), 0xB1, 0xF, 0xF, true));
  const unsigned v = odd ? pack2(recv, a1) : pack2(a0, recv);
  *(unsigned*)(basep + ro0 * ld) = v;
}
template <typename T> DI T* launder(T* p) { __attribute__((address_space(1))) T* g = (__attribute__((address_space(1))) T*)p; asm volatile("" : "+v"(g)); return (T*)g; }
#define ROFF(i, reg) ((i) * 32 + ((reg) & 3) + 8 * ((reg) >> 2))

DI void step_proj(const Params& p, int g, char* smem) {
  TILE_COORDS
  char* ws = glaunder(p.ws);
  u16* sA = (u16*)smem; u16* sB = sA + 128 * LDT;
  const u16* HBg = (const u16*)(ws + OFF_HB) + (size_t)g * TG * D;
  const u16* WIN = (const u16*)(ws + OFF_WIN);
  const float* DEC = (const float*)(ws + OFF_DEC);
  const bool lat = g > 0;
  for (int t = lbid(); t < 16 * 64; t += lgdim()) {
    const int nraw = t >> 4, mt = t & 15;
    const int ntile = nraw < 32 ? nraw : 32 + ((nraw - 32 + 16) & 31);
    const int m0 = mt * 256, n0 = ntile * 128;
    const int cbmode = n0 < 1024 ? 1 : 0;
    f32x16 acc[4][2];
    zero_acc4(acc);
    gemm_accum_256(acc, HBg + (size_t)(m0 >> 7) * 16 * 8192, 64, 8192, 16 * 8192, WIN + (size_t)ntile * 16 * 8192, 64, 8192, D, sA, cbmode);
    const int rowb = m0 + wm * 128 + 4 * h;
    if (n0 < 1024) {
      const bool isk = n0 >= 512;
      const int hh = (n0 & 511) >> 7;
      const int d1 = 32 * wn + r;
      const float* cosb = launder((const float*)(ws + OFF_COSR) + (size_t)rowb * 64 + d1);
      const float* sinb = launder((const float*)(ws + OFF_SINR) + (size_t)rowb * 64 + d1);
      const int ib = rowb & 127;
      const float* wfb = launder(DEC + (isk ? DEC_WKF : DEC_WQF) + hh * 128 + ib);
      const float* wbb = launder(DEC + (isk ? DEC_WKB : DEC_WQB) + hh * 128 + ib);
      const size_t o512 = (size_t)rowb * 512 + hh * 128 + d1;
      if (!isk) {
        u16* qr = launder((u16*)(ws + G_QR) + o512); u16* qa = launder((u16*)(ws + G_QA) + o512); u16* qb = launder((u16*)(ws + G_QB) + o512);
#pragma unroll
        for (int i = 0; i < 4; ++i) {
#pragma unroll
          for (int reg = 0; reg < 16; ++reg) {
            const int ro = ROFF(i, reg);
            const float x1 = acc[i][0][reg], x2 = acc[i][1][reg];
            float a = x1, b = x2;
            if (lat) { const float cs = cosb[ro * 64], sn = sinb[ro * 64]; a = x1 * cs - x2 * sn; b = x1 * sn + x2 * cs; }
            const float wf = wfb[ro], wb = wbb[ro];
            qr[ro * 512] = f2bf(a); qr[ro * 512 + 64] = f2bf(b);
            qa[ro * 512] = f2bf(a * wf); qa[ro * 512 + 64] = f2bf(b * wf);
            qb[ro * 512] = f2bf(a * wb); qb[ro * 512 + 64] = f2bf(b * wb);
          }
          SCHED_FENCE();
        }
      } else {
        u16* kr = launder((u16*)(ws + G_KR) + o512);
        const size_t ot = (size_t)(hh * 128 + d1) * TG + rowb;
        u16* kf = launder((u16*)(ws + G_KRTF) + ot); u16* kb = launder((u16*)(ws + G_KRTB) + ot);
#pragma unroll
        for (int i = 0; i < 4; ++i) {
#pragma unroll
          for (int rg = 0; rg < 4; ++rg) {
            float o1[4], o2[4], wf[4], wb[4];
#pragma unroll
            for (int e = 0; e < 4; ++e) {
              const int ro = ROFF(i, rg * 4 + e);
              const float x1 = acc[i][0][rg * 4 + e], x2 = acc[i][1][rg * 4 + e];
              float a = x1, b = x2;
              if (lat) { const float cs = cosb[ro * 64], sn = sinb[ro * 64]; a = x1 * cs - x2 * sn; b = x1 * sn + x2 * cs; }
              a *= 0.08838834764831845f; b *= 0.08838834764831845f;
              wf[e] = wfb[ro]; wb[e] = wbb[ro];
              o1[e] = a; o2[e] = b;
              kr[ro * 512] = f2bf(a); kr[ro * 512 + 64] = f2bf(b);
            }
            const int to = i * 32 + 8 * rg;
            u32x2 v;
            v.x = pack2(o1[0] * wf[0], o1[1] * wf[1]); v.y = pack2(o1[2] * wf[2], o1[3] * wf[3]); *(u32x2*)(kf + to) = v;
            v.x = pack2(o2[0] * wf[0], o2[1] * wf[1]); v.y = pack2(o2[2] * wf[2], o2[3] * wf[3]); *(u32x2*)(kf + to + 64 * TG) = v;
            v.x = pack2(o1[0] * wb[0], o1[1] * wb[1]); v.y = pack2(o1[2] * wb[2], o1[3] * wb[3]); *(u32x2*)(kb + to) = v;
            v.x = pack2(o2[0] * wb[0], o2[1] * wb[1]); v.y = pack2(o2[2] * wb[2], o2[3] * wb[3]); *(u32x2*)(kb + to + 64 * TG) = v;
          }
          SCHED_FENCE();
        }
      }
    } else if (n0 < 2048 || (n0 >= 5120 && n0 < 6144)) {
      const bool isd = n0 >= 5120;
      const int cbase = isd ? n0 - 5120 : n0 - 1024;
#pragma unroll
      for (int j = 0; j < 2; ++j) {
        const int col = cbase + COL_L(j, 0);
        u16* vt = launder((isd ? (u16*)(ws + G_VDT) : (u16*)(ws + G_VRT)) + (size_t)col * TG + rowb);
        float* ov = launder(p.out + OUT_DV + (size_t)rowb * 1024 + col);
#pragma unroll
        for (int i = 0; i < 4; ++i) {
#pragma unroll
          for (int rg = 0; rg < 4; ++rg) {
            u32x2 v;
            v.x = pack2(acc[i][j][rg * 4 + 0], acc[i][j][rg * 4 + 1]);
            v.y = pack2(acc[i][j][rg * 4 + 2], acc[i][j][rg * 4 + 3]);
            *(u32x2*)(vt + i * 32 + 8 * rg) = v;
            if (isd && !lat) {
#pragma unroll
              for (int e = 0; e < 4; ++e) ov[(i * 32 + 8 * rg + e) * 1024] = acc[i][j][rg * 4 + e];
            }
          }
        }
        SCHED_FENCE();
      }
    } else if (n0 < 3072) {
#pragma unroll
      for (int j = 0; j < 2; ++j) {
        u16* gr = launder((u16*)(ws + G_GR) + (size_t)rowb * 1024 + n0 - 2048 + COL_L(j, 0) + (r & 1) * 1023);
#pragma unroll
        for (int i = 0; i < 4; ++i)
#pragma unroll
          for (int reg = 0; reg < 16; reg += 2) st_pair_bf16(gr, ROFF(i, reg), 1024, silu_f(acc[i][j][reg]), silu_f(acc[i][j][reg + 1]), r & 1);
        SCHED_FENCE();
      }
    } else if (n0 < 5120) {
      const bool isk = n0 >= 4096;
      const int cbase = (isk ? n0 - 4096 : n0 - 3072) + 64 * wn + r;
      const float* cosb = launder((const float*)(ws + OFF_COSD) + (size_t)rowb * 32 + r);
      const float* sinb = launder((const float*)(ws + OFF_SIND) + (size_t)rowb * 32 + r);
      u16* dst = launder((isk ? (u16*)(ws + G_KD) : (u16*)(ws + G_QD)) + (size_t)rowb * 1024 + cbase);
      float* ok = launder(p.out + OUT_DK + (size_t)rowb * 1024 + cbase);
      const float qs = isk ? 1.f : 0.125f * 1.4426950408889634f;
#pragma unroll
      for (int i = 0; i < 4; ++i) {
#pragma unroll
        for (int reg = 0; reg < 16; ++reg) {
          const int ro = ROFF(i, reg);
          const float x1 = acc[i][0][reg], x2 = acc[i][1][reg];
          float a = x1, b = x2;
          if (lat) { const float cs = cosb[ro * 32], sn = sinb[ro * 32]; a = x1 * cs - x2 * sn; b = x1 * sn + x2 * cs; }
          else if (isk) { ok[ro * 1024] = x1; ok[ro * 1024 + 32] = x2; }
          dst[ro * 1024] = f2bf(a * qs);
          dst[ro * 1024 + 32] = f2bf(b * qs);
        }
        SCHED_FENCE();
      }
    } else {
#pragma unroll
      for (int j = 0; j < 2; ++j) {
        const int col = n0 - 6144 + COL_L(j, 0);
        const float bg = p.b_gate[col];
        u16* gt = launder((u16*)(ws + G_GATES) + (size_t)rowb * 2048 + col + (r & 1) * 2047);
#pragma unroll
        for (int i = 0; i < 4; ++i)
#pragma unroll
          for (int reg = 0; reg < 16; reg += 2) st_pair_bf16(gt, ROFF(i, reg), 2048, sigmoid_f(acc[i][j][reg] + bg), sigmoid_f(acc[i][j][reg + 1] + bg), r & 1);
        SCHED_FENCE();
      }
    }
  }
}

constexpr int LDK = 136, LDV = 72, LDC = 132;
DI void attn_item(const Params& p, int g, int item, char* smem, bool dummy = false) {
  const int tid = ltid(), lane = tid & 63, wave = tid >> 6, r = lane & 31, h = lane >> 5;
  const int m = wave >> 1, rw = wave & 1;
  char* ws = glaunder(p.ws);
  u16* sK = (u16*)smem; u16* sV = sK + 64 * LDK;
  float* cmb = (float*)smem;
  const int head = item & 7, rest = item >> 3;
  int q0, kbase, nt0, nt1;
  if (g == 0) { const int seq = rest >> 2; q0 = seq * 256 + (rest & 3) * 64; kbase = seq * 256; nt0 = 4; nt1 = 0; }
  else { q0 = rest * 64; kbase = 0; nt0 = 64; nt1 = 4; }
  u16* QD = (u16*)(ws + G_QD);
  const u16* KD = (const u16*)(ws + G_KD);
  const u16* VDT = (const u16*)(ws + G_VDT);
  const u16* KCb = (const u16*)(ws + OFF_KC) + (size_t)(g > 0 ? g - 1 : 0) * 256 * 1024;
  const u16* VCb = (const u16*)(ws + OFF_VCT) + (size_t)(g > 0 ? g - 1 : 0) * 1024 * 256;
  const float lam = ((const float*)(ws + OFF_DEC))[DEC_LAM];
  const int qrow = q0 + rw * 32 + r;
  bf16x8 qf[4];
#pragma unroll
  for (int ks = 0; ks < 4; ++ks) qf[ks] = *(const bf16x8*)(QD + (size_t)qrow * 1024 + head * 128 + m * 64 + ks * 16 + h * 8);
  f32x16 O[4];
#pragma unroll
  for (int d = 0; d < 4; ++d)
#pragma unroll
    for (int e = 0; e < 16; ++e) O[d][e] = 0.f;
  float mrun = -1e30f, lsum = 0.f;
  const int ntiles = nt0 + nt1;
  constexpr int ASTG = 64 * LDK + 128 * LDV;
  const u16* sKw = sK + r * LDK + m * 64 + h * 8;
  const u16* sVw = sV + r * LDV + 8 * h;
  const int krow_l = tid >> 4;
  const int krow_p = (krow_l & 3) | ((krow_l & 4) << 1) | ((krow_l & 8) >> 1);
  u16* wK = sK + krow_p * LDK + (tid & 15) * 8;
  u16* wV = sV + (tid >> 3) * LDV + (tid & 7) * 8;
  u32x4 rk[4], rv[4];
#define ATTN_LOAD(T)                                                                                                   \
  {                                                                                                                    \
    const u16* kp; const u16* vp; int ldv;                                                                             \
    if ((T) < nt0) { kp = KD + (size_t)(kbase + (T) * 64) * 1024 + head * 128; vp = VDT + (size_t)(head * 128) * TG + kbase + (T) * 64; ldv = TG; } \
    else { const int t2 = (T) - nt0; kp = KCb + (size_t)(t2 * 64) * 1024 + head * 128; vp = VCb + (size_t)(head * 128) * 256 + t2 * 64; ldv = 256; } \
    _Pragma("unroll") for (int q = 0; q < 4; ++q) {                                                                    \
      rk[q] = *(const u32x4*)(kp + (size_t)((tid >> 4) + 16 * q) * 1024 + (tid & 15) * 8);                             \
      rv[q] = *(const u32x4*)(vp + (size_t)((tid >> 3) + 32 * q) * ldv + (tid & 7) * 8);                               \
    }                                                                                                                  \
  }
#define ATTN_STORE(STAGE)                                                                                              \
  {                                                                                                                    \
    _Pragma("unroll") for (int q = 0; q < 4; ++q) {                                                                    \
      *(u32x4*)(wK + (STAGE) * ASTG + 16 * q * LDK) = rk[q];                                                           \
      *(u32x4*)(wV + (STAGE) * ASTG + 32 * q * LDV) = rv[q];                                                           \
    }                                                                                                                  \
  }
  ATTN_LOAD(0)
  __syncthreads();
  ATTN_STORE(0)
  __syncthreads();
  if (ntiles > 1) ATTN_LOAD(1)
  for (int t = 0; t < ntiles; ++t) {
    const int cur = t & 1;
    const u16* sKc = sKw + cur * ASTG;
    const u16* sVc = sVw + cur * ASTG;
    bf16x8 ka[2][4];
#pragma unroll
    for (int kb = 0; kb < 2; ++kb)
#pragma unroll
      for (int ks = 0; ks < 4; ++ks) ka[kb][ks] = *(const bf16x8*)(sKc + kb * 32 * LDK + ks * 16);
    __builtin_amdgcn_sched_barrier(0);
    f32x16 st[2];
#pragma unroll
    for (int e = 0; e < 16; ++e) { st[0][e] = 0.f; st[1][e] = 0.f; }
#pragma unroll
    for (int ks = 0; ks < 4; ++ks) {
      st[0] = MFMA(ka[0][ks], qf[ks], st[0]);
      st[1] = MFMA(ka[1][ks], qf[ks], st[1]);
    }
    bf16x8 va[2][4];
#define ATTN_LOADV(BUF, GI)                                                                       \
  {                                                                                               \
    _Pragma("unroll") for (int d = 0; d < 4; ++d) {                                               \
      va[BUF][d] = *(const bf16x8*)(sVc + d * 32 * LDV + (GI) * 16);                              \
    }                                                                                             \
  }
    ATTN_LOADV(0, 0)
    __builtin_amdgcn_sched_barrier(0);
    float mx = fmaxf(st[0][0], st[1][0]);
#pragma unroll
    for (int e = 1; e < 16; ++e) mx = fmaxf(mx, fmaxf(st[0][e], st[1][e]));
    mx = fmaxf(mx, __shfl_xor(mx, 32, 64));
    if (__any(mx > mrun + 8.0f)) {
      const float mnew = fmaxf(mrun, mx);
      const float alpha = __builtin_amdgcn_exp2f(mrun - mnew);
      mrun = mnew;
      lsum *= alpha;
#pragma unroll
      for (int d = 0; d < 4; ++d)
#pragma unroll
        for (int e = 0; e < 16; ++e) O[d][e] *= alpha;
    }
    float rs = 0.f;
#pragma unroll
    for (int kb = 0; kb < 2; ++kb)
#pragma unroll
      for (int e = 0; e < 16; ++e) { const float pv = __builtin_amdgcn_exp2f(st[kb][e] - mrun); st[kb][e] = pv; rs += pv; }
    rs += __shfl_xor(rs, 32, 64);
    lsum += rs;
    union { bf16x8 v; unsigned u[4]; } pf[4];
#pragma unroll
    for (int gi = 0; gi < 4; ++gi) {
      const int kb = gi >> 1, s2 = gi & 1;
      pf[gi].u[0] = pack2(st[kb][8 * s2 + 0], st[kb][8 * s2 + 1]);
      pf[gi].u[1] = pack2(st[kb][8 * s2 + 2], st[kb][8 * s2 + 3]);
      pf[gi].u[2] = pack2(st[kb][8 * s2 + 4], st[kb][8 * s2 + 5]);
      pf[gi].u[3] = pack2(st[kb][8 * s2 + 6], st[kb][8 * s2 + 7]);
    }
    __builtin_amdgcn_sched_barrier(0);
    __builtin_amdgcn_s_setprio(1);
#pragma unroll
    for (int gi = 0; gi < 4; ++gi) {
      if (gi < 3) ATTN_LOADV((gi + 1) & 1, gi + 1)
      __builtin_amdgcn_sched_barrier(0);
#pragma unroll
      for (int d = 0; d < 4; ++d) O[d] = MFMA(va[gi & 1][d], pf[gi].v, O[d]);
      __builtin_amdgcn_sched_barrier(0);
    }
    __builtin_amdgcn_s_setprio(0);
#undef ATTN_LOADV
    if (t + 1 < ntiles) ATTN_STORE(cur ^ 1)
    __syncthreads();
    if (t + 2 < ntiles) ATTN_LOAD(t + 2)
  }
#undef ATTN_LOAD
#undef ATTN_STORE
  __syncthreads();
  float* crow_p = cmb + (rw * 32 + r) * LDC + 4 * h;
  if (m == 1) {
    const float sc = lam / lsum;
#pragma unroll
    for (int d = 0; d < 4; ++d)
#pragma unroll
      for (int rg = 0; rg < 4; ++rg) {
        float4 v; v.x = O[d][rg * 4 + 0] * sc; v.y = O[d][rg * 4 + 1] * sc; v.z = O[d][rg * 4 + 2] * sc; v.w = O[d][rg * 4 + 3] * sc;
        *(float4*)(crow_p + d * 32 + 8 * rg) = v;
      }
  }
  __syncthreads();
  if (m == 0) {
    const float i0 = 1.f / lsum;
    float ss = 0.f;
#pragma unroll
    for (int d = 0; d < 4; ++d)
#pragma unroll
      for (int rg = 0; rg < 4; ++rg) {
        const float4 c = *(const float4*)(crow_p + d * 32 + 8 * rg);
        const float o0 = O[d][rg * 4 + 0] * i0 - c.x, o1 = O[d][rg * 4 + 1] * i0 - c.y, o2 = O[d][rg * 4 + 2] * i0 - c.z, o3 = O[d][rg * 4 + 3] * i0 - c.w;
        O[d][rg * 4 + 0] = o0; O[d][rg * 4 + 1] = o1; O[d][rg * 4 + 2] = o2; O[d][rg * 4 + 3] = o3;
        ss += o0 * o0 + o1 * o1 + o2 * o2 + o3 * o3;
      }
    ss += __shfl_xor(ss, 32, 64);
    const float rstd = rsqrtf(ss * (1.f / 128.f) + 1e-6f) * 0.8f;
#pragma unroll
    for (int d = 0; d < 4; ++d)
#pragma unroll
      for (int rg = 0; rg < 4; ++rg) {
        const int e0 = d * 32 + 8 * rg + 4 * h;
        const float4 gg = *(const float4*)(p.subln_g + e0);
        u32x2 v;
        v.x = pack2(O[d][rg * 4 + 0] * rstd * gg.x, O[d][rg * 4 + 1] * rstd * gg.y);
        v.y = pack2(O[d][rg * 4 + 2] * rstd * gg.z, O[d][rg * 4 + 3] * rstd * gg.w);
        *(u32x2*)((dummy ? (u16*)(ws + G_SP) : QD) + (size_t)qrow * 1024 + head * 128 + e0) = v;
      }
  }
}

DI void step_mix3(const Params& p, int g, char* smem) {
  TILE_COORDS
  char* ws = glaunder(p.ws);
  u16* sA = (u16*)smem; u16* sB = sA + 128 * LDT;
  const float* DEC = (const float*)(ws + OFF_DEC);
  for (int t = lbid(); t < 512 + 512 + 128; t += lgdim()) {
    if (t < 512) {
#if PROBE_M3
      attn_item(p, g, t, smem, true);
#endif
      attn_item(p, g, t, smem); continue; }
    f32x16 acc[2][2];
    zero_acc(acc);
    const int rowb = wm * 64 + 4 * h;
    if (t < 1024) {
      const int tt = t - 512;
      const int chunk = tt >> 4, hh = (tt >> 2) & 3, dir = (tt >> 1) & 1, mt = tt & 1;
      const u16* A = (const u16*)(ws + G_VRT) + (size_t)(hh * 256 + mt * 128) * TG + chunk * 128;
      const u16* Bt = (const u16*)(ws + (dir ? G_KRTB : G_KRTF)) + (size_t)(hh * 128) * TG + chunk * 128;
      gemm_accum(acc, A, TG, Bt, TG, 128, sA, sB, 0);
#pragma unroll
      for (int j = 0; j < 2; ++j) {
        float* kv = launder((float*)(ws + G_KV) + (size_t)((chunk * 4 + hh) * 2 + dir) * 32768 + (size_t)(mt * 128 + rowb) * 128 + COL_L(j, 0));
#pragma unroll
        for (int i = 0; i < 2; ++i)
#pragma unroll
          for (int reg = 0; reg < 16; ++reg) kv[ROFF(i, reg) * 128] = acc[i][j][reg];
        SCHED_FENCE();
      }
    } else {
      const int tt = t - 1024;
      const int chunk = tt >> 2, hh = tt & 3;
      const u16* A = (const u16*)(ws + G_QR) + (size_t)(chunk * 128) * 512 + hh * 128;
      const u16* Bt = (const u16*)(ws + G_KR) + (size_t)(chunk * 128) * 512 + hh * 128;
      gemm_accum(acc, A, 512, Bt, 512, 128, sA, sB, 0);
      const float lgf = DEC[DEC_LGF + hh], lgb = DEC[DEC_LGB + hh];
      int rbl = rowb;
      asm volatile("" : "+v"(rbl));
#pragma unroll
      for (int j = 0; j < 2; ++j) {
        const int cj = COL_L(j, 0);
        u16* sc = launder((u16*)(ws + G_SC) + (size_t)(chunk * 4 + hh) * 16384 + rowb * 128 + cj);
#pragma unroll
        for (int i = 0; i < 2; ++i)
#pragma unroll
          for (int reg = 0; reg < 16; ++reg) {
            const int ri = rbl + ROFF(i, reg);
            const float dd = (float)(ri - cj);
            const float dec = cj <= ri ? __expf(lgf * dd) : __expf(-lgb * dd);
            sc[ROFF(i, reg) * 128] = f2bf(acc[i][j][reg] * dec);
          }
        SCHED_FENCE();
      }
    }
  }
}

template <int NCH> DI void scan_body(const Params& p, int g, char* ws) {
  const float* DEC = (const float*)(ws + OFF_DEC);
  const float* KV = (const float*)(ws + G_KV);
  u16* SP = (u16*)(ws + G_SP);
  const int nseq = (4096 / 128) / NCH;
  const int total = nseq * 262144;
  for (int e = lbid() * 256 + ltid(); e < total; e += lgdim() * 256) {
    const int idx = e & 32767, hd = (e >> 15) & 7, hh = hd >> 1, dir = hd & 1, seq = e >> 18;
    const int dv = idx >> 7, dk = idx & 127;
    float s = 0.f;
    if (g > 0) s = (dir ? p.state_b : p.state_f)[(size_t)((g - 1) * 4 + hh) * 32768 + dk * 256 + dv];
    const float gc = DEC[(dir ? DEC_GCB : DEC_GCF) + hh];
    const int c0 = seq * NCH;
    const size_t ob = (size_t)(((dir ? c0 + NCH - 1 : c0) * 4 + hh) * 2 + dir) * 32768 + idx;
    const ptrdiff_t stp = (ptrdiff_t)(dir ? -1 : 1) * (4 * 2 * 32768);
    float kvv[NCH];
#pragma unroll
    for (int n = 0; n < NCH; ++n) kvv[n] = KV[ob + n * stp];
#pragma unroll
    for (int n = 0; n < NCH; ++n) {
      SP[ob + n * stp] = f2bf(s);
      s = gc * s + kvv[n];
    }
    if (g == 0) (p.out + (dir ? OUT_RB : OUT_RF))[(size_t)(seq * 4 + hh) * 32768 + dk * 256 + dv] = s;
  }
}
DI void step_scan(const Params& p, int g) {
  char* ws = glaunder(p.ws);
  if (g == 0) scan_body<2>(p, g, ws); else scan_body<32>(p, g, ws);
}

DI void step_retout(const Params& p, char* smem) {
  TILE_COORDS
  char* ws = glaunder(p.ws);
  u16* sA = (u16*)smem; u16* sB = sA + 128 * LDT;
  for (int t = lbid(); t < 512; t += lgdim()) {
    const int chunk = t >> 4, hh = (t >> 2) & 3, nt = t & 3;
    f32x16 acc[2][1];
    zero_acc1(acc);
    gemm_accum_t<1>(acc, (const u16*)(ws + G_SC) + (size_t)(chunk * 4 + hh) * 16384, 128,
                    (const u16*)(ws + G_VRT) + (size_t)(hh * 256 + nt * 64) * TG + chunk * 128, TG, 128, sA, sB, 0);
    gemm_accum_t<1>(acc, (const u16*)(ws + G_QA) + (size_t)(chunk * 128) * 512 + hh * 128, 512,
                    (const u16*)(ws + G_SP) + (size_t)((chunk * 4 + hh) * 2 + 0) * 32768 + (size_t)nt * 64 * 128, 128, 128, sA, sB, 0);
    gemm_accum_t<1>(acc, (const u16*)(ws + G_QB) + (size_t)(chunk * 128) * 512 + hh * 128, 512,
                    (const u16*)(ws + G_SP) + (size_t)((chunk * 4 + hh) * 2 + 1) * 32768 + (size_t)nt * 64 * 128, 128, 128, sA, sB, 0);
    const int rowb = chunk * 128 + wm * 64 + 4 * h;
    float* op = launder((float*)(ws + G_KV) + (size_t)rowb * 1024 + hh * 256 + nt * 64 + wn * 32 + r);
#pragma unroll
    for (int i = 0; i < 2; ++i)
#pragma unroll
      for (int reg = 0; reg < 16; ++reg) op[ROFF(i, reg) * 1024] = acc[i][0][reg];
  }
}

DI void step_gn(const Params& p) {
  const int lane = ltid() & 63, wave = ltid() >> 6;
  const float* OPRE = (const float*)(p.ws + G_KV);
  u16* GR = (u16*)(p.ws + G_GR);
  for (int it = lbid() * 4 + wave; it < TG * 4; it += lgdim() * 4) {
    const int tok = it >> 2, hh = it & 3;
    const size_t o = (size_t)tok * 1024 + hh * 256 + lane * 4;
    const float4 v = *(const float4*)(OPRE + o);
    const float mu = wave_sum(v.x + v.y + v.z + v.w) * (1.f / 256.f);
    const float d0 = v.x - mu, d1 = v.y - mu, d2 = v.z - mu, d3 = v.w - mu;
    const float var = wave_sum(d0 * d0 + d1 * d1 + d2 * d2 + d3 * d3) * (1.f / 256.f);
    const float rstd = rsqrtf(var + 1e-5f);
    const float4 gg = *(const float4*)(p.gn_g + hh * 256 + lane * 4);
    const u32x2 gr = *(const u32x2*)(GR + o);
    u32x2 w;
    w.x = pack2(d0 * rstd * gg.x * bf2f((u16)(gr.x & 0xffff)), d1 * rstd * gg.y * bf2f((u16)(gr.x >> 16)));
    w.y = pack2(d2 * rstd * gg.z * bf2f((u16)(gr.y & 0xffff)), d3 * rstd * gg.w * bf2f((u16)(gr.y >> 16)));
    *(u32x2*)(GR + o) = w;
  }
}

DI void step_branch(const Params& p, char* smem) {
  TILE_COORDS
  char* ws = glaunder(p.ws);
  u16* sA = (u16*)smem; u16* sB = sA + 128 * LDT;
  for (int t = lbid(); t < 512; t += lgdim()) {
    const int ntile = t >> 5, mt = t & 31;
    const int m0 = mt * 128, n0 = ntile * 64;
    const int rowb = m0 + wm * 64 + 4 * h;
    const int col = n0 + wn * 32 + r;
    f32x16 acc[2][1];
    zero_acc1(acc);
    gemm_accum_t<1>(acc, (const u16*)(ws + G_GR) + (size_t)m0 * 1024, 1024, (const u16*)(ws + OFF_WR) + (size_t)n0 * 1024, 1024, 1024, sA, sB, 0);
    {
      const u16* gt = launder((const u16*)(ws + G_GATES) + (size_t)rowb * 2048 + col);
      float* tmp = launder((float*)(ws + G_KV) + (size_t)rowb * 1024 + col);
#pragma unroll
      for (int i = 0; i < 2; ++i)
#pragma unroll
        for (int reg = 0; reg < 16; ++reg) tmp[ROFF(i, reg) * 1024] = acc[i][0][reg] * bf2f(gt[ROFF(i, reg) * 2048]);
      SCHED_FENCE();
    }
    zero_acc1(acc);
    gemm_accum_t<1>(acc, (const u16*)(ws + G_QD) + (size_t)m0 * 1024, 1024, (const u16*)(ws + OFF_WD) + (size_t)n0 * 1024, 1024, 1024, sA, sB, 0);
    {
      const u16* gt = launder((const u16*)(ws + G_GATES) + (size_t)rowb * 2048 + 1024 + col);
      const float* tmp = launder((const float*)(ws + G_KV) + (size_t)rowb * 1024 + col);
      u16* mix = launder((u16*)(ws + G_MIX) + (size_t)rowb * 1024 + col + (r & 1) * 1023);
#pragma unroll
      for (int i = 0; i < 2; ++i)
#pragma unroll
        for (int reg = 0; reg < 16; reg += 2)
          st_pair_bf16(mix, ROFF(i, reg), 1024, tmp[ROFF(i, reg) * 1024] + acc[i][0][reg] * bf2f(gt[ROFF(i, reg) * 2048]),
                       tmp[ROFF(i, reg + 1) * 1024] + acc[i][0][reg + 1] * bf2f(gt[ROFF(i, reg + 1) * 2048]), r & 1);
      SCHED_FENCE();
    }
  }
}

DI void step_wo(const Params& p, int g, char* smem) {
  TILE_COORDS
  char* ws = glaunder(p.ws);
  u16* sA = (u16*)smem; u16* sB = sA + 128 * LDT;
  const float* gate1 = (const float*)(ws + OFF_MOD) + g * 6144 + 2048;
  for (int t = lbid(); t < 512; t += lgdim()) {
    const int ntile = t >> 5, mt = t & 31;
    const int m0 = mt * 128, n0 = ntile * 64;
    f32x16 acc[2][1];
    zero_acc1(acc);
    gemm_accum_t<1>(acc, (const u16*)(ws + G_MIX) + (size_t)m0 * 1024, 1024, (const u16*)(ws + OFF_WO) + (size_t)n0 * 1024, 1024, 1024, sA, sB, 0);
    const int rowb = g * TG + m0 + wm * 64 + 4 * h;
    const int col = n0 + wn * 32 + r;
    const float g1 = gate1[col];
    const float* xs = launder(xrow(p, rowb) + col);
    float* o = launder(p.out + OUT_Y + (size_t)rowb * D + col);
#pragma unroll
    for (int i = 0; i < 2; ++i)
#pragma unroll
      for (int reg = 0; reg < 16; ++reg) o[ROFF(i, reg) * D] = xs[ROFF(i, reg) * D] + g1 * acc[i][0][reg];
  }
}

DI void step_ffn_up(const Params& p, char* smem) {
  TILE_COORDS
  char* ws = glaunder(p.ws);
  u16* sA = (u16*)smem; u16* sB = sA + 128 * LDT;
  for (int t = lbid(); t < 80 * 44; t += lgdim()) {
    const int ntile = t / 80, mt = t % 80;
    const int m0 = mt * 256, n0 = ntile * 128;
    f32x16 acc[4][2];
    zero_acc4(acc);
    gemm_accum_256(acc, (const u16*)(ws + OFF_HB) + (size_t)m0 * 1024, 1024, 64, 128 * 1024, (const u16*)(ws + OFF_WGU) + (size_t)n0 * 1024, 1024, 64, 1024, sA, 0);
    const int rowb = m0 + wm * 128 + 4 * h;
    u16* act = launder((u16*)(ws + OFF_ACT) + (size_t)rowb * FF + ntile * 64 + 32 * wn + r + (r & 1) * (FF - 1));
#pragma unroll
    for (int i = 0; i < 4; ++i) {
#pragma unroll
      for (int reg = 0; reg < 16; reg += 2) st_pair_bf16(act, ROFF(i, reg), FF, silu_f(acc[i][0][reg]) * acc[i][1][reg], silu_f(acc[i][0][reg + 1]) * acc[i][1][reg + 1], r & 1);
      SCHED_FENCE();
    }
  }
}

DI void step_ffn_down(const Params& p, char* smem) {
  TILE_COORDS
  char* ws = glaunder(p.ws);
  u16* sA = (u16*)smem; u16* sB = sA + 128 * LDT;
  const float* MOD = (const float*)(ws + OFF_MOD);
  for (int t = lbid(); t < 160 * 8; t += lgdim()) {
    const int ntile = t / 160, mt = t % 160;
    const int m0 = mt * 128, n0 = ntile * 128;
    f32x16 acc[2][2];
    zero_acc(acc);
    gemm_accum(acc, (const u16*)(ws + OFF_ACT) + (size_t)m0 * FF, FF, (const u16*)(ws + OFF_WDN) + (size_t)n0 * FF, FF, FF, sA, sB, 0);
    const int mv = m0 < TG ? 0 : 1 + ((m0 - TG) >> 12);
    const float* gate2 = MOD + mv * 6144 + 5120;
    const int rowb = m0 + wm * 64 + 4 * h;
#pragma unroll
    for (int j = 0; j < 2; ++j) {
      const int col = n0 + COL_L(j, 0);
      const float g2 = gate2[col];
      float* o = launder(p.out + OUT_Y + (size_t)rowb * D + col);
#pragma unroll
      for (int i = 0; i < 2; ++i)
#pragma unroll
        for (int reg = 0; reg < 16; ++reg) o[ROFF(i, reg) * D] = o[ROFF(i, reg) * D] + g2 * acc[i][j][reg];
      SCHED_FENCE();
    }
  }
}


#define XB_TMO      128
#define XB_XCNT(j)  (256  + 64 * (j))
#define XB_XSUB(j)  (1280 + 64 * (j))
#define XB_XGEN(j)  (2304 + 64 * (j))
#define XB_TOP      3328
#define XB_TOPGEN   3392
#define XCD_BAR_WORDS 3456
#define XB_SPIN_CAP (1u << 22)
#define LAS __attribute__((address_space(3)))
DI unsigned xb_ld(unsigned* p)              { return __hip_atomic_load(p, __ATOMIC_RELAXED, __HIP_MEMORY_SCOPE_AGENT); }
DI unsigned xb_add(unsigned* p, unsigned v) { return __hip_atomic_fetch_add(p, v, __ATOMIC_RELAXED, __HIP_MEMORY_SCOPE_AGENT); }
DI unsigned xb_xcc_id() { return (unsigned)__builtin_amdgcn_s_getreg((3 << 11) | 20) & 0xFu; }
#define XB_SPIN(cond, bar) do { unsigned _sp = 0; while (cond) { __builtin_amdgcn_s_sleep(1); \
    if ((++_sp & 255u) == 0u) { if (xb_ld(&(bar)[XB_TMO])) break; if (_sp > XB_SPIN_CAP) { atomicAdd(&(bar)[XB_TMO], 1u); break; } } } } while (0)
struct XcdBarrier { unsigned* bar; unsigned x; volatile LAS unsigned* st; };
DI XcdBarrier xcd_barrier_post(unsigned* bar, volatile LAS unsigned* st) {
  XcdBarrier b; b.bar = bar; b.x = xb_xcc_id(); b.st = st;
  if (threadIdx.x == 0) (void)xb_add(&bar[XB_XCNT(b.x)], 1u);
  return b;
}
DI void xcd_barrier_complete(unsigned* bar, unsigned x, unsigned& nloc, unsigned& nx) {
  const unsigned G = gridDim.x * gridDim.y * gridDim.z;
  unsigned sum, cnt, mine, sp = 0u;
  for (;;) {
    sum = 0u; cnt = 0u; mine = 0u;
#pragma unroll
    for (unsigned j = 0; j < 16; ++j) { const unsigned c = xb_ld(&bar[XB_XCNT(j)]); sum += c; cnt += (c > 0u) ? 1u : 0u; mine = (j == x) ? c : mine; }
    if (sum == G) break;
    __builtin_amdgcn_s_sleep(1);
    if ((++sp & 255u) == 0u) { if (xb_ld(&bar[XB_TMO])) break; if (sp > XB_SPIN_CAP) { atomicAdd(&bar[XB_TMO], 1u); break; } }
  }
  nloc = mine > 0u ? mine : 1u; nx = cnt > 0u ? cnt : 1u;
}
DI void xcd_barrier(const XcdBarrier& b) {
  asm volatile("s_waitcnt vmcnt(0)" ::: "memory");
  __syncthreads();
  if (threadIdx.x == 0) {
    unsigned* bar = b.bar;
    __builtin_amdgcn_s_waitcnt(0);
    unsigned nloc = b.st[0], nx = b.st[1];
    if (nloc == 0u) { xcd_barrier_complete(bar, b.x, nloc, nx); b.st[0] = nloc; b.st[1] = nx; }
    const unsigned old = xb_add(&bar[XB_XSUB(b.x)], 1u);
    const unsigned gen = old / nloc;
    if (old + 1u == (gen + 1u) * nloc) {
      __builtin_amdgcn_fence(__ATOMIC_RELEASE, "agent");
      asm volatile("s_waitcnt vmcnt(0)" ::: "memory");
      const unsigned og = xb_add(&bar[XB_TOP], 1u);
      const unsigned tg = og / nx;
      if (og + 1u == (tg + 1u) * nx) xb_add(&bar[XB_TOPGEN], 1u);
      else XB_SPIN(xb_ld(&bar[XB_TOPGEN]) == tg, bar);
      __builtin_amdgcn_fence(__ATOMIC_ACQUIRE, "agent");
      xb_add(&bar[XB_XGEN(b.x)], 1u);
      asm volatile("s_waitcnt vmcnt(0)" ::: "memory");
    } else {
      XB_SPIN(xb_ld(&bar[XB_XGEN(b.x)]) == gen, bar);
      __builtin_amdgcn_fence(__ATOMIC_ACQUIRE, "agent");
      asm volatile("s_waitcnt vmcnt(0)" ::: "memory");
    }
  }
  __syncthreads();
}

constexpr int NSTEPS = 37;

__global__ void __launch_bounds__(256, 2) mega(Params p, int lo, int hi) {
  __shared__ __attribute__((aligned(16))) char smem[SMEM_BYTES];
  __shared__ uint4 xb_words;
  cg::grid_group grid = cg::this_grid();
  if (lo > hi) grid.sync();
  if (threadIdx.x == 0) xb_words = make_uint4(0u, 0u, 0u, 0u);
  __syncthreads();
  XcdBarrier xb = xcd_barrier_post((unsigned*)(p.ws + OFF_BAR), (volatile LAS unsigned*)&xb_words);
  for (int step = lo; step < hi; ++step) {
    if (step == 0) { step_p0(p, smem); if (PROBE_M1) step_p0(p, smem); }
    else if (step == 1) { step_rownorm(p, 0); if (PROBE_M1) step_rownorm(p, 0); }
    else if (step == 2) step_proj(p, 0, smem);
    else if (step < 33) {
      const int g = (step - 3) / 6, s = (step - 3) % 6;
      if (s == 0) step_mix3(p, g, smem);
      else if (s == 1) { step_scan(p, g); if (PROBE_M1) step_scan(p, g); }
      else if (s == 2) { step_retout(p, smem); if (PROBE_M2) step_retout(p, smem); }
      else if (s == 3) step_gn(p);
      else if (s == 4) { step_branch(p, smem); if (PROBE_M2) step_branch(p, smem); }
      else { step_wo(p, g, smem); if (g < 4) step_proj(p, g + 1, smem); }
    } else if (step == 33) { step_rownorm(p, 1); if (PROBE_M1) step_rownorm(p, 1); }
    else if (step == 34) step_ffn_up(p, smem);
    else if (step == 35) step_ffn_down(p, smem);
    else step_rownorm(p, 2);
    if (step + 1 < hi) xcd_barrier(xb);
  }
}

extern "C" void kernel_launch(void* const* d_in, const int* in_sizes, int n_in, void* d_out, int out_size, void* d_ws, size_t ws_size, hipStream_t stream) {
  static int grid_blocks = 0;
  if (!grid_blocks) {
    int dev = 0, cus = 0, per_cu = 0;
    hipGetDevice(&dev);
    hipDeviceGetAttribute(&cus, hipDeviceAttributeMultiprocessorCount, dev);
    hipOccupancyMaxActiveBlocksPerMultiprocessor(&per_cu, mega, 256, 0);
    if (per_cu < 1) per_cu = 1;
    if (per_cu > 2) per_cu = 2;
    grid_blocks = cus * per_cu;
  }
  Params p{};
  const float** f = (const float**)&p;
  for (int i = 0; i < 29; ++i) f[i] = (const float*)d_in[i];
  p.out = (float*)d_out;
  p.ws = (char*)d_ws;
  hipMemsetAsync((char*)d_ws + OFF_BAR, 0, XCD_BAR_WORDS * 4, stream);
#if COOP
  int lo = 0, hi = NSTEPS;
  void* args[] = {&p, &lo, &hi};
  hipError_t e = hipLaunchCooperativeKernel((void*)mega, dim3(grid_blocks), dim3(256), args, 0, stream);
  if (e != hipSuccess) fprintf(stderr, "cooperative launch failed: %s (grid %d)\n", hipGetErrorString(e), grid_blocks);
#else
  for (int s = 0; s < NSTEPS; ++s) hipLaunchKernelGGL(mega, dim3(grid_blocks), dim3(256), 0, stream, p, s, s + 1);
#endif
}
```

```cpp
#include <hip/hip_runtime.h>
#include <hip/hip_cooperative_groups.h>
#include <cstdio>
namespace cg = cooperative_groups;

#ifndef PROBE_M1
#define PROBE_M1 0
#endif
#ifndef PROBE_M2
#define PROBE_M2 0
#endif
#ifndef PROBE_M3
#define PROBE_M3 0
#endif
#ifndef COOP
#define COOP 1
#endif

#define DI __device__ __forceinline__
typedef unsigned short u16;
typedef __attribute__((ext_vector_type(8))) short bf16x8;
typedef __attribute__((ext_vector_type(4))) short s16x4;
typedef __attribute__((ext_vector_type(16))) float f32x16;
typedef __attribute__((ext_vector_type(4))) unsigned u32x4;
typedef __attribute__((ext_vector_type(2))) unsigned u32x2;
#define SCHED_FENCE() asm volatile("" ::: "memory")
#define MFMA(a, b, c) __builtin_amdgcn_mfma_f32_32x32x16_bf16((a), (b), (c), 0, 0, 0)

constexpr int D = 1024;
constexpr int TG = 4096;
constexpr int NG = 5;
constexpr int TT = TG * NG;
constexpr int FF = 2816;
constexpr int WCOLS = 8192;

constexpr size_t OFF_WIN = 0;
constexpr size_t OFF_WR = OFF_WIN + (size_t)8192 * 1024 * 2;
constexpr size_t OFF_WD = OFF_WR + 2097152;
constexpr size_t OFF_WO = OFF_WD + 2097152;
constexpr size_t OFF_WGU = OFF_WO + 2097152;
constexpr size_t OFF_WDN = OFF_WGU + (size_t)5632 * 1024 * 2;
constexpr size_t OFF_MOD = OFF_WDN + (size_t)1024 * 2816 * 2;
constexpr size_t OFF_COSR = OFF_MOD + 122880;
constexpr size_t OFF_SINR = OFF_COSR + 1048576;
constexpr size_t OFF_COSD = OFF_SINR + 1048576;
constexpr size_t OFF_SIND = OFF_COSD + 524288;
constexpr size_t OFF_DEC = OFF_SIND + 524288;
constexpr size_t OFF_KC = OFF_DEC + 16384;
constexpr size_t OFF_VCT = OFF_KC + 2097152;
constexpr size_t OFF_HB = OFF_VCT + 2097152;
constexpr size_t OFF_G = OFF_HB + (size_t)TT * 1024 * 2;
constexpr size_t G_QR = OFF_G;
constexpr size_t G_QA = G_QR + 4194304;
constexpr size_t G_QB = G_QA + 4194304;
constexpr size_t G_KR = G_QB + 4194304;
constexpr size_t G_KRTF = G_KR + 4194304;
constexpr size_t G_KRTB = G_KRTF + 4194304;
constexpr size_t G_VRT = G_KRTB + 4194304;
constexpr size_t G_GR = G_VRT + 8388608;
constexpr size_t G_QD = G_GR + 8388608;
constexpr size_t G_KD = G_QD + 8388608;
constexpr size_t G_VDT = G_KD + 8388608;
constexpr size_t G_GATES = G_VDT + 8388608;
constexpr size_t G_KV = G_GATES + 16777216;
constexpr size_t G_SP = G_KV + 33554432;
constexpr size_t G_SC = G_SP + 16777216;
constexpr size_t G_MIX = G_SC + 4194304;
constexpr size_t G_END = G_MIX + 8388608;
constexpr size_t OFF_BAR = G_END;
constexpr size_t OFF_ACT = OFF_G;
static_assert((size_t)TT * FF * 2 <= G_END - OFF_G, "ACT alias");
static_assert(G_END + 16384 <= (size_t)256 * 1024 * 1024, "ws");

constexpr int DEC_WQF = 0, DEC_WQB = 512, DEC_WKF = 1024, DEC_WKB = 1536, DEC_LGF = 2048, DEC_LGB = 2052, DEC_GCF = 2056, DEC_GCB = 2060, DEC_LAM = 2064;

constexpr size_t OUT_Y = 0;
constexpr size_t OUT_RF = (size_t)TT * 1024;
constexpr size_t OUT_RB = OUT_RF + 2097152;
constexpr size_t OUT_DK = OUT_RB + 2097152;
constexpr size_t OUT_DV = OUT_DK + 4194304;

struct Params {
  const float *x_prompt, *x_sample, *state_f, *state_b, *cache_k, *cache_v, *c, *c_ctx, *norm1_g, *norm2_g, *w_ada, *b_ada, *w_in, *b_gate,
      *decay_f, *decay_b, *gn_g, *w_ret_out, *lq1, *lk1, *lq2, *lk2, *subln_g, *w_diff_out, *w_o, *w_gate, *w_up, *w_down, *final_g;
  float* out;
  char* ws;
};

DI int ltid() { int t = threadIdx.x; asm volatile("" : "+v"(t)); return t; }
DI char* glaunder(char* p) { __attribute__((address_space(1))) char* g = (__attribute__((address_space(1))) char*)p; asm volatile("" : "+s"(g)); return (char*)g; }
DI int lbid() { int b = blockIdx.x; asm volatile("" : "+s"(b)); return b; }
DI int lgdim() { int b = gridDim.x; asm volatile("" : "+s"(b)); return b; }
typedef __bf16 hbf16x2 __attribute__((ext_vector_type(2)));
typedef float f32x2 __attribute__((ext_vector_type(2)));
DI u16 f2bf(float x) { return __builtin_bit_cast(u16, (__bf16)x); }
DI float bf2f(u16 v) { return __uint_as_float(((unsigned)v) << 16); }
DI unsigned pack2(float a, float b) { f32x2 v = {a, b}; return __builtin_bit_cast(unsigned, __builtin_convertvector(v, hbf16x2)); }
DI float silu_f(float x) { return x * __builtin_amdgcn_rcpf(1.f + __expf(-x)); }
DI float sigmoid_f(float x) { return __builtin_amdgcn_rcpf(1.f + __expf(-x)); }
DI float wave_sum(float v) {
#pragma unroll
  for (int o = 32; o > 0; o >>= 1) v += __shfl_xor(v, o, 64);
  return v;
}
DI const float* xrow(const Params& p, int row) { return row < TG ? p.x_prompt + (size_t)row * D : p.x_sample + (size_t)(row - TG) * D; }

constexpr int LDT = 72;
constexpr int SMEM_BYTES = 2 * 2 * 128 * LDT * 2;
constexpr int SMEM_OLD_UNUSED = 0;

template <int NJ>
DI void gemm_accum_t(f32x16 (&acc)[2][NJ], const u16* A, int lda, const u16* Bt, int ldb, int K, u16* sA, u16* sB, int cbmode) {
  constexpr int STG = 2 * 128 * LDT;
  constexpr int NB = 2 * NJ;
  const int tid = ltid(), lane = tid & 63, wave = tid >> 6, wm = wave >> 1, wn = wave & 1, r = lane & 31, h = lane >> 5;
  const int lrow = tid >> 3, lcol = (tid & 7) * 8;
  const u16* ap = A + (size_t)lrow * lda + lcol;
  const u16* bp = Bt + (size_t)lrow * ldb + lcol;
  const int nk = K >> 6;
  u32x4 ra[3][4], rb[3][NB];
#define GEMM_LOAD(SET)                                                                            \
  {                                                                                               \
    _Pragma("unroll") for (int q = 0; q < 4; ++q) ra[SET][q] = *(const u32x4*)(ap + (size_t)(32 * q) * lda);  \
    _Pragma("unroll") for (int q = 0; q < NB; ++q) rb[SET][q] = *(const u32x4*)(bp + (size_t)(32 * q) * ldb); \
    ap += 64; bp += 64;                                                                           \
  }
  GEMM_LOAD(0)
  if (nk > 1) GEMM_LOAD(1)
  if (nk > 2) GEMM_LOAD(2)
  const int cb0 = NJ == 1 ? wn : (cbmode ? wn : 2 * wn), cb1 = cbmode ? wn + 2 : 2 * wn + 1;
  const u16* sa0 = sA + (wm * 64 + r) * LDT + h * 8;
  const u16* sb0 = sB + (cb0 * 32 + r) * LDT + h * 8;
  const u16* sb1 = sB + (cb1 * 32 + r) * LDT + h * 8;
  u16* wa = sA + lrow * LDT + lcol;
  u16* wb = sB + lrow * LDT + lcol;
  __syncthreads();
#pragma unroll
  for (int q = 0; q < 4; ++q) *(u32x4*)(wa + 32 * q * LDT) = ra[0][q];
#pragma unroll
  for (int q = 0; q < NB; ++q) *(u32x4*)(wb + 32 * q * LDT) = rb[0][q];
  __syncthreads();
#define GEMM_ITER(IDX, PAR, SET)                                                                  \
  {                                                                                               \
    const int kk = kt + IDX;                                                                      \
    if (kk + 3 < nk) GEMM_LOAD(SET)                                                               \
                       \
    bf16x8 fa[2][2], fb[2][2];                                                                    \
    fa[0][0] = *(const bf16x8*)(sa0 + PAR * STG);                                                 \
    fa[0][1] = *(const bf16x8*)(sa0 + PAR * STG + 32 * LDT);                                      \
    fb[0][0] = *(const bf16x8*)(sb0 + PAR * STG);                                                 \
    fb[0][1] = *(const bf16x8*)((NJ == 2 ? sb1 : sb0) + PAR * STG);                               \
    _Pragma("unroll") for (int ks = 0; ks < 4; ++ks) {                                            \
      if (ks < 3) {                                                                               \
        fa[(ks + 1) & 1][0] = *(const bf16x8*)(sa0 + PAR * STG + (ks + 1) * 16);                  \
        fa[(ks + 1) & 1][1] = *(const bf16x8*)(sa0 + PAR * STG + 32 * LDT + (ks + 1) * 16);       \
        fb[(ks + 1) & 1][0] = *(const bf16x8*)(sb0 + PAR * STG + (ks + 1) * 16);                  \
        if (NJ == 2) fb[(ks + 1) & 1][1] = *(const bf16x8*)(sb1 + PAR * STG + (ks + 1) * 16);     \
      }                                                                                           \
      __builtin_amdgcn_sched_barrier(0);                                                          \
      acc[0][0] = MFMA(fa[ks & 1][0], fb[ks & 1][0], acc[0][0]);                                  \
      acc[1][0] = MFMA(fa[ks & 1][1], fb[ks & 1][0], acc[1][0]);                                  \
      if (NJ == 2) {                                                                              \
        acc[0][NJ - 1] = MFMA(fa[ks & 1][0], fb[ks & 1][1], acc[0][NJ - 1]);                      \
        acc[1][NJ - 1] = MFMA(fa[ks & 1][1], fb[ks & 1][1], acc[1][NJ - 1]);                      \
      }                                                                                           \
      __builtin_amdgcn_sched_barrier(0);                                                          \
    }                                                                                             \
    if (kk + 1 < nk) {                                                                            \
      _Pragma("unroll") for (int q = 0; q < 4; ++q) *(u32x4*)(wa + (1 - PAR) * STG + 32 * q * LDT) = ra[(SET + 1) % 3][q];  \
      _Pragma("unroll") for (int q = 0; q < NB; ++q) *(u32x4*)(wb + (1 - PAR) * STG + 32 * q * LDT) = rb[(SET + 1) % 3][q]; \
    }                                                                                             \
    __syncthreads();                                                                              \
  }
  for (int kt = 0; kt < nk; kt += 6) {
    GEMM_ITER(0, 0, 0)
    if (kt + 1 < nk) GEMM_ITER(1, 1, 1)
    if (kt + 2 < nk) GEMM_ITER(2, 0, 2)
    if (kt + 3 < nk) GEMM_ITER(3, 1, 0)
    if (kt + 4 < nk) GEMM_ITER(4, 0, 1)
    if (kt + 5 < nk) GEMM_ITER(5, 1, 2)
  }
#undef GEMM_ITER
#undef GEMM_LOAD
}
DI void gemm_accum_256(f32x16 (&acc)[4][2], const u16* A, int a_rs, int a_ks, int a_sub, const u16* Bt, int b_rs, int b_ks, int K, u16* sA, int cbmode) {
  u16* sB = sA + 256 * LDT;
  const int tid = ltid(), lane = tid & 63, wave = tid >> 6, wm = wave >> 1, wn = wave & 1, r = lane & 31, h = lane >> 5;
  const int lrow = tid >> 3, lcol = (tid & 7) * 8;
  const u16* ap = A + (size_t)lrow * a_rs + lcol;
  const u16* bp = Bt + (size_t)lrow * b_rs + lcol;
  const int nk = K >> 6;
  u32x4 ra[8], rb[4];
#define A_OFF(q) ((size_t)((q) >> 2) * a_sub + (size_t)(32 * ((q) & 3)) * a_rs)
#pragma unroll
  for (int q = 0; q < 8; ++q) ra[q] = *(const u32x4*)(ap + A_OFF(q));
#pragma unroll
  for (int q = 0; q < 4; ++q) rb[q] = *(const u32x4*)(bp + (size_t)(32 * q) * b_rs);
  const int cb0 = cbmode ? wn : 2 * wn, cb1 = cbmode ? wn + 2 : 2 * wn + 1;
  const u16* sa0 = sA + (wm * 128 + r) * LDT + h * 8;
  const u16* sb0 = sB + (cb0 * 32 + r) * LDT + h * 8;
  const u16* sb1 = sB + (cb1 * 32 + r) * LDT + h * 8;
  u16* wa = sA + lrow * LDT + lcol;
  u16* wb = sB + lrow * LDT + lcol;
  for (int kt = 0; kt < nk; ++kt) {
    __syncthreads();
#pragma unroll
    for (int q = 0; q < 8; ++q) *(u32x4*)(wa + 32 * q * LDT) = ra[q];
#pragma unroll
    for (int q = 0; q < 4; ++q) *(u32x4*)(wb + 32 * q * LDT) = rb[q];
    __syncthreads();
    if (kt + 1 < nk) {
      ap += a_ks; bp += b_ks;
#pragma unroll
      for (int q = 0; q < 8; ++q) ra[q] = *(const u32x4*)(ap + A_OFF(q));
#pragma unroll
      for (int q = 0; q < 4; ++q) rb[q] = *(const u32x4*)(bp + (size_t)(32 * q) * b_rs);
    }
    bf16x8 fa[4], fb[2][2];
    fb[0][0] = *(const bf16x8*)(sb0);
    fb[0][1] = *(const bf16x8*)(sb1);
#pragma unroll
    for (int i = 0; i < 4; ++i) fa[i] = *(const bf16x8*)(sa0 + i * 32 * LDT);
#pragma unroll
    for (int ks = 0; ks < 4; ++ks) {
      if (ks < 3) {
        fb[(ks + 1) & 1][0] = *(const bf16x8*)(sb0 + (ks + 1) * 16);
        fb[(ks + 1) & 1][1] = *(const bf16x8*)(sb1 + (ks + 1) * 16);
      }
#pragma unroll
      for (int i = 0; i < 4; ++i) {
        __builtin_amdgcn_sched_barrier(0);
        acc[i][0] = MFMA(fa[i], fb[ks & 1][0], acc[i][0]);
        acc[i][1] = MFMA(fa[i], fb[ks & 1][1], acc[i][1]);
        __builtin_amdgcn_sched_barrier(0);
        if (ks < 3) fa[i] = *(const bf16x8*)(sa0 + i * 32 * LDT + (ks + 1) * 16);
      }
    }
  }
}
#undef A_OFF
DI void zero_acc4(f32x16 (&acc)[4][2]) {
#pragma unroll
  for (int i = 0; i < 4; ++i)
#pragma unroll
    for (int j = 0; j < 2; ++j)
#pragma unroll
      for (int e = 0; e < 16; ++e) acc[i][j][e] = 0.f;
}
DI void gemm_accum(f32x16 (&acc)[2][2], const u16* A, int lda, const u16* Bt, int ldb, int K, u16* sA, u16* sB, int cbmode) {
  gemm_accum_t<2>(acc, A, lda, Bt, ldb, K, sA, sB, cbmode);
}
DI void zero_acc1(f32x16 (&acc)[2][1]) {
#pragma unroll
  for (int i = 0; i < 2; ++i)
#pragma unroll
    for (int e = 0; e < 16; ++e) acc[i][0][e] = 0.f;
}

DI void zero_acc(f32x16 (&acc)[2][2]) {
#pragma unroll
  for (int i = 0; i < 2; ++i)
#pragma unroll
    for (int j = 0; j < 2; ++j)
#pragma unroll
      for (int e = 0; e < 16; ++e) acc[i][j][e] = 0.f;
}

#define TILE_COORDS                                                                                  \
  const int tid = ltid(), lane = tid & 63, wave = tid >> 6, wm = wave >> 1, wn = wave & 1;      \
  const int r = lane & 31, h = lane >> 5;                                                            \
  (void)r; (void)h; (void)wm; (void)wn;
#define ROW_L(i, reg) (wm * 64 + (i) * 32 + ((reg) & 3) + 8 * ((reg) >> 2) + 4 * h)
#define COL_L(j, cbmode) (((cbmode) ? (wn + 2 * (j)) : (2 * wn + (j))) * 32 + r)

DI void step_p0(const Params& p, char* smem) {
  const int tid = ltid();
  char* ws = glaunder(p.ws);
  {
    float(*tile)[65] = (float(*)[65])smem;
    constexpr int NT_ALL = 2048 + 768 + 1408 + 704 + 256;
    for (int t = lbid(); t < NT_ALL; t += lgdim()) {
      const float* src; int N; u16* dst; int dld; int mode = 0; int ntl; int tt = t;
      if (tt < 2048) { src = p.w_in; N = 8192; dst = (u16*)(ws + OFF_WIN); dld = 1024; ntl = 128; }
      else if ((tt -= 2048) < 256) { src = p.w_ret_out; N = 1024; dst = (u16*)(ws + OFF_WR); dld = 1024; ntl = 16; }
      else if ((tt -= 256) < 256) { src = p.w_diff_out; N = 1024; dst = (u16*)(ws + OFF_WD); dld = 1024; ntl = 16; }
      else if ((tt -= 256) < 256) { src = p.w_o; N = 1024; dst = (u16*)(ws + OFF_WO); dld = 1024; ntl = 16; }
      else if ((tt -= 256) < 704) { src = p.w_gate; N = FF; dst = (u16*)(ws + OFF_WGU); dld = 1024; mode = 1; ntl = 44; }
      else if ((tt -= 704) < 704) { src = p.w_up; N = FF; dst = (u16*)(ws + OFF_WGU); dld = 1024; mode = 2; ntl = 44; }
      else if ((tt -= 704) < 704) { src = p.w_down; N = 1024; dst = (u16*)(ws + OFF_WDN); dld = FF; ntl = 16; }
      else { tt -= 704; int b = tt >> 6; tt &= 63; src = p.cache_v + (size_t)b * 256 * 1024; N = 1024; dst = (u16*)(ws + OFF_VCT) + (size_t)b * 1024 * 256; dld = 256; ntl = 16; }
      const int kt = tt / ntl, nt = tt % ntl;
      __syncthreads();
#pragma unroll
      for (int q = 0; q < 4; ++q) {
        const int k = (tid >> 4) + 16 * q, n4 = (tid & 15) * 4;
        const float4 v = *(const float4*)(src + (size_t)(kt * 64 + k) * N + nt * 64 + n4);
        tile[k][n4 + 0] = v.x; tile[k][n4 + 1] = v.y; tile[k][n4 + 2] = v.z; tile[k][n4 + 3] = v.w;
      }
      __syncthreads();
#pragma unroll
      for (int q = 0; q < 2; ++q) {
        const int n = (tid >> 3) + 32 * q, k8 = (tid & 7) * 8;
        uint4 o;
        o.x = pack2(tile[k8 + 0][n], tile[k8 + 1][n]);
        o.y = pack2(tile[k8 + 2][n], tile[k8 + 3][n]);
        o.z = pack2(tile[k8 + 4][n], tile[k8 + 5][n]);
        o.w = pack2(tile[k8 + 6][n], tile[k8 + 7][n]);
        const int ng = nt * 64 + n;
        const int drow = mode == 0 ? ng : (64 * (ng >> 5) + (mode == 2 ? 32 : 0) + (ng & 31));
        if (t < 2048) *(uint4*)(dst + ((size_t)((drow >> 7) * 16 + kt) * 128 + (drow & 127)) * 64 + k8) = o;
        else *(uint4*)(dst + (size_t)drow * dld + kt * 64 + k8) = o;
      }
    }
  }
  {
    float* sil = (float*)smem;
    float* red = sil + 5 * 1024;
    float* MOD = (float*)(ws + OFF_MOD);
    for (int t = lbid(); t < 192; t += lgdim()) {
      __syncthreads();
      for (int e = tid; e < 5 * 1024; e += 256) {
        const int v = e >> 10, k = e & 1023;
        const float cv = v == 0 ? p.c_ctx[k] : p.c[(v - 1) * 1024 + k];
        sil[e] = silu_f(cv);
      }
      __syncthreads();
      const int cidx = tid & 31, kg = tid >> 5, n0 = t * 32;
      float a0 = 0, a1 = 0, a2 = 0, a3 = 0, a4 = 0;
      const float* wp = p.w_ada + (size_t)kg * 6144 + n0 + cidx;
      for (int k0 = 0; k0 < 128; k0 += 16) {
        float w[16];
#pragma unroll
        for (int u = 0; u < 16; ++u) w[u] = wp[(size_t)(k0 + u) * (8 * 6144)];
#pragma unroll
        for (int u = 0; u < 16; ++u) {
          const int k = kg + 8 * (k0 + u);
          a0 += sil[k] * w[u]; a1 += sil[1024 + k] * w[u]; a2 += sil[2048 + k] * w[u]; a3 += sil[3072 + k] * w[u]; a4 += sil[4096 + k] * w[u];
        }
      }
      red[(kg * 5 + 0) * 32 + cidx] = a0; red[(kg * 5 + 1) * 32 + cidx] = a1; red[(kg * 5 + 2) * 32 + cidx] = a2;
      red[(kg * 5 + 3) * 32 + cidx] = a3; red[(kg * 5 + 4) * 32 + cidx] = a4;
      __syncthreads();
      if (tid < 160) {
        const int v = tid >> 5, cc = tid & 31;
        float s = p.b_ada[n0 + cc];
#pragma unroll
        for (int g8 = 0; g8 < 8; ++g8) s += red[(g8 * 5 + v) * 32 + cc];
        MOD[v * 6144 + n0 + cc] = s;
      }
    }
  }
  {
    const int gt = lbid() * 256 + tid, gn = lgdim() * 256;
    u16* KC = (u16*)(ws + OFF_KC);
    for (int e = gt; e < 4 * 256 * 1024 / 4; e += gn) {
      const float4 v = *(const float4*)(p.cache_k + (size_t)e * 4);
      uint2 o; o.x = pack2(v.x, v.y); o.y = pack2(v.z, v.w);
      *(uint2*)(KC + (size_t)e * 4) = o;
    }
    float* cosR = (float*)(ws + OFF_COSR); float* sinR = (float*)(ws + OFF_SINR);
    for (int e = gt; e < 4096 * 64; e += gn) {
      const int pos = e >> 6, d = e & 63;
      const int fi = d & 31;
      const float inv = powf(10000.0f, -(float)fi / 32.0f);
      const float pp = d < 32 ? (float)(pos >> 6) : (float)(pos & 63);
      const float ang = pp * inv;
      cosR[e] = cosf(ang); sinR[e] = sinf(ang);
    }
    float* cosD = (float*)(ws + OFF_COSD); float* sinD = (float*)(ws + OFF_SIND);
    for (int e = gt; e < 4096 * 32; e += gn) {
      const int pos = e >> 5, d = e & 31;
      const int fi = d & 15;
      const float inv = powf(10000.0f, -(float)fi / 16.0f);
      const float pp = d < 16 ? (float)(pos >> 6) : (float)(pos & 63);
      const float ang = pp * inv;
      cosD[e] = cosf(ang); sinD[e] = sinf(ang);
    }
  }
  if (lbid() == 0) {
    float* DEC = (float*)(ws + OFF_DEC);
    for (int e = tid; e < 512; e += 256) {
      const int hh = e >> 7, i = e & 127;
      const float df = p.decay_f[hh], db = p.decay_b[hh];
      const float lgf = fminf(df, 0.f) - log1pf(expf(-fabsf(df)));
      const float lgb = fminf(db, 0.f) - log1pf(expf(-fabsf(db)));
      DEC[DEC_WQF + e] = expf(lgf * (float)(i + 1));
      DEC[DEC_WQB + e] = expf(lgb * (float)(128 - i));
      DEC[DEC_WKF + e] = expf(lgf * (float)(127 - i));
      DEC[DEC_WKB + e] = expf(lgb * (float)i);
      if (i == 0) {
        DEC[DEC_LGF + hh] = lgf; DEC[DEC_LGB + hh] = lgb;
        DEC[DEC_GCF + hh] = expf(lgf * 128.f); DEC[DEC_GCB + hh] = expf(lgb * 128.f);
      }
    }
    if (tid < 64) {
      float s1 = p.lq1[tid] * p.lk1[tid], s2 = p.lq2[tid] * p.lk2[tid];
      s1 = wave_sum(s1); s2 = wave_sum(s2);
      if (tid == 0) DEC[DEC_LAM] = expf(s1) - expf(s2) + 0.2f;
    }
  }
}

DI void step_rownorm(const Params& p, int mode) {
  const int lane = ltid() & 63, wave = ltid() >> 6;
  const float* MOD = (const float*)(p.ws + OFF_MOD);
  u16* HB = (u16*)(p.ws + OFF_HB);
  for (int row = lbid() * 4 + wave; row < TT; row += lgdim() * 4) {
    const float* src = mode == 0 ? xrow(p, row) : p.out + OUT_Y + (size_t)row * D;
    float4 v[4];
    float ss = 0.f;
#pragma unroll
    for (int i = 0; i < 4; ++i) {
      v[i] = *(const float4*)(src + lane * 4 + 256 * i);
      ss += v[i].x * v[i].x + v[i].y * v[i].y + v[i].z * v[i].z + v[i].w * v[i].w;
    }
    ss = wave_sum(ss);
    const float rstd = rsqrtf(ss * (1.f / 1024.f) + 1e-6f);
    const int mv = row < TG ? 0 : 1 + ((row - TG) >> 12);
    const float* md = MOD + mv * 6144;
#pragma unroll
    for (int i = 0; i < 4; ++i) {
      const int col = lane * 4 + 256 * i;
      if (mode == 2) {
        const float4 g = *(const float4*)(p.final_g + col);
        float4 o; o.x = v[i].x * rstd * g.x; o.y = v[i].y * rstd * g.y; o.z = v[i].z * rstd * g.z; o.w = v[i].w * rstd * g.w;
        *(float4*)(p.out + OUT_Y + (size_t)row * D + col) = o;
      } else {
        const float4 g = *(const float4*)((mode == 0 ? p.norm1_g : p.norm2_g) + col);
        const float4 sh = *(const float4*)(md + (mode == 0 ? 0 : 3072) + col);
        const float4 sc = *(const float4*)(md + (mode == 0 ? 1024 : 4096) + col);
        uint2 o;
        o.x = pack2(v[i].x * rstd * g.x * (1.f + sc.x) + sh.x, v[i].y * rstd * g.y * (1.f + sc.y) + sh.y);
        o.y = pack2(v[i].z * rstd * g.z * (1.f + sc.z) + sh.z, v[i].w * rstd * g.w * (1.f + sc.w) + sh.w);
        if (mode == 0) *(uint2*)(HB + ((size_t)((row >> 7) * 16 + (col >> 6)) * 128 + (row & 127)) * 64 + (col & 63)) = o;
        else *(uint2*)(HB + (size_t)row * D + col) = o;
      }
    }
  }
}

DI void st_pair_bf16(u16* basep, int ro0, int ld, float a0, float a1, int odd) {
  const float send = odd ? a0 : a1;
  const float recv = __int_as_float(__builtin_amdgcn_mov_dpp(__float_as_int(send), 0xB1, 0xF, 0xF, true));
  const unsigned v = odd ? pack2(recv, a1) : pack2(a0, recv);
  *(unsigned*)(basep + ro0 * ld) = v;
}
DI void st_pair_f32_add(float* dstp, const float* srcp, int ro0, int ld, float v0, float v1, int odd) {
  const float send = odd ? v0 : v1;
  const float recv = __int_as_float(__builtin_amdgcn_mov_dpp(__float_as_int(send), 0xB1, 0xF, 0xF, true));
  const float2 x = *(const float2*)(srcp + ro0 * ld);
  float2 o;
  o.x = x.x + (odd ? recv : v0);
  o.y = x.y + (odd ? v1 : recv);
  *(float2*)(dstp + ro0 * ld) = o;
}
template <typename T> DI T* launder(T* p) { __attribute__((address_space(1))) T* g = (__attribute__((address_space(1))) T*)p; asm volatile("" : "+v"(g)); return (T*)g; }
#define ROFF(i, reg) ((i) * 32 + ((reg) & 3) + 8 * ((reg) >> 2))

DI void step_proj(const Params& p, int g, char* smem) {
  TILE_COORDS
  char* ws = glaunder(p.ws);
  u16* sA = (u16*)smem; u16* sB = sA + 128 * LDT;
  const u16* HBg = (const u16*)(ws + OFF_HB) + (size_t)g * TG * D;
  const u16* WIN = (const u16*)(ws + OFF_WIN);
  const float* DEC = (const float*)(ws + OFF_DEC);
  const bool lat = g > 0;
  for (int t = lbid(); t < 16 * 64; t += lgdim()) {
    const int nraw = t >> 4, mt = t & 15;
    const int ntile = nraw < 32 ? nraw : 32 + ((nraw - 32 + 16) & 31);
    const int m0 = mt * 256, n0 = ntile * 128;
    const int cbmode = n0 < 1024 ? 1 : 0;
    f32x16 acc[4][2];
    zero_acc4(acc);
    gemm_accum_256(acc, HBg + (size_t)(m0 >> 7) * 16 * 8192, 64, 8192, 16 * 8192, WIN + (size_t)ntile * 16 * 8192, 64, 8192, D, sA, cbmode);
    const int rowb = m0 + wm * 128 + 4 * h;
    if (n0 < 1024) {
      const bool isk = n0 >= 512;
      const int hh = (n0 & 511) >> 7;
      const int d1 = 32 * wn + r;
      const float* cosb = launder((const float*)(ws + OFF_COSR) + (size_t)rowb * 64 + d1);
      const float* sinb = launder((const float*)(ws + OFF_SINR) + (size_t)rowb * 64 + d1);
      const int ib = rowb & 127;
      const float* wfb = launder(DEC + (isk ? DEC_WKF : DEC_WQF) + hh * 128 + ib);
      const float* wbb = launder(DEC + (isk ? DEC_WKB : DEC_WQB) + hh * 128 + ib);
      const size_t o512 = (size_t)rowb * 512 + hh * 128 + d1;
      if (!isk) {
        u16* qr = launder((u16*)(ws + G_QR) + o512); u16* qa = launder((u16*)(ws + G_QA) + o512); u16* qb = launder((u16*)(ws + G_QB) + o512);
#pragma unroll
        for (int i = 0; i < 4; ++i) {
#pragma unroll
          for (int reg = 0; reg < 16; ++reg) {
            const int ro = ROFF(i, reg);
            const float x1 = acc[i][0][reg], x2 = acc[i][1][reg];
            float a = x1, b = x2;
            if (lat) { const float cs = cosb[ro * 64], sn = sinb[ro * 64]; a = x1 * cs - x2 * sn; b = x1 * sn + x2 * cs; }
            const float wf = wfb[ro], wb = wbb[ro];
            qr[ro * 512] = f2bf(a); qr[ro * 512 + 64] = f2bf(b);
            qa[ro * 512] = f2bf(a * wf); qa[ro * 512 + 64] = f2bf(b * wf);
            qb[ro * 512] = f2bf(a * wb); qb[ro * 512 + 64] = f2bf(b * wb);
          }
          SCHED_FENCE();
        }
      } else {
        u16* kr = launder((u16*)(ws + G_KR) + o512);
        const size_t ot = (size_t)(hh * 128 + d1) * TG + rowb;
        u16* kf = launder((u16*)(ws + G_KRTF) + ot); u16* kb = launder((u16*)(ws + G_KRTB) + ot);
#pragma unroll
        for (int i = 0; i < 4; ++i) {
#pragma unroll
          for (int rg = 0; rg < 4; ++rg) {
            float o1[4], o2[4], wf[4], wb[4];
#pragma unroll
            for (int e = 0; e < 4; ++e) {
              const int ro = ROFF(i, rg * 4 + e);
              const float x1 = acc[i][0][rg * 4 + e], x2 = acc[i][1][rg * 4 + e];
              float a = x1, b = x2;
              if (lat) { const float cs = cosb[ro * 64], sn = sinb[ro * 64]; a = x1 * cs - x2 * sn; b = x1 * sn + x2 * cs; }
              a *= 0.08838834764831845f; b *= 0.08838834764831845f;
              wf[e] = wfb[ro]; wb[e] = wbb[ro];
              o1[e] = a; o2[e] = b;
              kr[ro * 512] = f2bf(a); kr[ro * 512 + 64] = f2bf(b);
            }
            const int to = i * 32 + 8 * rg;
            u32x2 v;
            v.x = pack2(o1[0] * wf[0], o1[1] * wf[1]); v.y = pack2(o1[2] * wf[2], o1[3] * wf[3]); *(u32x2*)(kf + to) = v;
            v.x = pack2(o2[0] * wf[0], o2[1] * wf[1]); v.y = pack2(o2[2] * wf[2], o2[3] * wf[3]); *(u32x2*)(kf + to + 64 * TG) = v;
            v.x = pack2(o1[0] * wb[0], o1[1] * wb[1]); v.y = pack2(o1[2] * wb[2], o1[3] * wb[3]); *(u32x2*)(kb + to) = v;
            v.x = pack2(o2[0] * wb[0], o2[1] * wb[1]); v.y = pack2(o2[2] * wb[2], o2[3] * wb[3]); *(u32x2*)(kb + to + 64 * TG) = v;
          }
          SCHED_FENCE();
        }
      }
    } else if (n0 < 2048 || (n0 >= 5120 && n0 < 6144)) {
      const bool isd = n0 >= 5120;
      const int cbase = isd ? n0 - 5120 : n0 - 1024;
#pragma unroll
      for (int j = 0; j < 2; ++j) {
        const int col = cbase + COL_L(j, 0);
        u16* vt = launder((isd ? (u16*)(ws + G_VDT) : (u16*)(ws + G_VRT)) + (size_t)col * TG + rowb);
        float* ov = launder(p.out + OUT_DV + (size_t)rowb * 1024 + col);
#pragma unroll
        for (int i = 0; i < 4; ++i) {
#pragma unroll
          for (int rg = 0; rg < 4; ++rg) {
            u32x2 v;
            v.x = pack2(acc[i][j][rg * 4 + 0], acc[i][j][rg * 4 + 1]);
            v.y = pack2(acc[i][j][rg * 4 + 2], acc[i][j][rg * 4 + 3]);
            *(u32x2*)(vt + i * 32 + 8 * rg) = v;
            if (isd && !lat) {
#pragma unroll
              for (int e = 0; e < 4; ++e) ov[(i * 32 + 8 * rg + e) * 1024] = acc[i][j][rg * 4 + e];
            }
          }
        }
        SCHED_FENCE();
      }
    } else if (n0 < 3072) {
#pragma unroll
      for (int j = 0; j < 2; ++j) {
        u16* gr = launder((u16*)(ws + G_GR) + (size_t)rowb * 1024 + n0 - 2048 + COL_L(j, 0) + (r & 1) * 1023);
#pragma unroll
        for (int i = 0; i < 4; ++i)
#pragma unroll
          for (int reg = 0; reg < 16; reg += 2) st_pair_bf16(gr, ROFF(i, reg), 1024, silu_f(acc[i][j][reg]), silu_f(acc[i][j][reg + 1]), r & 1);
        SCHED_FENCE();
      }
    } else if (n0 < 5120) {
      const bool isk = n0 >= 4096;
      const int cbase = (isk ? n0 - 4096 : n0 - 3072) + 64 * wn + r;
      const float* cosb = launder((const float*)(ws + OFF_COSD) + (size_t)rowb * 32 + r);
      const float* sinb = launder((const float*)(ws + OFF_SIND) + (size_t)rowb * 32 + r);
      u16* dst = launder((isk ? (u16*)(ws + G_KD) : (u16*)(ws + G_QD)) + (size_t)rowb * 1024 + cbase);
      float* ok = launder(p.out + OUT_DK + (size_t)rowb * 1024 + cbase);
      const float qs = isk ? 1.f : 0.125f * 1.4426950408889634f;
#pragma unroll
      for (int i = 0; i < 4; ++i) {
#pragma unroll
        for (int reg = 0; reg < 16; ++reg) {
          const int ro = ROFF(i, reg);
          const float x1 = acc[i][0][reg], x2 = acc[i][1][reg];
          float a = x1, b = x2;
          if (lat) { const float cs = cosb[ro * 32], sn = sinb[ro * 32]; a = x1 * cs - x2 * sn; b = x1 * sn + x2 * cs; }
          else if (isk) { ok[ro * 1024] = x1; ok[ro * 1024 + 32] = x2; }
          dst[ro * 1024] = f2bf(a * qs);
          dst[ro * 1024 + 32] = f2bf(b * qs);
        }
        SCHED_FENCE();
      }
    } else {
#pragma unroll
      for (int j = 0; j < 2; ++j) {
        const int col = n0 - 6144 + COL_L(j, 0);
        const float bg = p.b_gate[col];
        u16* gt = launder((u16*)(ws + G_GATES) + (size_t)rowb * 2048 + col + (r & 1) * 2047);
#pragma unroll
        for (int i = 0; i < 4; ++i)
#pragma unroll
          for (int reg = 0; reg < 16; reg += 2) st_pair_bf16(gt, ROFF(i, reg), 2048, sigmoid_f(acc[i][j][reg] + bg), sigmoid_f(acc[i][j][reg + 1] + bg), r & 1);
        SCHED_FENCE();
      }
    }
  }
}

constexpr int LDK = 136, LDV = 72, LDC = 132;
DI void attn_item(const Params& p, int g, int item, char* smem, bool dummy = false) {
  const int tid = ltid(), lane = tid & 63, wave = tid >> 6, r = lane & 31, h = lane >> 5;
  const int m = wave >> 1, rw = wave & 1;
  char* ws = glaunder(p.ws);
  u16* sK = (u16*)smem; u16* sV = sK + 64 * LDK;
  float* cmb = (float*)smem;
  const int head = item & 7, rest = item >> 3;
  int q0, kbase, nt0, nt1;
  if (g == 0) { const int seq = rest >> 2; q0 = seq * 256 + (rest & 3) * 64; kbase = seq * 256; nt0 = 4; nt1 = 0; }
  else { q0 = rest * 64; kbase = 0; nt0 = 64; nt1 = 4; }
  u16* QD = (u16*)(ws + G_QD);
  const u16* KD = (const u16*)(ws + G_KD);
  const u16* VDT = (const u16*)(ws + G_VDT);
  const u16* KCb = (const u16*)(ws + OFF_KC) + (size_t)(g > 0 ? g - 1 : 0) * 256 * 1024;
  const u16* VCb = (const u16*)(ws + OFF_VCT) + (size_t)(g > 0 ? g - 1 : 0) * 1024 * 256;
  const float lam = ((const float*)(ws + OFF_DEC))[DEC_LAM];
  const int qrow = q0 + rw * 32 + r;
  bf16x8 qf[4];
#pragma unroll
  for (int ks = 0; ks < 4; ++ks) qf[ks] = *(const bf16x8*)(QD + (size_t)qrow * 1024 + head * 128 + m * 64 + ks * 16 + h * 8);
  f32x16 O[4];
#pragma unroll
  for (int d = 0; d < 4; ++d)
#pragma unroll
    for (int e = 0; e < 16; ++e) O[d][e] = 0.f;
  float mrun = -1e30f, lsum = 0.f;
  const int ntiles = nt0 + nt1;
  constexpr int ASTG = 64 * LDK + 128 * LDV;
  const u16* sKw = sK + r * LDK + m * 64 + h * 8;
  const u16* sVw = sV + r * LDV + 8 * h;
  const int krow_l = tid >> 4;
  const int krow_p = (krow_l & 3) | ((krow_l & 4) << 1) | ((krow_l & 8) >> 1);
  u16* wK = sK + krow_p * LDK + (tid & 15) * 8;
  u16* wV = sV + (tid >> 3) * LDV + (tid & 7) * 8;
  u32x4 rk[4], rv[4];
#define ATTN_LOAD(T)                                                                                                   \
  {                                                                                                                    \
    const u16* kp; const u16* vp; int ldv;                                                                             \
    if ((T) < nt0) { kp = KD + (size_t)(kbase + (T) * 64) * 1024 + head * 128; vp = VDT + (size_t)(head * 128) * TG + kbase + (T) * 64; ldv = TG; } \
    else { const int t2 = (T) - nt0; kp = KCb + (size_t)(t2 * 64) * 1024 + head * 128; vp = VCb + (size_t)(head * 128) * 256 + t2 * 64; ldv = 256; } \
    _Pragma("unroll") for (int q = 0; q < 4; ++q) {                                                                    \
      rk[q] = *(const u32x4*)(kp + (size_t)((tid >> 4) + 16 * q) * 1024 + (tid & 15) * 8);                             \
      rv[q] = *(const u32x4*)(vp + (size_t)((tid >> 3) + 32 * q) * ldv + (tid & 7) * 8);                               \
    }                                                                                                                  \
  }
#define ATTN_STORE(STAGE)                                                                                              \
  {                                                                                                                    \
    _Pragma("unroll") for (int q = 0; q < 4; ++q) {                                                                    \
      *(u32x4*)(wK + (STAGE) * ASTG + 16 * q * LDK) = rk[q];                                                           \
      *(u32x4*)(wV + (STAGE) * ASTG + 32 * q * LDV) = rv[q];                                                           \
    }                                                                                                                  \
  }
  ATTN_LOAD(0)
  __syncthreads();
  ATTN_STORE(0)
  __syncthreads();
  if (ntiles > 1) ATTN_LOAD(1)
  for (int t = 0; t < ntiles; ++t) {
    const int cur = t & 1;
    const u16* sKc = sKw + cur * ASTG;
    const u16* sVc = sVw + cur * ASTG;
    bf16x8 ka[2][4];
#pragma unroll
    for (int kb = 0; kb < 2; ++kb)
#pragma unroll
      for (int ks = 0; ks < 4; ++ks) ka[kb][ks] = *(const bf16x8*)(sKc + kb * 32 * LDK + ks * 16);
    __builtin_amdgcn_sched_barrier(0);
    f32x16 st[2];
#pragma unroll
    for (int e = 0; e < 16; ++e) { st[0][e] = 0.f; st[1][e] = 0.f; }
#pragma unroll
    for (int ks = 0; ks < 4; ++ks) {
      st[0] = MFMA(ka[0][ks], qf[ks], st[0]);
      st[1] = MFMA(ka[1][ks], qf[ks], st[1]);
    }
    bf16x8 va[2][4];
#define ATTN_LOADV(BUF, GI)                                                                       \
  {                                                                                               \
    _Pragma("unroll") for (int d = 0; d < 4; ++d) {                                               \
      va[BUF][d] = *(const bf16x8*)(sVc + d * 32 * LDV + (GI) * 16);                              \
    }                                                                                             \
  }
    ATTN_LOADV(0, 0)
    __builtin_amdgcn_sched_barrier(0);
    float mx = fmaxf(st[0][0], st[1][0]);
#pragma unroll
    for (int e = 1; e < 16; ++e) mx = fmaxf(mx, fmaxf(st[0][e], st[1][e]));
    mx = fmaxf(mx, __shfl_xor(mx, 32, 64));
    if (__any(mx > mrun + 8.0f)) {
      const float mnew = fmaxf(mrun, mx);
      const float alpha = __builtin_amdgcn_exp2f(mrun - mnew);
      mrun = mnew;
      lsum *= alpha;
#pragma unroll
      for (int d = 0; d < 4; ++d)
#pragma unroll
        for (int e = 0; e < 16; ++e) O[d][e] *= alpha;
    }
    float rs = 0.f;
#pragma unroll
    for (int kb = 0; kb < 2; ++kb)
#pragma unroll
      for (int e = 0; e < 16; ++e) { const float pv = __builtin_amdgcn_exp2f(st[kb][e] - mrun); st[kb][e] = pv; rs += pv; }
    rs += __shfl_xor(rs, 32, 64);
    lsum += rs;
    union { bf16x8 v; unsigned u[4]; } pf[4];
#pragma unroll
    for (int gi = 0; gi < 4; ++gi) {
      const int kb = gi >> 1, s2 = gi & 1;
      pf[gi].u[0] = pack2(st[kb][8 * s2 + 0], st[kb][8 * s2 + 1]);
      pf[gi].u[1] = pack2(st[kb][8 * s2 + 2], st[kb][8 * s2 + 3]);
      pf[gi].u[2] = pack2(st[kb][8 * s2 + 4], st[kb][8 * s2 + 5]);
      pf[gi].u[3] = pack2(st[kb][8 * s2 + 6], st[kb][8 * s2 + 7]);
    }
    __builtin_amdgcn_sched_barrier(0);
    __builtin_amdgcn_s_setprio(1);
#pragma unroll
    for (int gi = 0; gi < 4; ++gi) {
      if (gi < 3) ATTN_LOADV((gi + 1) & 1, gi + 1)
      __builtin_amdgcn_sched_barrier(0);
#pragma unroll
      for (int d = 0; d < 4; ++d) O[d] = MFMA(va[gi & 1][d], pf[gi].v, O[d]);
      __builtin_amdgcn_sched_barrier(0);
    }
    __builtin_amdgcn_s_setprio(0);
#undef ATTN_LOADV
    if (t + 1 < ntiles) ATTN_STORE(cur ^ 1)
    __syncthreads();
    if (t + 2 < ntiles) ATTN_LOAD(t + 2)
  }
#undef ATTN_LOAD
#undef ATTN_STORE
  __syncthreads();
  float* crow_p = cmb + (rw * 32 + r) * LDC + 4 * h;
  if (m == 1) {
    const float sc = lam / lsum;
#pragma unroll
    for (int d = 0; d < 4; ++d)
#pragma unroll
      for (int rg = 0; rg < 4; ++rg) {
        float4 v; v.x = O[d][rg * 4 + 0] * sc; v.y = O[d][rg * 4 + 1] * sc; v.z = O[d][rg * 4 + 2] * sc; v.w = O[d][rg * 4 + 3] * sc;
        *(float4*)(crow_p + d * 32 + 8 * rg) = v;
      }
  }
  __syncthreads();
  if (m == 0) {
    const float i0 = 1.f / lsum;
    float ss = 0.f;
#pragma unroll
    for (int d = 0; d < 4; ++d)
#pragma unroll
      for (int rg = 0; rg < 4; ++rg) {
        const float4 c = *(const float4*)(crow_p + d * 32 + 8 * rg);
        const float o0 = O[d][rg * 4 + 0] * i0 - c.x, o1 = O[d][rg * 4 + 1] * i0 - c.y, o2 = O[d][rg * 4 + 2] * i0 - c.z, o3 = O[d][rg * 4 + 3] * i0 - c.w;
        O[d][rg * 4 + 0] = o0; O[d][rg * 4 + 1] = o1; O[d][rg * 4 + 2] = o2; O[d][rg * 4 + 3] = o3;
        ss += o0 * o0 + o1 * o1 + o2 * o2 + o3 * o3;
      }
    ss += __shfl_xor(ss, 32, 64);
    const float rstd = rsqrtf(ss * (1.f / 128.f) + 1e-6f) * 0.8f;
#pragma unroll
    for (int d = 0; d < 4; ++d)
#pragma unroll
      for (int rg = 0; rg < 4; ++rg) {
        const int e0 = d * 32 + 8 * rg + 4 * h;
        const float4 gg = *(const float4*)(p.subln_g + e0);
        u32x2 v;
        v.x = pack2(O[d][rg * 4 + 0] * rstd * gg.x, O[d][rg * 4 + 1] * rstd * gg.y);
        v.y = pack2(O[d][rg * 4 + 2] * rstd * gg.z, O[d][rg * 4 + 3] * rstd * gg.w);
        *(u32x2*)((dummy ? (u16*)(ws + G_SP) : QD) + (size_t)qrow * 1024 + head * 128 + e0) = v;
      }
  }
}

DI void step_mix3(const Params& p, int g, char* smem) {
  TILE_COORDS
  char* ws = glaunder(p.ws);
  u16* sA = (u16*)smem; u16* sB = sA + 128 * LDT;
  const float* DEC = (const float*)(ws + OFF_DEC);
  for (int t = lbid(); t < 512 + 512 + 128; t += lgdim()) {
    if (t < 512) {
#if PROBE_M3
      attn_item(p, g, t, smem, true);
#endif
      attn_item(p, g, t, smem); continue; }
    f32x16 acc[2][2];
    zero_acc(acc);
    const int rowb = wm * 64 + 4 * h;
    if (t < 1024) {
      const int tt = t - 512;
      const int chunk = tt >> 4, hh = (tt >> 2) & 3, dir = (tt >> 1) & 1, mt = tt & 1;
      const u16* A = (const u16*)(ws + G_VRT) + (size_t)(hh * 256 + mt * 128) * TG + chunk * 128;
      const u16* Bt = (const u16*)(ws + (dir ? G_KRTB : G_KRTF)) + (size_t)(hh * 128) * TG + chunk * 128;
      gemm_accum(acc, A, TG, Bt, TG, 128, sA, sB, 0);
#pragma unroll
      for (int j = 0; j < 2; ++j) {
        float* kv = launder((float*)(ws + G_KV) + (size_t)((chunk * 4 + hh) * 2 + dir) * 32768 + (size_t)(mt * 128 + rowb) * 128 + COL_L(j, 0));
#pragma unroll
        for (int i = 0; i < 2; ++i)
#pragma unroll
          for (int reg = 0; reg < 16; ++reg) kv[ROFF(i, reg) * 128] = acc[i][j][reg];
        SCHED_FENCE();
      }
    } else {
      const int tt = t - 1024;
      const int chunk = tt >> 2, hh = tt & 3;
      const u16* A = (const u16*)(ws + G_QR) + (size_t)(chunk * 128) * 512 + hh * 128;
      const u16* Bt = (const u16*)(ws + G_KR) + (size_t)(chunk * 128) * 512 + hh * 128;
      gemm_accum(acc, A, 512, Bt, 512, 128, sA, sB, 0);
      const float lgf = DEC[DEC_LGF + hh], lgb = DEC[DEC_LGB + hh];
      int rbl = rowb;
      asm volatile("" : "+v"(rbl));
#pragma unroll
      for (int j = 0; j < 2; ++j) {
        const int cj = COL_L(j, 0);
        u16* sc = launder((u16*)(ws + G_SC) + (size_t)(chunk * 4 + hh) * 16384 + rowb * 128 + cj);
#pragma unroll
        for (int i = 0; i < 2; ++i)
#pragma unroll
          for (int reg = 0; reg < 16; ++reg) {
            const int ri = rbl + ROFF(i, reg);
            const float dd = (float)(ri - cj);
            const float dec = cj <= ri ? __expf(lgf * dd) : __expf(-lgb * dd);
            sc[ROFF(i, reg) * 128] = f2bf(acc[i][j][reg] * dec);
          }
        SCHED_FENCE();
      }
    }
  }
}

template <int NCH> DI void scan_body(const Params& p, int g, char* ws) {
  const float* DEC = (const float*)(ws + OFF_DEC);
  const float* KV = (const float*)(ws + G_KV);
  u16* SP = (u16*)(ws + G_SP);
  const int nseq = (4096 / 128) / NCH;
  const int total = nseq * 262144;
  for (int e = lbid() * 256 + ltid(); e < total; e += lgdim() * 256) {
    const int idx = e & 32767, hd = (e >> 15) & 7, hh = hd >> 1, dir = hd & 1, seq = e >> 18;
    const int dv = idx >> 7, dk = idx & 127;
    float s = 0.f;
    if (g > 0) s = (dir ? p.state_b : p.state_f)[(size_t)((g - 1) * 4 + hh) * 32768 + dk * 256 + dv];
    const float gc = DEC[(dir ? DEC_GCB : DEC_GCF) + hh];
    const int c0 = seq * NCH;
    const size_t ob = (size_t)(((dir ? c0 + NCH - 1 : c0) * 4 + hh) * 2 + dir) * 32768 + idx;
    const ptrdiff_t stp = (ptrdiff_t)(dir ? -1 : 1) * (4 * 2 * 32768);
    float kvv[NCH];
#pragma unroll
    for (int n = 0; n < NCH; ++n) kvv[n] = KV[ob + n * stp];
#pragma unroll
    for (int n = 0; n < NCH; ++n) {
      SP[ob + n * stp] = f2bf(s);
      s = gc * s + kvv[n];
    }
    if (g == 0) (p.out + (dir ? OUT_RB : OUT_RF))[(size_t)(seq * 4 + hh) * 32768 + dk * 256 + dv] = s;
  }
}
DI void step_scan(const Params& p, int g) {
  char* ws = glaunder(p.ws);
  if (g == 0) scan_body<2>(p, g, ws); else scan_body<32>(p, g, ws);
}

DI void step_retout(const Params& p, char* smem) {
  TILE_COORDS
  char* ws = glaunder(p.ws);
  u16* sA = (u16*)smem; u16* sB = sA + 128 * LDT;
  for (int t = lbid(); t < 512; t += lgdim()) {
    const int chunk = t >> 4, hh = (t >> 2) & 3, nt = t & 3;
    f32x16 acc[2][1];
    zero_acc1(acc);
    gemm_accum_t<1>(acc, (const u16*)(ws + G_SC) + (size_t)(chunk * 4 + hh) * 16384, 128,
                    (const u16*)(ws + G_VRT) + (size_t)(hh * 256 + nt * 64) * TG + chunk * 128, TG, 128, sA, sB, 0);
    gemm_accum_t<1>(acc, (const u16*)(ws + G_QA) + (size_t)(chunk * 128) * 512 + hh * 128, 512,
                    (const u16*)(ws + G_SP) + (size_t)((chunk * 4 + hh) * 2 + 0) * 32768 + (size_t)nt * 64 * 128, 128, 128, sA, sB, 0);
    gemm_accum_t<1>(acc, (const u16*)(ws + G_QB) + (size_t)(chunk * 128) * 512 + hh * 128, 512,
                    (const u16*)(ws + G_SP) + (size_t)((chunk * 4 + hh) * 2 + 1) * 32768 + (size_t)nt * 64 * 128, 128, 128, sA, sB, 0);
    const int rowb = chunk * 128 + wm * 64 + 4 * h;
    float* op = launder((float*)(ws + G_KV) + (size_t)rowb * 1024 + hh * 256 + nt * 64 + wn * 32 + r);
#pragma unroll
    for (int i = 0; i < 2; ++i)
#pragma unroll
      for (int reg = 0; reg < 16; ++reg) op[ROFF(i, reg) * 1024] = acc[i][0][reg];
  }
}

DI void step_gn(const Params& p) {
  const int lane = ltid() & 63, wave = ltid() >> 6;
  const float* OPRE = (const float*)(p.ws + G_KV);
  u16* GR = (u16*)(p.ws + G_GR);
  for (int it = lbid() * 4 + wave; it < TG * 4; it += lgdim() * 4) {
    const int tok = it >> 2, hh = it & 3;
    const size_t o = (size_t)tok * 1024 + hh * 256 + lane * 4;
    const float4 v = *(const float4*)(OPRE + o);
    const float mu = wave_sum(v.x + v.y + v.z + v.w) * (1.f / 256.f);
    const float d0 = v.x - mu, d1 = v.y - mu, d2 = v.z - mu, d3 = v.w - mu;
    const float var = wave_sum(d0 * d0 + d1 * d1 + d2 * d2 + d3 * d3) * (1.f / 256.f);
    const float rstd = rsqrtf(var + 1e-5f);
    const float4 gg = *(const float4*)(p.gn_g + hh * 256 + lane * 4);
    const u32x2 gr = *(const u32x2*)(GR + o);
    u32x2 w;
    w.x = pack2(d0 * rstd * gg.x * bf2f((u16)(gr.x & 0xffff)), d1 * rstd * gg.y * bf2f((u16)(gr.x >> 16)));
    w.y = pack2(d2 * rstd * gg.z * bf2f((u16)(gr.y & 0xffff)), d3 * rstd * gg.w * bf2f((u16)(gr.y >> 16)));
    *(u32x2*)(GR + o) = w;
  }
}

DI void step_branch(const Params& p, char* smem) {
  TILE_COORDS
  char* ws = glaunder(p.ws);
  u16* sA = (u16*)smem; u16* sB = sA + 128 * LDT;
  for (int t = lbid(); t < 512; t += lgdim()) {
    const int ntile = t >> 5, mt = t & 31;
    const int m0 = mt * 128, n0 = ntile * 64;
    const int rowb = m0 + wm * 64 + 4 * h;
    const int col = n0 + wn * 32 + r;
    f32x16 acc[2][1];
    zero_acc1(acc);
    gemm_accum_t<1>(acc, (const u16*)(ws + G_GR) + (size_t)m0 * 1024, 1024, (const u16*)(ws + OFF_WR) + (size_t)n0 * 1024, 1024, 1024, sA, sB, 0);
    {
      const u16* gt = launder((const u16*)(ws + G_GATES) + (size_t)rowb * 2048 + col);
      float* tmp = launder((float*)(ws + G_KV) + (size_t)rowb * 1024 + col);
#pragma unroll
      for (int i = 0; i < 2; ++i)
#pragma unroll
        for (int reg = 0; reg < 16; ++reg) tmp[ROFF(i, reg) * 1024] = acc[i][0][reg] * bf2f(gt[ROFF(i, reg) * 2048]);
      SCHED_FENCE();
    }
    zero_acc1(acc);
    gemm_accum_t<1>(acc, (const u16*)(ws + G_QD) + (size_t)m0 * 1024, 1024, (const u16*)(ws + OFF_WD) + (size_t)n0 * 1024, 1024, 1024, sA, sB, 0);
    {
      const u16* gt = launder((const u16*)(ws + G_GATES) + (size_t)rowb * 2048 + 1024 + col);
      const float* tmp = launder((const float*)(ws + G_KV) + (size_t)rowb * 1024 + col);
      u16* mix = launder((u16*)(ws + G_MIX) + (size_t)rowb * 1024 + col + (r & 1) * 1023);
#pragma unroll
      for (int i = 0; i < 2; ++i)
#pragma unroll
        for (int reg = 0; reg < 16; reg += 2)
          st_pair_bf16(mix, ROFF(i, reg), 1024, tmp[ROFF(i, reg) * 1024] + acc[i][0][reg] * bf2f(gt[ROFF(i, reg) * 2048]),
                       tmp[ROFF(i, reg + 1) * 1024] + acc[i][0][reg + 1] * bf2f(gt[ROFF(i, reg + 1) * 2048]), r & 1);
      SCHED_FENCE();
    }
  }
}

DI void step_wo(const Params& p, int g, char* smem) {
  TILE_COORDS
  char* ws = glaunder(p.ws);
  u16* sA = (u16*)smem; u16* sB = sA + 128 * LDT;
  const float* gate1 = (const float*)(ws + OFF_MOD) + g * 6144 + 2048;
  for (int t = lbid(); t < 512; t += lgdim()) {
    const int ntile = t >> 5, mt = t & 31;
    const int m0 = mt * 128, n0 = ntile * 64;
    f32x16 acc[2][1];
    zero_acc1(acc);
    gemm_accum_t<1>(acc, (const u16*)(ws + G_MIX) + (size_t)m0 * 1024, 1024, (const u16*)(ws + OFF_WO) + (size_t)n0 * 1024, 1024, 1024, sA, sB, 0);
    const int rowb = g * TG + m0 + wm * 64 + 4 * h;
    const int col = n0 + wn * 32 + r;
    const float g1 = gate1[col];
    const float* xs = launder(xrow(p, rowb) + col + (r & 1) * (D - 1));
    float* o = launder(p.out + OUT_Y + (size_t)rowb * D + col + (r & 1) * (D - 1));
#pragma unroll
    for (int i = 0; i < 2; ++i)
#pragma unroll
      for (int reg = 0; reg < 16; reg += 2) st_pair_f32_add(o, xs, ROFF(i, reg), D, g1 * acc[i][0][reg], g1 * acc[i][0][reg + 1], r & 1);
  }
}

DI void step_ffn_up(const Params& p, char* smem) {
  TILE_COORDS
  char* ws = glaunder(p.ws);
  u16* sA = (u16*)smem; u16* sB = sA + 128 * LDT;
  for (int t = lbid(); t < 80 * 44; t += lgdim()) {
    const int ntile = t / 80, mt = t % 80;
    const int m0 = mt * 256, n0 = ntile * 128;
    f32x16 acc[4][2];
    zero_acc4(acc);
    gemm_accum_256(acc, (const u16*)(ws + OFF_HB) + (size_t)m0 * 1024, 1024, 64, 128 * 1024, (const u16*)(ws + OFF_WGU) + (size_t)n0 * 1024, 1024, 64, 1024, sA, 0);
    const int rowb = m0 + wm * 128 + 4 * h;
    u16* act = launder((u16*)(ws + OFF_ACT) + (size_t)rowb * FF + ntile * 64 + 32 * wn + r + (r & 1) * (FF - 1));
#pragma unroll
    for (int i = 0; i < 4; ++i) {
#pragma unroll
      for (int reg = 0; reg < 16; reg += 2) st_pair_bf16(act, ROFF(i, reg), FF, silu_f(acc[i][0][reg]) * acc[i][1][reg], silu_f(acc[i][0][reg + 1]) * acc[i][1][reg + 1], r & 1);
      SCHED_FENCE();
    }
  }
}

DI void step_ffn_down(const Params& p, char* smem) {
  TILE_COORDS
  char* ws = glaunder(p.ws);
  u16* sA = (u16*)smem; u16* sB = sA + 128 * LDT;
  const float* MOD = (const float*)(ws + OFF_MOD);
  for (int t = lbid(); t < 160 * 8; t += lgdim()) {
    const int ntile = t / 160, mt = t % 160;
    const int m0 = mt * 128, n0 = ntile * 128;
    f32x16 acc[2][2];
    zero_acc(acc);
    gemm_accum(acc, (const u16*)(ws + OFF_ACT) + (size_t)m0 * FF, FF, (const u16*)(ws + OFF_WDN) + (size_t)n0 * FF, FF, FF, sA, sB, 0);
    const int mv = m0 < TG ? 0 : 1 + ((m0 - TG) >> 12);
    const float* gate2 = MOD + mv * 6144 + 5120;
    const int rowb = m0 + wm * 64 + 4 * h;
#pragma unroll
    for (int j = 0; j < 2; ++j) {
      const int col = n0 + COL_L(j, 0);
      const float g2 = gate2[col];
      float* o = launder(p.out + OUT_Y + (size_t)rowb * D + col + (r & 1) * (D - 1));
#pragma unroll
      for (int i = 0; i < 2; ++i)
#pragma unroll
        for (int reg = 0; reg < 16; reg += 2) st_pair_f32_add(o, o, ROFF(i, reg), D, g2 * acc[i][j][reg], g2 * acc[i][j][reg + 1], r & 1);
      SCHED_FENCE();
    }
  }
}


#define XB_TMO      128
#define XB_XCNT(j)  (256  + 64 * (j))
#define XB_XSUB(j)  (1280 + 64 * (j))
#define XB_XGEN(j)  (2304 + 64 * (j))
#define XB_TOP      3328
#define XB_TOPGEN   3392
#define XCD_BAR_WORDS 3456
#define XB_SPIN_CAP (1u << 22)
#define LAS __attribute__((address_space(3)))
DI unsigned xb_ld(unsigned* p)              { return __hip_atomic_load(p, __ATOMIC_RELAXED, __HIP_MEMORY_SCOPE_AGENT); }
DI unsigned xb_add(unsigned* p, unsigned v) { return __hip_atomic_fetch_add(p, v, __ATOMIC_RELAXED, __HIP_MEMORY_SCOPE_AGENT); }
DI unsigned xb_xcc_id() { return (unsigned)__builtin_amdgcn_s_getreg((3 << 11) | 20) & 0xFu; }
#define XB_SPIN(cond, bar) do { unsigned _sp = 0; while (cond) { __builtin_amdgcn_s_sleep(1); \
    if ((++_sp & 255u) == 0u) { if (xb_ld(&(bar)[XB_TMO])) break; if (_sp > XB_SPIN_CAP) { atomicAdd(&(bar)[XB_TMO], 1u); break; } } } } while (0)
struct XcdBarrier { unsigned* bar; unsigned x; volatile LAS unsigned* st; };
DI XcdBarrier xcd_barrier_post(unsigned* bar, volatile LAS unsigned* st) {
  XcdBarrier b; b.bar = bar; b.x = xb_xcc_id(); b.st = st;
  if (threadIdx.x == 0) (void)xb_add(&bar[XB_XCNT(b.x)], 1u);
  return b;
}
DI void xcd_barrier_complete(unsigned* bar, unsigned x, unsigned& nloc, unsigned& nx) {
  const unsigned G = gridDim.x * gridDim.y * gridDim.z;
  unsigned sum, cnt, mine, sp = 0u;
  for (;;) {
    sum = 0u; cnt = 0u; mine = 0u;
#pragma unroll
    for (unsigned j = 0; j < 16; ++j) { const unsigned c = xb_ld(&bar[XB_XCNT(j)]); sum += c; cnt += (c > 0u) ? 1u : 0u; mine = (j == x) ? c : mine; }
    if (sum == G) break;
    __builtin_amdgcn_s_sleep(1);
    if ((++sp & 255u) == 0u) { if (xb_ld(&bar[XB_TMO])) break; if (sp > XB_SPIN_CAP) { atomicAdd(&bar[XB_TMO], 1u); break; } }
  }
  nloc = mine > 0u ? mine : 1u; nx = cnt > 0u ? cnt : 1u;
}
DI void xcd_barrier(const XcdBarrier& b) {
  asm volatile("s_waitcnt vmcnt(0)" ::: "memory");
  __syncthreads();
  if (threadIdx.x == 0) {
    unsigned* bar = b.bar;
    __builtin_amdgcn_s_waitcnt(0);
    unsigned nloc = b.st[0], nx = b.st[1];
    if (nloc == 0u) { xcd_barrier_complete(bar, b.x, nloc, nx); b.st[0] = nloc; b.st[1] = nx; }
    const unsigned old = xb_add(&bar[XB_XSUB(b.x)], 1u);
    const unsigned gen = old / nloc;
    if (old + 1u == (gen + 1u) * nloc) {
      __builtin_amdgcn_fence(__ATOMIC_RELEASE, "agent");
      asm volatile("s_waitcnt vmcnt(0)" ::: "memory");
      const unsigned og = xb_add(&bar[XB_TOP], 1u);
      const unsigned tg = og / nx;
      if (og + 1u == (tg + 1u) * nx) xb_add(&bar[XB_TOPGEN], 1u);
      else XB_SPIN(xb_ld(&bar[XB_TOPGEN]) == tg, bar);
      __builtin_amdgcn_fence(__ATOMIC_ACQUIRE, "agent");
      xb_add(&bar[XB_XGEN(b.x)], 1u);
      asm volatile("s_waitcnt vmcnt(0)" ::: "memory");
    } else {
      XB_SPIN(xb_ld(&bar[XB_XGEN(b.x)]) == gen, bar);
      __builtin_amdgcn_fence(__ATOMIC_ACQUIRE, "agent");
      asm volatile("s_waitcnt vmcnt(0)" ::: "memory");
    }
  }
  __syncthreads();
}

constexpr int NSTEPS = 37;

__global__ void __launch_bounds__(256, 2) mega(Params p, int lo, int hi) {
  __shared__ __attribute__((aligned(16))) char smem[SMEM_BYTES];
  __shared__ uint4 xb_words;
  cg::grid_group grid = cg::this_grid();
  if (lo > hi) grid.sync();
  if (threadIdx.x == 0) xb_words = make_uint4(0u, 0u, 0u, 0u);
  __syncthreads();
  XcdBarrier xb = xcd_barrier_post((unsigned*)(p.ws + OFF_BAR), (volatile LAS unsigned*)&xb_words);
  for (int step = lo; step < hi; ++step) {
    if (step == 0) { step_p0(p, smem); if (PROBE_M1) step_p0(p, smem); }
    else if (step == 1) { step_rownorm(p, 0); if (PROBE_M1) step_rownorm(p, 0); }
    else if (step == 2) step_proj(p, 0, smem);
    else if (step < 33) {
      const int g = (step - 3) / 6, s = (step - 3) % 6;
      if (s == 0) step_mix3(p, g, smem);
      else if (s == 1) { step_scan(p, g); if (PROBE_M1) step_scan(p, g); }
      else if (s == 2) { step_retout(p, smem); if (PROBE_M2) step_retout(p, smem); }
      else if (s == 3) step_gn(p);
      else if (s == 4) { step_branch(p, smem); if (PROBE_M2) step_branch(p, smem); }
      else { step_wo(p, g, smem); if (g < 4) step_proj(p, g + 1, smem); }
    } else if (step == 33) { step_rownorm(p, 1); if (PROBE_M1) step_rownorm(p, 1); }
    else if (step == 34) step_ffn_up(p, smem);
    else if (step == 35) step_ffn_down(p, smem);
    else step_rownorm(p, 2);
    if (step + 1 < hi) xcd_barrier(xb);
  }
}

extern "C" void kernel_launch(void* const* d_in, const int* in_sizes, int n_in, void* d_out, int out_size, void* d_ws, size_t ws_size, hipStream_t stream) {
  static int grid_blocks = 0;
  if (!grid_blocks) {
    int dev = 0, cus = 0, per_cu = 0;
    hipGetDevice(&dev);
    hipDeviceGetAttribute(&cus, hipDeviceAttributeMultiprocessorCount, dev);
    hipOccupancyMaxActiveBlocksPerMultiprocessor(&per_cu, mega, 256, 0);
    if (per_cu < 1) per_cu = 1;
    if (per_cu > 2) per_cu = 2;
    grid_blocks = cus * per_cu;
  }
  Params p{};
  const float** f = (const float**)&p;
  for (int i = 0; i < 29; ++i) f[i] = (const float*)d_in[i];
  p.out = (float*)d_out;
  p.ws = (char*)d_ws;
  hipMemsetAsync((char*)d_ws + OFF_BAR, 0, XCD_BAR_WORDS * 4, stream);
#if COOP
  int lo = 0, hi = NSTEPS;
  void* args[] = {&p, &lo, &hi};
  hipError_t e = hipLaunchCooperativeKernel((void*)mega, dim3(grid_blocks), dim3(256), args, 0, stream);
  if (e != hipSuccess) fprintf(stderr, "cooperative launch failed: %s (grid %d)\n", hipGetErrorString(e), grid_blocks);
#else
  for (int s = 0; s < NSTEPS; ++s) hipLaunchKernelGGL(mega, dim3(grid_blocks), dim3(256), 0, stream, p, s, s + 1);
#endif
}
```

```cpp
#include <hip/hip_runtime.h>
#include <hip/hip_cooperative_groups.h>
#include <cstdio>
namespace cg = cooperative_groups;

#ifndef PROBE_M1
#define PROBE_M1 0
#endif
#ifndef PROBE_M2
#define PROBE_M2 0
#endif
#ifndef PROBE_M3
#define PROBE_M3 0
#endif
#ifndef COOP
#define COOP 1
#endif

#define DI __device__ __forceinline__
typedef unsigned short u16;
typedef __attribute__((ext_vector_type(8))) short bf16x8;
typedef __attribute__((ext_vector_type(4))) short s16x4;
typedef __attribute__((ext_vector_type(16))) float f32x16;
typedef __attribute__((ext_vector_type(4))) unsigned u32x4;
typedef __attribute__((ext_vector_type(2))) unsigned u32x2;
#define SCHED_FENCE() asm volatile("" ::: "memory")
#define MFMA(a, b, c) __builtin_amdgcn_mfma_f32_32x32x16_bf16((a), (b), (c), 0, 0, 0)

constexpr int D = 1024;
constexpr int TG = 4096;
constexpr int NG = 5;
constexpr int TT = TG * NG;
constexpr int FF = 2816;
constexpr int WCOLS = 8192;

constexpr size_t OFF_WIN = 0;
constexpr size_t OFF_WR = OFF_WIN + (size_t)8192 * 1024 * 2;
constexpr size_t OFF_WD = OFF_WR + 2097152;
constexpr size_t OFF_WO = OFF_WD + 2097152;
constexpr size_t OFF_WGU = OFF_WO + 2097152;
constexpr size_t OFF_WDN = OFF_WGU + (size_t)5632 * 1024 * 2;
constexpr size_t OFF_MOD = OFF_WDN + (size_t)1024 * 2816 * 2;
constexpr size_t OFF_COSR = OFF_MOD + 122880;
constexpr size_t OFF_SINR = OFF_COSR + 1048576;
constexpr size_t OFF_COSD = OFF_SINR + 1048576;
constexpr size_t OFF_SIND = OFF_COSD + 524288;
constexpr size_t OFF_DEC = OFF_SIND + 524288;
constexpr size_t OFF_KC = OFF_DEC + 16384;
constexpr size_t OFF_VCT = OFF_KC + 2097152;
constexpr size_t OFF_HB = OFF_VCT + 2097152;
constexpr size_t OFF_G = OFF_HB + (size_t)TT * 1024 * 2;
constexpr size_t G_QR = OFF_G;
constexpr size_t G_QA = G_QR + 4194304;
constexpr size_t G_QB = G_QA + 4194304;
constexpr size_t G_KR = G_QB + 4194304;
constexpr size_t G_KRTF = G_KR + 4194304;
constexpr size_t G_KRTB = G_KRTF + 4194304;
constexpr size_t G_VRT = G_KRTB + 4194304;
constexpr size_t G_GR = G_VRT + 8388608;
constexpr size_t G_QD = G_GR + 8388608;
constexpr size_t G_KD = G_QD + 8388608;
constexpr size_t G_VDT = G_KD + 8388608;
constexpr size_t G_GATES = G_VDT + 8388608;
constexpr size_t G_KV = G_GATES + 16777216;
constexpr size_t G_SP = G_KV + 33554432;
constexpr size_t G_SC = G_SP + 16777216;
constexpr size_t G_MIX = G_SC + 4194304;
constexpr size_t G_END = G_MIX + 8388608;
constexpr size_t OFF_BAR = G_END;
constexpr size_t OFF_ACT = OFF_G;
static_assert((size_t)TT * FF * 2 <= G_END - OFF_G, "ACT alias");
static_assert(G_END + 16384 <= (size_t)256 * 1024 * 1024, "ws");

constexpr int DEC_WQF = 0, DEC_WQB = 512, DEC_WKF = 1024, DEC_WKB = 1536, DEC_LGF = 2048, DEC_LGB = 2052, DEC_GCF = 2056, DEC_GCB = 2060, DEC_LAM = 2064;

constexpr size_t OUT_Y = 0;
constexpr size_t OUT_RF = (size_t)TT * 1024;
constexpr size_t OUT_RB = OUT_RF + 2097152;
constexpr size_t OUT_DK = OUT_RB + 2097152;
constexpr size_t OUT_DV = OUT_DK + 4194304;

struct Params {
  const float *x_prompt, *x_sample, *state_f, *state_b, *cache_k, *cache_v, *c, *c_ctx, *norm1_g, *norm2_g, *w_ada, *b_ada, *w_in, *b_gate,
      *decay_f, *decay_b, *gn_g, *w_ret_out, *lq1, *lk1, *lq2, *lk2, *subln_g, *w_diff_out, *w_o, *w_gate, *w_up, *w_down, *final_g;
  float* out;
  char* ws;
};

DI int ltid() { int t = threadIdx.x; asm volatile("" : "+v"(t)); return t; }
DI char* glaunder(char* p) { __attribute__((address_space(1))) char* g = (__attribute__((address_space(1))) char*)p; asm volatile("" : "+s"(g)); return (char*)g; }
DI int lbid() { int b = blockIdx.x; asm volatile("" : "+s"(b)); return b; }
DI int lgdim() { int b = gridDim.x; asm volatile("" : "+s"(b)); return b; }
typedef __bf16 hbf16x2 __attribute__((ext_vector_type(2)));
typedef float f32x2 __attribute__((ext_vector_type(2)));
DI u16 f2bf(float x) { return __builtin_bit_cast(u16, (__bf16)x); }
DI float bf2f(u16 v) { return __uint_as_float(((unsigned)v) << 16); }
DI unsigned pack2(float a, float b) { f32x2 v = {a, b}; return __builtin_bit_cast(unsigned, __builtin_convertvector(v, hbf16x2)); }
DI float silu_f(float x) { return x * __builtin_amdgcn_rcpf(1.f + __expf(-x)); }
DI float sigmoid_f(float x) { return __builtin_amdgcn_rcpf(1.f + __expf(-x)); }
DI float wave_sum(float v) {
#pragma unroll
  for (int o = 32; o > 0; o >>= 1) v += __shfl_xor(v, o, 64);
  return v;
}
DI const float* xrow(const Params& p, int row) { return row < TG ? p.x_prompt + (size_t)row * D : p.x_sample + (size_t)(row - TG) * D; }

constexpr int LDT = 72;
constexpr int SMEM_BYTES = 2 * 2 * 128 * LDT * 2;
constexpr int SMEM_OLD_UNUSED = 0;

template <int NJ>
DI void gemm_accum_t(f32x16 (&acc)[2][NJ], const u16* A, int lda, const u16* Bt, int ldb, int K, u16* sA, u16* sB, int cbmode) {
  constexpr int STG = 2 * 128 * LDT;
  constexpr int NB = 2 * NJ;
  const int tid = ltid(), lane = tid & 63, wave = tid >> 6, wm = wave >> 1, wn = wave & 1, r = lane & 31, h = lane >> 5;
  const int lrow = tid >> 3, lcol = (tid & 7) * 8;
  const u16* ap = A + (size_t)lrow * lda + lcol;
  const u16* bp = Bt + (size_t)lrow * ldb + lcol;
  const int nk = K >> 6;
  u32x4 ra[3][4], rb[3][NB];
#define GEMM_LOAD(SET)                                                                            \
  {                                                                                               \
    _Pragma("unroll") for (int q = 0; q < 4; ++q) ra[SET][q] = *(const u32x4*)(ap + (size_t)(32 * q) * lda);  \
    _Pragma("unroll") for (int q = 0; q < NB; ++q) rb[SET][q] = *(const u32x4*)(bp + (size_t)(32 * q) * ldb); \
    ap += 64; bp += 64;                                                                           \
  }
  GEMM_LOAD(0)
  if (nk > 1) GEMM_LOAD(1)
  if (nk > 2) GEMM_LOAD(2)
  const int cb0 = NJ == 1 ? wn : (cbmode ? wn : 2 * wn), cb1 = cbmode ? wn + 2 : 2 * wn + 1;
  const u16* sa0 = sA + (wm * 64 + r) * LDT + h * 8;
  const u16* sb0 = sB + (cb0 * 32 + r) * LDT + h * 8;
  const u16* sb1 = sB + (cb1 * 32 + r) * LDT + h * 8;
  u16* wa = sA + lrow * LDT + lcol;
  u16* wb = sB + lrow * LDT + lcol;
  __syncthreads();
#pragma unroll
  for (int q = 0; q < 4; ++q) *(u32x4*)(wa + 32 * q * LDT) = ra[0][q];
#pragma unroll
  for (int q = 0; q < NB; ++q) *(u32x4*)(wb + 32 * q * LDT) = rb[0][q];
  __syncthreads();
#define GEMM_ITER(IDX, PAR, SET)                                                                  \
  {                                                                                               \
    const int kk = kt + IDX;                                                                      \
    if (kk + 3 < nk) GEMM_LOAD(SET)                                                               \
                       \
    bf16x8 fa[2][2], fb[2][2];                                                                    \
    fa[0][0] = *(const bf16x8*)(sa0 + PAR * STG);                                                 \
    fa[0][1] = *(const bf16x8*)(sa0 + PAR * STG + 32 * LDT);                                      \
    fb[0][0] = *(const bf16x8*)(sb0 + PAR * STG);                                                 \
    fb[0][1] = *(const bf16x8*)((NJ == 2 ? sb1 : sb0) + PAR * STG);                               \
    _Pragma("unroll") for (int ks = 0; ks < 4; ++ks) {                                            \
      if (ks < 3) {                                                                               \
        fa[(ks + 1) & 1][0] = *(const bf16x8*)(sa0 + PAR * STG + (ks + 1) * 16);                  \
        fa[(ks + 1) & 1][1] = *(const bf16x8*)(sa0 + PAR * STG + 32 * LDT + (ks + 1) * 16);       \
        fb[(ks + 1) & 1][0] = *(const bf16x8*)(sb0 + PAR * STG + (ks + 1) * 16);                  \
        if (NJ == 2) fb[(ks + 1) & 1][1] = *(const bf16x8*)(sb1 + PAR * STG + (ks + 1) * 16);     \
      }                                                                                           \
      __builtin_amdgcn_sched_barrier(0);                                                          \
      acc[0][0] = MFMA(fa[ks & 1][0], fb[ks & 1][0], acc[0][0]);                                  \
      acc[1][0] = MFMA(fa[ks & 1][1], fb[ks & 1][0], acc[1][0]);                                  \
      if (NJ == 2) {                                                                              \
        acc[0][NJ - 1] = MFMA(fa[ks & 1][0], fb[ks & 1][1], acc[0][NJ - 1]);                      \
        acc[1][NJ - 1] = MFMA(fa[ks & 1][1], fb[ks & 1][1], acc[1][NJ - 1]);                      \
      }                                                                                           \
      __builtin_amdgcn_sched_barrier(0);                                                          \
    }                                                                                             \
    if (kk + 1 < nk) {                                                                            \
      _Pragma("unroll") for (int q = 0; q < 4; ++q) *(u32x4*)(wa + (1 - PAR) * STG + 32 * q * LDT) = ra[(SET + 1) % 3][q];  \
      _Pragma("unroll") for (int q = 0; q < NB; ++q) *(u32x4*)(wb + (1 - PAR) * STG + 32 * q * LDT) = rb[(SET + 1) % 3][q]; \
    }                                                                                             \
    __syncthreads();                                                                              \
  }
  for (int kt = 0; kt < nk; kt += 6) {
    GEMM_ITER(0, 0, 0)
    if (kt + 1 < nk) GEMM_ITER(1, 1, 1)
    if (kt + 2 < nk) GEMM_ITER(2, 0, 2)
    if (kt + 3 < nk) GEMM_ITER(3, 1, 0)
    if (kt + 4 < nk) GEMM_ITER(4, 0, 1)
    if (kt + 5 < nk) GEMM_ITER(5, 1, 2)
  }
#undef GEMM_ITER
#undef GEMM_LOAD
}
DI void gemm_accum_256(f32x16 (&acc)[4][2], const u16* A, int a_rs, int a_ks, int a_sub, const u16* Bt, int b_rs, int b_ks, int K, u16* sA, int cbmode) {
  u16* sB = sA + 256 * LDT;
  const int tid = ltid(), lane = tid & 63, wave = tid >> 6, wm = wave >> 1, wn = wave & 1, r = lane & 31, h = lane >> 5;
  const int lrow = tid >> 3, lcol = (tid & 7) * 8;
  const u16* ap = A + (size_t)lrow * a_rs + lcol;
  const u16* bp = Bt + (size_t)lrow * b_rs + lcol;
  const int nk = K >> 6;
  u32x4 ra[8], rb[4];
#define A_OFF(q) ((size_t)((q) >> 2) * a_sub + (size_t)(32 * ((q) & 3)) * a_rs)
#pragma unroll
  for (int q = 0; q < 8; ++q) ra[q] = *(const u32x4*)(ap + A_OFF(q));
#pragma unroll
  for (int q = 0; q < 4; ++q) rb[q] = *(const u32x4*)(bp + (size_t)(32 * q) * b_rs);
  const int cb0 = cbmode ? wn : 2 * wn, cb1 = cbmode ? wn + 2 : 2 * wn + 1;
  const u16* sa0 = sA + (wm * 128 + r) * LDT + h * 8;
  const u16* sb0 = sB + (cb0 * 32 + r) * LDT + h * 8;
  const u16* sb1 = sB + (cb1 * 32 + r) * LDT + h * 8;
  u16* wa = sA + lrow * LDT + lcol;
  u16* wb = sB + lrow * LDT + lcol;
  for (int kt = 0; kt < nk; ++kt) {
    __syncthreads();
#pragma unroll
    for (int q = 0; q < 8; ++q) *(u32x4*)(wa + 32 * q * LDT) = ra[q];
#pragma unroll
    for (int q = 0; q < 4; ++q) *(u32x4*)(wb + 32 * q * LDT) = rb[q];
    __syncthreads();
    if (kt + 1 < nk) {
      ap += a_ks; bp += b_ks;
#pragma unroll
      for (int q = 0; q < 8; ++q) ra[q] = *(const u32x4*)(ap + A_OFF(q));
#pragma unroll
      for (int q = 0; q < 4; ++q) rb[q] = *(const u32x4*)(bp + (size_t)(32 * q) * b_rs);
    }
    bf16x8 fa[4], fb[2][2];
    fb[0][0] = *(const bf16x8*)(sb0);
    fb[0][1] = *(const bf16x8*)(sb1);
#pragma unroll
    for (int i = 0; i < 4; ++i) fa[i] = *(const bf16x8*)(sa0 + i * 32 * LDT);
#pragma unroll
    for (int ks = 0; ks < 4; ++ks) {
      if (ks < 3) {
        fb[(ks + 1) & 1][0] = *(const bf16x8*)(sb0 + (ks + 1) * 16);
        fb[(ks + 1) & 1][1] = *(const bf16x8*)(sb1 + (ks + 1) * 16);
      }
#pragma unroll
      for (int i = 0; i < 4; ++i) {
        __builtin_amdgcn_sched_barrier(0);
        acc[i][0] = MFMA(fa[i], fb[ks & 1][0], acc[i][0]);
        acc[i][1] = MFMA(fa[i], fb[ks & 1][1], acc[i][1]);
        __builtin_amdgcn_sched_barrier(0);
        if (ks < 3) fa[i] = *(const bf16x8*)(sa0 + i * 32 * LDT + (ks + 1) * 16);
      }
    }
  }
}
#undef A_OFF
DI void zero_acc4(f32x16 (&acc)[4][2]) {
#pragma unroll
  for (int i = 0; i < 4; ++i)
#pragma unroll
    for (int j = 0; j < 2; ++j)
#pragma unroll
      for (int e = 0; e < 16; ++e) acc[i][j][e] = 0.f;
}
DI void gemm_accum(f32x16 (&acc)[2][2], const u16* A, int lda, const u16* Bt, int ldb, int K, u16* sA, u16* sB, int cbmode) {
  gemm_accum_t<2>(acc, A, lda, Bt, ldb, K, sA, sB, cbmode);
}
DI void zero_acc1(f32x16 (&acc)[2][1]) {
#pragma unroll
  for (int i = 0; i < 2; ++i)
#pragma unroll
    for (int e = 0; e < 16; ++e) acc[i][0][e] = 0.f;
}

DI void zero_acc(f32x16 (&acc)[2][2]) {
#pragma unroll
  for (int i = 0; i < 2; ++i)
#pragma unroll
    for (int j = 0; j < 2; ++j)
#pragma unroll
      for (int e = 0; e < 16; ++e) acc[i][j][e] = 0.f;
}

#define TILE_COORDS                                                                                  \
  const int tid = ltid(), lane = tid & 63, wave = tid >> 6, wm = wave >> 1, wn = wave & 1;      \
  const int r = lane & 31, h = lane >> 5;                                                            \
  (void)r; (void)h; (void)wm; (void)wn;
#define ROW_L(i, reg) (wm * 64 + (i) * 32 + ((reg) & 3) + 8 * ((reg) >> 2) + 4 * h)
#define COL_L(j, cbmode) (((cbmode) ? (wn + 2 * (j)) : (2 * wn + (j))) * 32 + r)

DI void step_p0(const Params& p, char* smem) {
  const int tid = ltid();
  char* ws = glaunder(p.ws);
  {
    float(*tile)[65] = (float(*)[65])smem;
    constexpr int NT_ALL = 2048 + 768 + 1408 + 704 + 256;
    for (int t = lbid(); t < NT_ALL; t += lgdim()) {
      const float* src; int N; u16* dst; int dld; int mode = 0; int ntl; int tt = t;
      if (tt < 2048) { src = p.w_in; N = 8192; dst = (u16*)(ws + OFF_WIN); dld = 1024; ntl = 128; }
      else if ((tt -= 2048) < 256) { src = p.w_ret_out; N = 1024; dst = (u16*)(ws + OFF_WR); dld = 1024; ntl = 16; }
      else if ((tt -= 256) < 256) { src = p.w_diff_out; N = 1024; dst = (u16*)(ws + OFF_WD); dld = 1024; ntl = 16; }
      else if ((tt -= 256) < 256) { src = p.w_o; N = 1024; dst = (u16*)(ws + OFF_WO); dld = 1024; ntl = 16; }
      else if ((tt -= 256) < 704) { src = p.w_gate; N = FF; dst = (u16*)(ws + OFF_WGU); dld = 1024; mode = 1; ntl = 44; }
      else if ((tt -= 704) < 704) { src = p.w_up; N = FF; dst = (u16*)(ws + OFF_WGU); dld = 1024; mode = 2; ntl = 44; }
      else if ((tt -= 704) < 704) { src = p.w_down; N = 1024; dst = (u16*)(ws + OFF_WDN); dld = FF; ntl = 16; }
      else { tt -= 704; int b = tt >> 6; tt &= 63; src = p.cache_v + (size_t)b * 256 * 1024; N = 1024; dst = (u16*)(ws + OFF_VCT) + (size_t)b * 1024 * 256; dld = 256; ntl = 16; }
      const int kt = tt / ntl, nt = tt % ntl;
      __syncthreads();
#pragma unroll
      for (int q = 0; q < 4; ++q) {
        const int k = (tid >> 4) + 16 * q, n4 = (tid & 15) * 4;
        const float4 v = *(const float4*)(src + (size_t)(kt * 64 + k) * N + nt * 64 + n4);
        tile[k][n4 + 0] = v.x; tile[k][n4 + 1] = v.y; tile[k][n4 + 2] = v.z; tile[k][n4 + 3] = v.w;
      }
      __syncthreads();
#pragma unroll
      for (int q = 0; q < 2; ++q) {
        const int n = (tid >> 3) + 32 * q, k8 = (tid & 7) * 8;
        uint4 o;
        o.x = pack2(tile[k8 + 0][n], tile[k8 + 1][n]);
        o.y = pack2(tile[k8 + 2][n], tile[k8 + 3][n]);
        o.z = pack2(tile[k8 + 4][n], tile[k8 + 5][n]);
        o.w = pack2(tile[k8 + 6][n], tile[k8 + 7][n]);
        const int ng = nt * 64 + n;
        const int drow = mode == 0 ? ng : (64 * (ng >> 5) + (mode == 2 ? 32 : 0) + (ng & 31));
        if (t < 2048) *(uint4*)(dst + ((size_t)((drow >> 7) * 16 + kt) * 128 + (drow & 127)) * 64 + k8) = o;
        else *(uint4*)(dst + (size_t)drow * dld + kt * 64 + k8) = o;
      }
    }
  }
  {
    float* sil = (float*)smem;
    float* red = sil + 5 * 1024;
    float* MOD = (float*)(ws + OFF_MOD);
    for (int t = lbid(); t < 192; t += lgdim()) {
      __syncthreads();
      for (int e = tid; e < 5 * 1024; e += 256) {
        const int v = e >> 10, k = e & 1023;
        const float cv = v == 0 ? p.c_ctx[k] : p.c[(v - 1) * 1024 + k];
        sil[e] = silu_f(cv);
      }
      __syncthreads();
      const int cidx = tid & 31, kg = tid >> 5, n0 = t * 32;
      float a0 = 0, a1 = 0, a2 = 0, a3 = 0, a4 = 0;
      const float* wp = p.w_ada + (size_t)kg * 6144 + n0 + cidx;
      for (int k0 = 0; k0 < 128; k0 += 16) {
        float w[16];
#pragma unroll
        for (int u = 0; u < 16; ++u) w[u] = wp[(size_t)(k0 + u) * (8 * 6144)];
#pragma unroll
        for (int u = 0; u < 16; ++u) {
          const int k = kg + 8 * (k0 + u);
          a0 += sil[k] * w[u]; a1 += sil[1024 + k] * w[u]; a2 += sil[2048 + k] * w[u]; a3 += sil[3072 + k] * w[u]; a4 += sil[4096 + k] * w[u];
        }
      }
      red[(kg * 5 + 0) * 32 + cidx] = a0; red[(kg * 5 + 1) * 32 + cidx] = a1; red[(kg * 5 + 2) * 32 + cidx] = a2;
      red[(kg * 5 + 3) * 32 + cidx] = a3; red[(kg * 5 + 4) * 32 + cidx] = a4;
      __syncthreads();
      if (tid < 160) {
        const int v = tid >> 5, cc = tid & 31;
        float s = p.b_ada[n0 + cc];
#pragma unroll
        for (int g8 = 0; g8 < 8; ++g8) s += red[(g8 * 5 + v) * 32 + cc];
        MOD[v * 6144 + n0 + cc] = s;
      }
    }
  }
  {
    const int gt = lbid() * 256 + tid, gn = lgdim() * 256;
    u16* KC = (u16*)(ws + OFF_KC);
    for (int e = gt; e < 4 * 256 * 1024 / 4; e += gn) {
      const float4 v = *(const float4*)(p.cache_k + (size_t)e * 4);
      uint2 o; o.x = pack2(v.x, v.y); o.y = pack2(v.z, v.w);
      *(uint2*)(KC + (size_t)e * 4) = o;
    }
    float* cosR = (float*)(ws + OFF_COSR); float* sinR = (float*)(ws + OFF_SINR);
    for (int e = gt; e < 4096 * 64; e += gn) {
      const int pos = e >> 6, d = e & 63;
      const int fi = d & 31;
      const float inv = powf(10000.0f, -(float)fi / 32.0f);
      const float pp = d < 32 ? (float)(pos >> 6) : (float)(pos & 63);
      const float ang = pp * inv;
      cosR[e] = cosf(ang); sinR[e] = sinf(ang);
    }
    float* cosD = (float*)(ws + OFF_COSD); float* sinD = (float*)(ws + OFF_SIND);
    for (int e = gt; e < 4096 * 32; e += gn) {
      const int pos = e >> 5, d = e & 31;
      const int fi = d & 15;
      const float inv = powf(10000.0f, -(float)fi / 16.0f);
      const float pp = d < 16 ? (float)(pos >> 6) : (float)(pos & 63);
      const float ang = pp * inv;
      cosD[e] = cosf(ang); sinD[e] = sinf(ang);
    }
  }
  if (lbid() == 0) {
    float* DEC = (float*)(ws + OFF_DEC);
    for (int e = tid; e < 512; e += 256) {
      const int hh = e >> 7, i = e & 127;
      const float df = p.decay_f[hh], db = p.decay_b[hh];
      const float lgf = fminf(df, 0.f) - log1pf(expf(-fabsf(df)));
      const float lgb = fminf(db, 0.f) - log1pf(expf(-fabsf(db)));
      DEC[DEC_WQF + e] = expf(lgf * (float)(i + 1));
      DEC[DEC_WQB + e] = expf(lgb * (float)(128 - i));
      DEC[DEC_WKF + e] = expf(lgf * (float)(127 - i));
      DEC[DEC_WKB + e] = expf(lgb * (float)i);
      if (i == 0) {
        DEC[DEC_LGF + hh] = lgf; DEC[DEC_LGB + hh] = lgb;
        DEC[DEC_GCF + hh] = expf(lgf * 128.f); DEC[DEC_GCB + hh] = expf(lgb * 128.f);
      }
    }
    if (tid < 64) {
      float s1 = p.lq1[tid] * p.lk1[tid], s2 = p.lq2[tid] * p.lk2[tid];
      s1 = wave_sum(s1); s2 = wave_sum(s2);
      if (tid == 0) DEC[DEC_LAM] = expf(s1) - expf(s2) + 0.2f;
    }
  }
}

DI void step_rownorm(const Params& p, int mode) {
  const int lane = ltid() & 63, wave = ltid() >> 6;
  const float* MOD = (const float*)(p.ws + OFF_MOD);
  u16* HB = (u16*)(p.ws + OFF_HB);
  for (int row = lbid() * 4 + wave; row < TT; row += lgdim() * 4) {
    const float* src = mode == 0 ? xrow(p, row) : p.out + OUT_Y + (size_t)row * D;
    float4 v[4];
    float ss = 0.f;
#pragma unroll
    for (int i = 0; i < 4; ++i) {
      v[i] = *(const float4*)(src + lane * 4 + 256 * i);
      ss += v[i].x * v[i].x + v[i].y * v[i].y + v[i].z * v[i].z + v[i].w * v[i].w;
    }
    ss = wave_sum(ss);
    const float rstd = rsqrtf(ss * (1.f / 1024.f) + 1e-6f);
    const int mv = row < TG ? 0 : 1 + ((row - TG) >> 12);
    const float* md = MOD + mv * 6144;
#pragma unroll
    for (int i = 0; i < 4; ++i) {
      const int col = lane * 4 + 256 * i;
      if (mode == 2) {
        const float4 g = *(const float4*)(p.final_g + col);
        float4 o; o.x = v[i].x * rstd * g.x; o.y = v[i].y * rstd * g.y; o.z = v[i].z * rstd * g.z; o.w = v[i].w * rstd * g.w;
        *(float4*)(p.out + OUT_Y + (size_t)row * D + col) = o;
      } else {
        const float4 g = *(const float4*)((mode == 0 ? p.norm1_g : p.norm2_g) + col);
        const float4 sh = *(const float4*)(md + (mode == 0 ? 0 : 3072) + col);
        const float4 sc = *(const float4*)(md + (mode == 0 ? 1024 : 4096) + col);
        uint2 o;
        o.x = pack2(v[i].x * rstd * g.x * (1.f + sc.x) + sh.x, v[i].y * rstd * g.y * (1.f + sc.y) + sh.y);
        o.y = pack2(v[i].z * rstd * g.z * (1.f + sc.z) + sh.z, v[i].w * rstd * g.w * (1.f + sc.w) + sh.w);
        if (mode == 0) *(uint2*)(HB + ((size_t)((row >> 7) * 16 + (col >> 6)) * 128 + (row & 127)) * 64 + (col & 63)) = o;
        else *(uint2*)(HB + (size_t)row * D + col) = o;
      }
    }
  }
}

DI void st_pair_bf16(u16* basep, int ro0, int ld, float a0, float a1, int odd) {
  const float send = odd ? a0 : a1;
  const float recv = __int_as_float(__builtin_amdgcn_mov_dpp(__float_as_int(send), 0xB1, 0xF, 0xF, true));
  const unsigned v = odd ? pack2(recv, a1) : pack2(a0, recv);
  *(unsigned*)(basep + ro0 * ld) = v;
}
DI void st_pair_f32_add(float* dstp, const float* srcp, int ro0, int ld, float v0, float v1, int odd) {
  const float send = odd ? v0 : v1;
  const float recv = __int_as_float(__builtin_amdgcn_mov_dpp(__float_as_int(send), 0xB1, 0xF, 0xF, true));
  const float2 x = *(const float2*)(srcp + ro0 * ld);
  float2 o;
  o.x = x.x + (odd ? recv : v0);
  o.y = x.y + (odd ? v1 : recv);
  *(float2*)(dstp + ro0 * ld) = o;
}
template <typename T> DI T* launder(T* p) { __attribute__((address_space(1))) T* g = (__attribute__((address_space(1))) T*)p; asm volatile("" : "+v"(g)); return (T*)g; }
#define ROFF(i, reg) ((i) * 32 + ((reg) & 3) + 8 * ((reg) >> 2))

DI void step_proj(const Params& p, int g, char* smem) {
  TILE_COORDS
  char* ws = glaunder(p.ws);
  u16* sA = (u16*)smem; u16* sB = sA + 128 * LDT;
  const u16* HBg = (const u16*)(ws + OFF_HB) + (size_t)g * TG * D;
  const u16* WIN = (const u16*)(ws + OFF_WIN);
  const float* DEC = (const float*)(ws + OFF_DEC);
  const bool lat = g > 0;
  for (int t = lbid(); t < 16 * 64; t += lgdim()) {
    const int nraw = t >> 4, mt = t & 15;
    const int ntile = nraw < 32 ? nraw : 32 + ((nraw - 32 + 16) & 31);
    const int m0 = mt * 256, n0 = ntile * 128;
    const int cbmode = n0 < 1024 ? 1 : 0;
    f32x16 acc[4][2];
    zero_acc4(acc);
    gemm_accum_256(acc, HBg + (size_t)(m0 >> 7) * 16 * 8192, 64, 8192, 16 * 8192, WIN + (size_t)ntile * 16 * 8192, 64, 8192, D, sA, cbmode);
    const int rowb = m0 + wm * 128 + 4 * h;
    if (n0 < 1024) {
      const bool isk = n0 >= 512;
      const int hh = (n0 & 511) >> 7;
      const int d1 = 32 * wn + r;
      const float* cosb = launder((const float*)(ws + OFF_COSR) + (size_t)rowb * 64 + d1);
      const float* sinb = launder((const float*)(ws + OFF_SINR) + (size_t)rowb * 64 + d1);
      const int ib = rowb & 127;
      const float* wfb = launder(DEC + (isk ? DEC_WKF : DEC_WQF) + hh * 128 + ib);
      const float* wbb = launder(DEC + (isk ? DEC_WKB : DEC_WQB) + hh * 128 + ib);
      const size_t o512 = (size_t)rowb * 512 + hh * 128 + d1;
      if (!isk) {
        u16* qr = launder((u16*)(ws + G_QR) + o512); u16* qa = launder((u16*)(ws + G_QA) + o512); u16* qb = launder((u16*)(ws + G_QB) + o512);
#pragma unroll
        for (int i = 0; i < 4; ++i) {
#pragma unroll
          for (int reg = 0; reg < 16; ++reg) {
            const int ro = ROFF(i, reg);
            const float x1 = acc[i][0][reg], x2 = acc[i][1][reg];
            float a = x1, b = x2;
            if (lat) { const float cs = cosb[ro * 64], sn = sinb[ro * 64]; a = x1 * cs - x2 * sn; b = x1 * sn + x2 * cs; }
            const float wf = wfb[ro], wb = wbb[ro];
            qr[ro * 512] = f2bf(a); qr[ro * 512 + 64] = f2bf(b);
            qa[ro * 512] = f2bf(a * wf); qa[ro * 512 + 64] = f2bf(b * wf);
            qb[ro * 512] = f2bf(a * wb); qb[ro * 512 + 64] = f2bf(b * wb);
          }
          SCHED_FENCE();
        }
      } else {
        u16* kr = launder((u16*)(ws + G_KR) + o512);
        const size_t ot = (size_t)(hh * 128 + d1) * TG + rowb;
        u16* kf = launder((u16*)(ws + G_KRTF) + ot); u16* kb = launder((u16*)(ws + G_KRTB) + ot);
#pragma unroll
        for (int i = 0; i < 4; ++i) {
#pragma unroll
          for (int rg = 0; rg < 4; ++rg) {
            float o1[4], o2[4], wf[4], wb[4];
#pragma unroll
            for (int e = 0; e < 4; ++e) {
              const int ro = ROFF(i, rg * 4 + e);
              const float x1 = acc[i][0][rg * 4 + e], x2 = acc[i][1][rg * 4 + e];
              float a = x1, b = x2;
              if (lat) { const float cs = cosb[ro * 64], sn = sinb[ro * 64]; a = x1 * cs - x2 * sn; b = x1 * sn + x2 * cs; }
              a *= 0.08838834764831845f; b *= 0.08838834764831845f;
              wf[e] = wfb[ro]; wb[e] = wbb[ro];
              o1[e] = a; o2[e] = b;
              kr[ro * 512] = f2bf(a); kr[ro * 512 + 64] = f2bf(b);
            }
            const int to = i * 32 + 8 * rg;
            u32x2 v;
            v.x = pack2(o1[0] * wf[0], o1[1] * wf[1]); v.y = pack2(o1[2] * wf[2], o1[3] * wf[3]); *(u32x2*)(kf + to) = v;
            v.x = pack2(o2[0] * wf[0], o2[1] * wf[1]); v.y = pack2(o2[2] * wf[2], o2[3] * wf[3]); *(u32x2*)(kf + to + 64 * TG) = v;
            v.x = pack2(o1[0] * wb[0], o1[1] * wb[1]); v.y = pack2(o1[2] * wb[2], o1[3] * wb[3]); *(u32x2*)(kb + to) = v;
            v.x = pack2(o2[0] * wb[0], o2[1] * wb[1]); v.y = pack2(o2[2] * wb[2], o2[3] * wb[3]); *(u32x2*)(kb + to + 64 * TG) = v;
          }
          SCHED_FENCE();
        }
      }
    } else if (n0 < 2048 || (n0 >= 5120 && n0 < 6144)) {
      const bool isd = n0 >= 5120;
      const int cbase = isd ? n0 - 5120 : n0 - 1024;
#pragma unroll
      for (int j = 0; j < 2; ++j) {
        const int col = cbase + COL_L(j, 0);
        u16* vt = launder((isd ? (u16*)(ws + G_VDT) : (u16*)(ws + G_VRT)) + (size_t)col * TG + rowb);
        float* ov = launder(p.out + OUT_DV + (size_t)rowb * 1024 + col);
#pragma unroll
        for (int i = 0; i < 4; ++i) {
#pragma unroll
          for (int rg = 0; rg < 4; ++rg) {
            u32x2 v;
            v.x = pack2(acc[i][j][rg * 4 + 0], acc[i][j][rg * 4 + 1]);
            v.y = pack2(acc[i][j][rg * 4 + 2], acc[i][j][rg * 4 + 3]);
            *(u32x2*)(vt + i * 32 + 8 * rg) = v;
            if (isd && !lat) {
#pragma unroll
              for (int e = 0; e < 4; ++e) ov[(i * 32 + 8 * rg + e) * 1024] = acc[i][j][rg * 4 + e];
            }
          }
        }
        SCHED_FENCE();
      }
    } else if (n0 < 3072) {
#pragma unroll
      for (int j = 0; j < 2; ++j) {
        u16* gr = launder((u16*)(ws + G_GR) + (size_t)rowb * 1024 + n0 - 2048 + COL_L(j, 0) + (r & 1) * 1023);
#pragma unroll
        for (int i = 0; i < 4; ++i)
#pragma unroll
          for (int reg = 0; reg < 16; reg += 2) st_pair_bf16(gr, ROFF(i, reg), 1024, silu_f(acc[i][j][reg]), silu_f(acc[i][j][reg + 1]), r & 1);
        SCHED_FENCE();
      }
    } else if (n0 < 5120) {
      const bool isk = n0 >= 4096;
      const int cbase = (isk ? n0 - 4096 : n0 - 3072) + 64 * wn + r;
      const float* cosb = launder((const float*)(ws + OFF_COSD) + (size_t)rowb * 32 + r);
      const float* sinb = launder((const float*)(ws + OFF_SIND) + (size_t)rowb * 32 + r);
      u16* dst = launder((isk ? (u16*)(ws + G_KD) : (u16*)(ws + G_QD)) + (size_t)rowb * 1024 + cbase);
      float* ok = launder(p.out + OUT_DK + (size_t)rowb * 1024 + cbase);
      const float qs = isk ? 1.f : 0.125f * 1.4426950408889634f;
#pragma unroll
      for (int i = 0; i < 4; ++i) {
#pragma unroll
        for (int reg = 0; reg < 16; ++reg) {
          const int ro = ROFF(i, reg);
          const float x1 = acc[i][0][reg], x2 = acc[i][1][reg];
          float a = x1, b = x2;
          if (lat) { const float cs = cosb[ro * 32], sn = sinb[ro * 32]; a = x1 * cs - x2 * sn; b = x1 * sn + x2 * cs; }
          else if (isk) { ok[ro * 1024] = x1; ok[ro * 1024 + 32] = x2; }
          dst[ro * 1024] = f2bf(a * qs);
          dst[ro * 1024 + 32] = f2bf(b * qs);
        }
        SCHED_FENCE();
      }
    } else {
#pragma unroll
      for (int j = 0; j < 2; ++j) {
        const int col = n0 - 6144 + COL_L(j, 0);
        const float bg = p.b_gate[col];
        u16* gt = launder((u16*)(ws + G_GATES) + (size_t)rowb * 2048 + col + (r & 1) * 2047);
#pragma unroll
        for (int i = 0; i < 4; ++i)
#pragma unroll
          for (int reg = 0; reg < 16; reg += 2) st_pair_bf16(gt, ROFF(i, reg), 2048, sigmoid_f(acc[i][j][reg] + bg), sigmoid_f(acc[i][j][reg + 1] + bg), r & 1);
        SCHED_FENCE();
      }
    }
  }
}

constexpr int LDK = 136, LDV = 72, LDC = 132;
DI void attn_item(const Params& p, int g, int item, char* smem, bool dummy = false) {
  const int tid = ltid(), lane = tid & 63, wave = tid >> 6, r = lane & 31, h = lane >> 5;
  const int m = wave >> 1, rw = wave & 1;
  char* ws = glaunder(p.ws);
  u16* sK = (u16*)smem; u16* sV = sK + 64 * LDK;
  float* cmb = (float*)smem;
  const int head = item & 7, rest = item >> 3;
  int q0, kbase, nt0, nt1;
  if (g == 0) { const int seq = rest >> 2; q0 = seq * 256 + (rest & 3) * 64; kbase = seq * 256; nt0 = 4; nt1 = 0; }
  else { q0 = rest * 64; kbase = 0; nt0 = 64; nt1 = 4; }
  u16* QD = (u16*)(ws + G_QD);
  const u16* KD = (const u16*)(ws + G_KD);
  const u16* VDT = (const u16*)(ws + G_VDT);
  const u16* KCb = (const u16*)(ws + OFF_KC) + (size_t)(g > 0 ? g - 1 : 0) * 256 * 1024;
  const u16* VCb = (const u16*)(ws + OFF_VCT) + (size_t)(g > 0 ? g - 1 : 0) * 1024 * 256;
  const float lam = ((const float*)(ws + OFF_DEC))[DEC_LAM];
  const int qrow = q0 + rw * 32 + r;
  bf16x8 qf[4];
#pragma unroll
  for (int ks = 0; ks < 4; ++ks) qf[ks] = *(const bf16x8*)(QD + (size_t)qrow * 1024 + head * 128 + m * 64 + ks * 16 + h * 8);
  f32x16 O[4];
#pragma unroll
  for (int d = 0; d < 4; ++d)
#pragma unroll
    for (int e = 0; e < 16; ++e) O[d][e] = 0.f;
  float mrun = -1e30f, lsum = 0.f;
  const int ntiles = nt0 + nt1;
  constexpr int ASTG = 64 * LDK + 128 * LDV;
  const u16* sKw = sK + r * LDK + m * 64 + h * 8;
  const u16* sVw = sV + r * LDV + 8 * h;
  const int krow_l = tid >> 4;
  const int krow_p = (krow_l & 3) | ((krow_l & 4) << 1) | ((krow_l & 8) >> 1);
  u16* wK = sK + krow_p * LDK + (tid & 15) * 8;
  u16* wV = sV + (tid >> 3) * LDV + (tid & 7) * 8;
  u32x4 rk[4], rv[4];
#define ATTN_LOAD(T)                                                                                                   \
  {                                                                                                                    \
    const u16* kp; const u16* vp; int ldv;                                                                             \
    if ((T) < nt0) { kp = KD + (size_t)(kbase + (T) * 64) * 1024 + head * 128; vp = VDT + (size_t)(head * 128) * TG + kbase + (T) * 64; ldv = TG; } \
    else { const int t2 = (T) - nt0; kp = KCb + (size_t)(t2 * 64) * 1024 + head * 128; vp = VCb + (size_t)(head * 128) * 256 + t2 * 64; ldv = 256; } \
    _Pragma("unroll") for (int q = 0; q < 4; ++q) {                                                                    \
      rk[q] = *(const u32x4*)(kp + (size_t)((tid >> 4) + 16 * q) * 1024 + (tid & 15) * 8);                             \
      rv[q] = *(const u32x4*)(vp + (size_t)((tid >> 3) + 32 * q) * ldv + (tid & 7) * 8);                               \
    }                                                                                                                  \
  }
#define ATTN_STORE(STAGE)                                                                                              \
  {                                                                                                                    \
    _Pragma("unroll") for (int q = 0; q < 4; ++q) {                                                                    \
      *(u32x4*)(wK + (STAGE) * ASTG + 16 * q * LDK) = rk[q];                                                           \
      *(u32x4*)(wV + (STAGE) * ASTG + 32 * q * LDV) = rv[q];                                                           \
    }                                                                                                                  \
  }
  ATTN_LOAD(0)
  __syncthreads();
  ATTN_STORE(0)
  __syncthreads();
  if (ntiles > 1) ATTN_LOAD(1)
  for (int t = 0; t < ntiles; ++t) {
    const int cur = t & 1;
    const u16* sKc = sKw + cur * ASTG;
    const u16* sVc = sVw + cur * ASTG;
    bf16x8 ka[2][4];
#pragma unroll
    for (int kb = 0; kb < 2; ++kb)
#pragma unroll
      for (int ks = 0; ks < 4; ++ks) ka[kb][ks] = *(const bf16x8*)(sKc + kb * 32 * LDK + ks * 16);
    __builtin_amdgcn_sched_barrier(0);
    f32x16 st[2];
#pragma unroll
    for (int e = 0; e < 16; ++e) { st[0][e] = 0.f; st[1][e] = 0.f; }
#pragma unroll
    for (int ks = 0; ks < 4; ++ks) {
      st[0] = MFMA(ka[0][ks], qf[ks], st[0]);
      st[1] = MFMA(ka[1][ks], qf[ks], st[1]);
    }
    bf16x8 va[2][4];
#define ATTN_LOADV(BUF, GI)                                                                       \
  {                                                                                               \
    _Pragma("unroll") for (int d = 0; d < 4; ++d) {                                               \
      va[BUF][d] = *(const bf16x8*)(sVc + d * 32 * LDV + (GI) * 16);                              \
    }                                                                                             \
  }
    ATTN_LOADV(0, 0)
    __builtin_amdgcn_sched_barrier(0);
    float mx = fmaxf(st[0][0], st[1][0]);
#pragma unroll
    for (int e = 1; e < 16; ++e) mx = fmaxf(mx, fmaxf(st[0][e], st[1][e]));
    mx = fmaxf(mx, __shfl_xor(mx, 32, 64));
    if (__any(mx > mrun + 8.0f)) {
      const float mnew = fmaxf(mrun, mx);
      const float alpha = __builtin_amdgcn_exp2f(mrun - mnew);
      mrun = mnew;
      lsum *= alpha;
#pragma unroll
      for (int d = 0; d < 4; ++d)
#pragma unroll
        for (int e = 0; e < 16; ++e) O[d][e] *= alpha;
    }
    float rs = 0.f;
#pragma unroll
    for (int kb = 0; kb < 2; ++kb)
#pragma unroll
      for (int e = 0; e < 16; ++e) { const float pv = __builtin_amdgcn_exp2f(st[kb][e] - mrun); st[kb][e] = pv; rs += pv; }
    rs += __shfl_xor(rs, 32, 64);
    lsum += rs;
    union { bf16x8 v; unsigned u[4]; } pf[4];
#pragma unroll
    for (int gi = 0; gi < 4; ++gi) {
      const int kb = gi >> 1, s2 = gi & 1;
      pf[gi].u[0] = pack2(st[kb][8 * s2 + 0], st[kb][8 * s2 + 1]);
      pf[gi].u[1] = pack2(st[kb][8 * s2 + 2], st[kb][8 * s2 + 3]);
      pf[gi].u[2] = pack2(st[kb][8 * s2 + 4], st[kb][8 * s2 + 5]);
      pf[gi].u[3] = pack2(st[kb][8 * s2 + 6], st[kb][8 * s2 + 7]);
    }
    __builtin_amdgcn_sched_barrier(0);
    __builtin_amdgcn_s_setprio(1);
#pragma unroll
    for (int gi = 0; gi < 4; ++gi) {
      if (gi < 3) ATTN_LOADV((gi + 1) & 1, gi + 1)
      __builtin_amdgcn_sched_barrier(0);
#pragma unroll
      for (int d = 0; d < 4; ++d) O[d] = MFMA(va[gi & 1][d], pf[gi].v, O[d]);
      __builtin_amdgcn_sched_barrier(0);
    }
    __builtin_amdgcn_s_setprio(0);
#undef ATTN_LOADV
    if (t + 1 < ntiles) ATTN_STORE(cur ^ 1)
    __syncthreads();
    if (t + 2 < ntiles) ATTN_LOAD(t + 2)
  }
#undef ATTN_LOAD
#undef ATTN_STORE
  __syncthreads();
  float* crow_p = cmb + (rw * 32 + r) * LDC + 4 * h;
  if (m == 1) {
    const float sc = lam / lsum;
#pragma unroll
    for (int d = 0; d < 4; ++d)
#pragma unroll
      for (int rg = 0; rg < 4; ++rg) {
        float4 v; v.x = O[d][rg * 4 + 0] * sc; v.y = O[d][rg * 4 + 1] * sc; v.z = O[d][rg * 4 + 2] * sc; v.w = O[d][rg * 4 + 3] * sc;
        *(float4*)(crow_p + d * 32 + 8 * rg) = v;
      }
  }
  __syncthreads();
  if (m == 0) {
    const float i0 = 1.f / lsum;
    float ss = 0.f;
#pragma unroll
    for (int d = 0; d < 4; ++d)
#pragma unroll
      for (int rg = 0; rg < 4; ++rg) {
        const float4 c = *(const float4*)(crow_p + d * 32 + 8 * rg);
        const float o0 = O[d][rg * 4 + 0] * i0 - c.x, o1 = O[d][rg * 4 + 1] * i0 - c.y, o2 = O[d][rg * 4 + 2] * i0 - c.z, o3 = O[d][rg * 4 + 3] * i0 - c.w;
        O[d][rg * 4 + 0] = o0; O[d][rg * 4 + 1] = o1; O[d][rg * 4 + 2] = o2; O[d][rg * 4 + 3] = o3;
        ss += o0 * o0 + o1 * o1 + o2 * o2 + o3 * o3;
      }
    ss += __shfl_xor(ss, 32, 64);
    const float rstd = rsqrtf(ss * (1.f / 128.f) + 1e-6f) * 0.8f;
#pragma unroll
    for (int d = 0; d < 4; ++d)
#pragma unroll
      for (int rg = 0; rg < 4; ++rg) {
        const int e0 = d * 32 + 8 * rg + 4 * h;
        const float4 gg = *(const float4*)(p.subln_g + e0);
        u32x2 v;
        v.x = pack2(O[d][rg * 4 + 0] * rstd * gg.x, O[d][rg * 4 + 1] * rstd * gg.y);
        v.y = pack2(O[d][rg * 4 + 2] * rstd * gg.z, O[d][rg * 4 + 3] * rstd * gg.w);
        *(u32x2*)((dummy ? (u16*)(ws + G_SP) : QD) + (size_t)qrow * 1024 + head * 128 + e0) = v;
      }
  }
}

DI void step_mix3(const Params& p, int g, char* smem) {
  TILE_COORDS
  char* ws = glaunder(p.ws);
  u16* sA = (u16*)smem; u16* sB = sA + 128 * LDT;
  const float* DEC = (const float*)(ws + OFF_DEC);
  for (int t = lbid(); t < 512 + 512 + 128; t += lgdim()) {
    if (t < 512) {
#if PROBE_M3
      attn_item(p, g, t, smem, true);
#endif
      attn_item(p, g, t, smem); continue; }
    f32x16 acc[2][2];
    zero_acc(acc);
    const int rowb = wm * 64 + 4 * h;
    if (t < 1024) {
      const int tt = t - 512;
      const int chunk = tt >> 4, hh = (tt >> 2) & 3, dir = (tt >> 1) & 1, mt = tt & 1;
      const u16* A = (const u16*)(ws + G_VRT) + (size_t)(hh * 256 + mt * 128) * TG + chunk * 128;
      const u16* Bt = (const u16*)(ws + (dir ? G_KRTB : G_KRTF)) + (size_t)(hh * 128) * TG + chunk * 128;
      gemm_accum(acc, A, TG, Bt, TG, 128, sA, sB, 0);
#pragma unroll
      for (int j = 0; j < 2; ++j) {
        float* kv = launder((float*)(ws + G_KV) + (size_t)((chunk * 4 + hh) * 2 + dir) * 32768 + (size_t)(mt * 128 + rowb) * 128 + COL_L(j, 0));
#pragma unroll
        for (int i = 0; i < 2; ++i)
#pragma unroll
          for (int reg = 0; reg < 16; ++reg) kv[ROFF(i, reg) * 128] = acc[i][j][reg];
        SCHED_FENCE();
      }
    } else {
      const int tt = t - 1024;
      const int chunk = tt >> 2, hh = tt & 3;
      const u16* A = (const u16*)(ws + G_QR) + (size_t)(chunk * 128) * 512 + hh * 128;
      const u16* Bt = (const u16*)(ws + G_KR) + (size_t)(chunk * 128) * 512 + hh * 128;
      gemm_accum(acc, A, 512, Bt, 512, 128, sA, sB, 0);
      const float lgf = DEC[DEC_LGF + hh], lgb = DEC[DEC_LGB + hh];
      int rbl = rowb;
      asm volatile("" : "+v"(rbl));
#pragma unroll
      for (int j = 0; j < 2; ++j) {
        const int cj = COL_L(j, 0);
        u16* sc = launder((u16*)(ws + G_SC) + (size_t)(chunk * 4 + hh) * 16384 + rowb * 128 + cj);
#pragma unroll
        for (int i = 0; i < 2; ++i)
#pragma unroll
          for (int reg = 0; reg < 16; ++reg) {
            const int ri = rbl + ROFF(i, reg);
            const float dd = (float)(ri - cj);
            const float dec = cj <= ri ? __expf(lgf * dd) : __expf(-lgb * dd);
            sc[ROFF(i, reg) * 128] = f2bf(acc[i][j][reg] * dec);
          }
        SCHED_FENCE();
      }
    }
  }
}

template <int NCH> DI void scan_body(const Params& p, int g, char* ws) {
  const float* DEC = (const float*)(ws + OFF_DEC);
  const float* KV = (const float*)(ws + G_KV);
  u16* SP = (u16*)(ws + G_SP);
  const int nseq = (4096 / 128) / NCH;
  const int total = nseq * 262144;
  for (int e = lbid() * 256 + ltid(); e < total; e += lgdim() * 256) {
    const int idx = e & 32767, hd = (e >> 15) & 7, hh = hd >> 1, dir = hd & 1, seq = e >> 18;
    const int dv = idx >> 7, dk = idx & 127;
    float s = 0.f;
    if (g > 0) s = (dir ? p.state_b : p.state_f)[(size_t)((g - 1) * 4 + hh) * 32768 + dk * 256 + dv];
    const float gc = DEC[(dir ? DEC_GCB : DEC_GCF) + hh];
    const int c0 = seq * NCH;
    const size_t ob = (size_t)(((dir ? c0 + NCH - 1 : c0) * 4 + hh) * 2 + dir) * 32768 + idx;
    const ptrdiff_t stp = (ptrdiff_t)(dir ? -1 : 1) * (4 * 2 * 32768);
    float kvv[NCH];
#pragma unroll
    for (int n = 0; n < NCH; ++n) kvv[n] = KV[ob + n * stp];
#pragma unroll
    for (int n = 0; n < NCH; ++n) {
      SP[ob + n * stp] = f2bf(s);
      s = gc * s + kvv[n];
    }
    if (g == 0) (p.out + (dir ? OUT_RB : OUT_RF))[(size_t)(seq * 4 + hh) * 32768 + dk * 256 + dv] = s;
  }
}
DI void step_scan(const Params& p, int g) {
  char* ws = glaunder(p.ws);
  if (g == 0) scan_body<2>(p, g, ws); else scan_body<32>(p, g, ws);
}

DI void step_retout(const Params& p, char* smem) {
  TILE_COORDS
  char* ws = glaunder(p.ws);
  u16* sA = (u16*)smem; u16* sB = sA + 128 * LDT;
  for (int t = lbid(); t < 512; t += lgdim()) {
    const int chunk = t >> 4, hh = (t >> 2) & 3, nt = t & 3;
    f32x16 acc[2][1];
    zero_acc1(acc);
    gemm_accum_t<1>(acc, (const u16*)(ws + G_SC) + (size_t)(chunk * 4 + hh) * 16384, 128,
                    (const u16*)(ws + G_VRT) + (size_t)(hh * 256 + nt * 64) * TG + chunk * 128, TG, 128, sA, sB, 0);
    gemm_accum_t<1>(acc, (const u16*)(ws + G_QA) + (size_t)(chunk * 128) * 512 + hh * 128, 512,
                    (const u16*)(ws + G_SP) + (size_t)((chunk * 4 + hh) * 2 + 0) * 32768 + (size_t)nt * 64 * 128, 128, 128, sA, sB, 0);
    gemm_accum_t<1>(acc, (const u16*)(ws + G_QB) + (size_t)(chunk * 128) * 512 + hh * 128, 512,
                    (const u16*)(ws + G_SP) + (size_t)((chunk * 4 + hh) * 2 + 1) * 32768 + (size_t)nt * 64 * 128, 128, 128, sA, sB, 0);
    const int rowb = chunk * 128 + wm * 64 + 4 * h;
    float* op = launder((float*)(ws + G_KV) + (size_t)rowb * 1024 + hh * 256 + nt * 64 + wn * 32 + r);
#pragma unroll
    for (int i = 0; i < 2; ++i)
#pragma unroll
      for (int reg = 0; reg < 16; ++reg) op[ROFF(i, reg) * 1024] = acc[i][0][reg];
  }
}

DI void step_gn(const Params& p) {
  const int lane = ltid() & 63, wave = ltid() >> 6;
  const float* OPRE = (const float*)(p.ws + G_KV);
  u16* GR = (u16*)(p.ws + G_GR);
  for (int it = lbid() * 4 + wave; it < TG * 4; it += lgdim() * 4) {
    const int tok = it >> 2, hh = it & 3;
    const size_t o = (size_t)tok * 1024 + hh * 256 + lane * 4;
    const float4 v = *(const float4*)(OPRE + o);
    const float mu = wave_sum(v.x + v.y + v.z + v.w) * (1.f / 256.f);
    const float d0 = v.x - mu, d1 = v.y - mu, d2 = v.z - mu, d3 = v.w - mu;
    const float var = wave_sum(d0 * d0 + d1 * d1 + d2 * d2 + d3 * d3) * (1.f / 256.f);
    const float rstd = rsqrtf(var + 1e-5f);
    const float4 gg = *(const float4*)(p.gn_g + hh * 256 + lane * 4);
    const u32x2 gr = *(const u32x2*)(GR + o);
    u32x2 w;
    w.x = pack2(d0 * rstd * gg.x * bf2f((u16)(gr.x & 0xffff)), d1 * rstd * gg.y * bf2f((u16)(gr.x >> 16)));
    w.y = pack2(d2 * rstd * gg.z * bf2f((u16)(gr.y & 0xffff)), d3 * rstd * gg.w * bf2f((u16)(gr.y >> 16)));
    *(u32x2*)(GR + o) = w;
  }
}

DI void pair_own(float a0, float a1, int odd, float& p0, float& p1) {
  const float send = odd ? a0 : a1;
  const float recv = __int_as_float(__builtin_amdgcn_mov_dpp(__float_as_int(send), 0xB1, 0xF, 0xF, true));
  p0 = odd ? recv : a0;
  p1 = odd ? a1 : recv;
}
DI void step_branch(const Params& p, char* smem) {
  TILE_COORDS
  char* ws = glaunder(p.ws);
  u16* sA = (u16*)smem; u16* sB = sA + 128 * LDT;
  for (int t = lbid(); t < 512; t += lgdim()) {
    const int ntile = t >> 5, mt = t & 31;
    const int m0 = mt * 128, n0 = ntile * 64;
    const int rowb = m0 + wm * 64 + 4 * h;
    const int col = n0 + wn * 32 + r;
    const int odd = r & 1;
    f32x16 acc[2][1];
    zero_acc1(acc);
    gemm_accum_t<1>(acc, (const u16*)(ws + G_GR) + (size_t)m0 * 1024, 1024, (const u16*)(ws + OFF_WR) + (size_t)n0 * 1024, 1024, 1024, sA, sB, 0);
    f32x16 res[2];
    {
      const u16* gt = launder((const u16*)(ws + G_GATES) + (size_t)rowb * 2048 + col + odd * 2047);
#pragma unroll
      for (int i = 0; i < 2; ++i)
#pragma unroll
        for (int reg = 0; reg < 16; reg += 2) {
          float p0, p1;
          pair_own(acc[i][0][reg], acc[i][0][reg + 1], odd, p0, p1);
          const unsigned g2 = *(const unsigned*)(gt + ROFF(i, reg) * 2048);
          res[i][reg] = p0 * bf2f((u16)(g2 & 0xffff));
          res[i][reg + 1] = p1 * bf2f((u16)(g2 >> 16));
        }
      SCHED_FENCE();
    }
    zero_acc1(acc);
    gemm_accum_t<1>(acc, (const u16*)(ws + G_QD) + (size_t)m0 * 1024, 1024, (const u16*)(ws + OFF_WD) + (size_t)n0 * 1024, 1024, 1024, sA, sB, 0);
    {
      const u16* gt = launder((const u16*)(ws + G_GATES) + (size_t)rowb * 2048 + 1024 + col + odd * 2047);
      u16* mix = launder((u16*)(ws + G_MIX) + (size_t)rowb * 1024 + col + odd * 1023);
#pragma unroll
      for (int i = 0; i < 2; ++i)
#pragma unroll
        for (int reg = 0; reg < 16; reg += 2) {
          float p0, p1;
          pair_own(acc[i][0][reg], acc[i][0][reg + 1], odd, p0, p1);
          const unsigned g2 = *(const unsigned*)(gt + ROFF(i, reg) * 2048);
          *(unsigned*)(mix + ROFF(i, reg) * 1024) = pack2(res[i][reg] + p0 * bf2f((u16)(g2 & 0xffff)), res[i][reg + 1] + p1 * bf2f((u16)(g2 >> 16)));
        }
      SCHED_FENCE();
    }
  }
}

DI void step_wo(const Params& p, int g, char* smem) {
  TILE_COORDS
  char* ws = glaunder(p.ws);
  u16* sA = (u16*)smem; u16* sB = sA + 128 * LDT;
  const float* gate1 = (const float*)(ws + OFF_MOD) + g * 6144 + 2048;
  for (int t = lbid(); t < 512; t += lgdim()) {
    const int ntile = t >> 5, mt = t & 31;
    const int m0 = mt * 128, n0 = ntile * 64;
    f32x16 acc[2][1];
    zero_acc1(acc);
    gemm_accum_t<1>(acc, (const u16*)(ws + G_MIX) + (size_t)m0 * 1024, 1024, (const u16*)(ws + OFF_WO) + (size_t)n0 * 1024, 1024, 1024, sA, sB, 0);
    const int rowb = g * TG + m0 + wm * 64 + 4 * h;
    const int col = n0 + wn * 32 + r;
    const float g1 = gate1[col];
    const float* xs = launder(xrow(p, rowb) + col + (r & 1) * (D - 1));
    float* o = launder(p.out + OUT_Y + (size_t)rowb * D + col + (r & 1) * (D - 1));
#pragma unroll
    for (int i = 0; i < 2; ++i)
#pragma unroll
      for (int reg = 0; reg < 16; reg += 2) st_pair_f32_add(o, xs, ROFF(i, reg), D, g1 * acc[i][0][reg], g1 * acc[i][0][reg + 1], r & 1);
  }
}

DI void step_ffn_up(const Params& p, char* smem) {
  TILE_COORDS
  char* ws = glaunder(p.ws);
  u16* sA = (u16*)smem; u16* sB = sA + 128 * LDT;
  for (int t = lbid(); t < 80 * 44; t += lgdim()) {
    const int ntile = t / 80, mt = t % 80;
    const int m0 = mt * 256, n0 = ntile * 128;
    f32x16 acc[4][2];
    zero_acc4(acc);
    gemm_accum_256(acc, (const u16*)(ws + OFF_HB) + (size_t)m0 * 1024, 1024, 64, 128 * 1024, (const u16*)(ws + OFF_WGU) + (size_t)n0 * 1024, 1024, 64, 1024, sA, 0);
    const int rowb = m0 + wm * 128 + 4 * h;
    u16* act = launder((u16*)(ws + OFF_ACT) + (size_t)rowb * FF + ntile * 64 + 32 * wn + r + (r & 1) * (FF - 1));
#pragma unroll
    for (int i = 0; i < 4; ++i) {
#pragma unroll
      for (int reg = 0; reg < 16; reg += 2) st_pair_bf16(act, ROFF(i, reg), FF, silu_f(acc[i][0][reg]) * acc[i][1][reg], silu_f(acc[i][0][reg + 1]) * acc[i][1][reg + 1], r & 1);
      SCHED_FENCE();
    }
  }
}

DI void step_ffn_down(const Params& p, char* smem) {
  TILE_COORDS
  char* ws = glaunder(p.ws);
  u16* sA = (u16*)smem; u16* sB = sA + 128 * LDT;
  const float* MOD = (const float*)(ws + OFF_MOD);
  for (int t = lbid(); t < 160 * 8; t += lgdim()) {
    const int ntile = t / 160, mt = t % 160;
    const int m0 = mt * 128, n0 = ntile * 128;
    f32x16 acc[2][2];
    zero_acc(acc);
    gemm_accum(acc, (const u16*)(ws + OFF_ACT) + (size_t)m0 * FF, FF, (const u16*)(ws + OFF_WDN) + (size_t)n0 * FF, FF, FF, sA, sB, 0);
    const int mv = m0 < TG ? 0 : 1 + ((m0 - TG) >> 12);
    const float* gate2 = MOD + mv * 6144 + 5120;
    const int rowb = m0 + wm * 64 + 4 * h;
#pragma unroll
    for (int j = 0; j < 2; ++j) {
      const int col = n0 + COL_L(j, 0);
      const float g2 = gate2[col];
      float* o = launder(p.out + OUT_Y + (size_t)rowb * D + col + (r & 1) * (D - 1));
#pragma unroll
      for (int i = 0; i < 2; ++i)
#pragma unroll
        for (int reg = 0; reg < 16; reg += 2) st_pair_f32_add(o, o, ROFF(i, reg), D, g2 * acc[i][j][reg], g2 * acc[i][j][reg + 1], r & 1);
      SCHED_FENCE();
    }
  }
}


#define XB_TMO      128
#define XB_XCNT(j)  (256  + 64 * (j))
#define XB_XSUB(j)  (1280 + 64 * (j))
#define XB_XGEN(j)  (2304 + 64 * (j))
#define XB_TOP      3328
#define XB_TOPGEN   3392
#define XCD_BAR_WORDS 3456
#define XB_SPIN_CAP (1u << 22)
#define LAS __attribute__((address_space(3)))
DI unsigned xb_ld(unsigned* p)              { return __hip_atomic_load(p, __ATOMIC_RELAXED, __HIP_MEMORY_SCOPE_AGENT); }
DI unsigned xb_add(unsigned* p, unsigned v) { return __hip_atomic_fetch_add(p, v, __ATOMIC_RELAXED, __HIP_MEMORY_SCOPE_AGENT); }
DI unsigned xb_xcc_id() { return (unsigned)__builtin_amdgcn_s_getreg((3 << 11) | 20) & 0xFu; }
#define XB_SPIN(cond, bar) do { unsigned _sp = 0; while (cond) { __builtin_amdgcn_s_sleep(1); \
    if ((++_sp & 255u) == 0u) { if (xb_ld(&(bar)[XB_TMO])) break; if (_sp > XB_SPIN_CAP) { atomicAdd(&(bar)[XB_TMO], 1u); break; } } } } while (0)
struct XcdBarrier { unsigned* bar; unsigned x; volatile LAS unsigned* st; };
DI XcdBarrier xcd_barrier_post(unsigned* bar, volatile LAS unsigned* st) {
  XcdBarrier b; b.bar = bar; b.x = xb_xcc_id(); b.st = st;
  if (threadIdx.x == 0) (void)xb_add(&bar[XB_XCNT(b.x)], 1u);
  return b;
}
DI void xcd_barrier_complete(unsigned* bar, unsigned x, unsigned& nloc, unsigned& nx) {
  const unsigned G = gridDim.x * gridDim.y * gridDim.z;
  unsigned sum, cnt, mine, sp = 0u;
  for (;;) {
    sum = 0u; cnt = 0u; mine = 0u;
#pragma unroll
    for (unsigned j = 0; j < 16; ++j) { const unsigned c = xb_ld(&bar[XB_XCNT(j)]); sum += c; cnt += (c > 0u) ? 1u : 0u; mine = (j == x) ? c : mine; }
    if (sum == G) break;
    __builtin_amdgcn_s_sleep(1);
    if ((++sp & 255u) == 0u) { if (xb_ld(&bar[XB_TMO])) break; if (sp > XB_SPIN_CAP) { atomicAdd(&bar[XB_TMO], 1u); break; } }
  }
  nloc = mine > 0u ? mine : 1u; nx = cnt > 0u ? cnt : 1u;
}
DI void xcd_barrier(const XcdBarrier& b) {
  asm volatile("s_waitcnt vmcnt(0)" ::: "memory");
  __syncthreads();
  if (threadIdx.x == 0) {
    unsigned* bar = b.bar;
    __builtin_amdgcn_s_waitcnt(0);
    unsigned nloc = b.st[0], nx = b.st[1];
    if (nloc == 0u) { xcd_barrier_complete(bar, b.x, nloc, nx); b.st[0] = nloc; b.st[1] = nx; }
    const unsigned old = xb_add(&bar[XB_XSUB(b.x)], 1u);
    const unsigned gen = old / nloc;
    if (old + 1u == (gen + 1u) * nloc) {
      __builtin_amdgcn_fence(__ATOMIC_RELEASE, "agent");
      asm volatile("s_waitcnt vmcnt(0)" ::: "memory");
      const unsigned og = xb_add(&bar[XB_TOP], 1u);
      const unsigned tg = og / nx;
      if (og + 1u == (tg + 1u) * nx) xb_add(&bar[XB_TOPGEN], 1u);
      else XB_SPIN(xb_ld(&bar[XB_TOPGEN]) == tg, bar);
      __builtin_amdgcn_fence(__ATOMIC_ACQUIRE, "agent");
      xb_add(&bar[XB_XGEN(b.x)], 1u);
      asm volatile("s_waitcnt vmcnt(0)" ::: "memory");
    } else {
      XB_SPIN(xb_ld(&bar[XB_XGEN(b.x)]) == gen, bar);
      __builtin_amdgcn_fence(__ATOMIC_ACQUIRE, "agent");
      asm volatile("s_waitcnt vmcnt(0)" ::: "memory");
    }
  }
  __syncthreads();
}

constexpr int NSTEPS = 37;

__global__ void __launch_bounds__(256, 2) mega(Params p, int lo, int hi) {
  __shared__ __attribute__((aligned(16))) char smem[SMEM_BYTES];
  __shared__ uint4 xb_words;
  cg::grid_group grid = cg::this_grid();
  if (lo > hi) grid.sync();
  if (threadIdx.x == 0) xb_words = make_uint4(0u, 0u, 0u, 0u);
  __syncthreads();
  XcdBarrier xb = xcd_barrier_post((unsigned*)(p.ws + OFF_BAR), (volatile LAS unsigned*)&xb_words);
  for (int step = lo; step < hi; ++step) {
    if (step == 0) { step_p0(p, smem); if (PROBE_M1) step_p0(p, smem); }
    else if (step == 1) { step_rownorm(p, 0); if (PROBE_M1) step_rownorm(p, 0); }
    else if (step == 2) step_proj(p, 0, smem);
    else if (step < 33) {
      const int g = (step - 3) / 6, s = (step - 3) % 6;
      if (s == 0) step_mix3(p, g, smem);
      else if (s == 1) { step_scan(p, g); if (PROBE_M1) step_scan(p, g); }
      else if (s == 2) { step_retout(p, smem); if (PROBE_M2) step_retout(p, smem); }
      else if (s == 3) step_gn(p);
      else if (s == 4) { step_branch(p, smem); if (PROBE_M2) step_branch(p, smem); }
      else { step_wo(p, g, smem); if (g < 4) step_proj(p, g + 1, smem); }
    } else if (step == 33) { step_rownorm(p, 1); if (PROBE_M1) step_rownorm(p, 1); }
    else if (step == 34) step_ffn_up(p, smem);
    else if (step == 35) step_ffn_down(p, smem);
    else step_rownorm(p, 2);
    if (step + 1 < hi) xcd_barrier(xb);
  }
}

extern "C" void kernel_launch(void* const* d_in, const int* in_sizes, int n_in, void* d_out, int out_size, void* d_ws, size_t ws_size, hipStream_t stream) {
  static int grid_blocks = 0;
  if (!grid_blocks) {
    int dev = 0, cus = 0, per_cu = 0;
    hipGetDevice(&dev);
    hipDeviceGetAttribute(&cus, hipDeviceAttributeMultiprocessorCount, dev);
    hipOccupancyMaxActiveBlocksPerMultiprocessor(&per_cu, mega, 256, 0);
    if (per_cu < 1) per_cu = 1;
    if (per_cu > 2) per_cu = 2;
    grid_blocks = cus * per_cu;
  }
  Params p{};
  const float** f = (const float**)&p;
  for (int i = 0; i < 29; ++i) f[i] = (const float*)d_in[i];
  p.out = (float*)d_out;
  p.ws = (char*)d_ws;
  hipMemsetAsync((char*)d_ws + OFF_BAR, 0, XCD_BAR_WORDS * 4, stream);
#if COOP
  int lo = 0, hi = NSTEPS;
  void* args[] = {&p, &lo, &hi};
  hipError_t e = hipLaunchCooperativeKernel((void*)mega, dim3(grid_blocks), dim3(256), args, 0, stream);
  if (e != hipSuccess) fprintf(stderr, "cooperative launch failed: %s (grid %d)\n", hipGetErrorString(e), grid_blocks);
#else
  for (int s = 0; s < NSTEPS; ++s) hipLaunchKernelGGL(mega, dim3(grid_blocks), dim3(256), 0, stream, p, s, s + 1);
#endif
}
```
